# Optimizing an MI355X kernel written in HIP

```python
import jax, jax.numpy as jnp
from jax import lax
import numpy as np

D_MODEL = 2048
BATCH = 8
SEQ = 2048
DEPTH = 2

GRID_W = 64
CTX_LEN = 256
D_CONV = D_MODEL // 2
CONV_W = 3
HG_DK = 128
HG_DV = 128
D_F = D_MODEL // 2
D_V = D_MODEL // 2
HG_HEADS = D_F // HG_DK
CHUNK = 64
PEER_HEADS = 8
N_KEYS = 128
N_EXPERTS = N_KEYS * N_KEYS
D_QUERY = 256
TOPK_HALF = 16
TOPK = 16
PEER_BLOCK = 128
IN_WIDTH = 3 * D_CONV + 3 * D_F + 2 * D_V + 2 * D_MODEL
ALPHA = (2.0 * DEPTH) ** 0.25
BETA = (8.0 * DEPTH) ** -0.25
EPS = 1e-6
F_MIN = 1e-30

kernel_name = 'hybrid_conv_hgrn2_peer_diffusion_block'


def _layer_norm(x, g=None, b=None):
    xf = x.astype(jnp.float32)
    mu = jnp.mean(xf, axis=-1, keepdims=True)
    var = jnp.mean(jnp.square(xf - mu), axis=-1, keepdims=True)
    y = (xf - mu) * lax.rsqrt(var + EPS)
    if g is not None:
        y = y * g.astype(jnp.float32) + b.astype(jnp.float32)
    return y.astype(x.dtype)


def _modulate(x, shift, scale):
    return _layer_norm(x) * (1 + scale) + shift


def _split_in(p):
    sizes = (D_CONV,) * 3 + (D_F,) * 3 + (D_V,) * 2 + (D_MODEL,) * 2
    cuts = [int(s) for s in np.cumsum(sizes)[:-1]]
    return jnp.split(p, cuts, axis=-1)


def _short_conv(u, w, b):
    pad = [(0, 0)] * (u.ndim - 2) + [(1, 1), (0, 0)]
    up = jnp.pad(u, pad)
    return up[..., :-2, :] * w[0] + up[..., 1:-1, :] * w[1] + up[..., 2:, :] * w[2] + b


def _conv_branch(cb, cc, cv, w, b, grid):
    bsz, t, ch = cv.shape
    u = cc * cv
    if grid:
        rows = t // GRID_W
        u = u.reshape(bsz, rows, GRID_W, ch)
    y = _short_conv(u, w, b).reshape(bsz, t, ch)
    return cb * y


def _heads(a, dh):
    bsz, t, _ = a.shape
    return a.reshape(bsz, t, -1, dh).transpose(0, 2, 1, 3)


def _forget_terms(z, lb):
    zf = z.astype(jnp.float32)
    f = lb + (1.0 - lb) * jax.nn.sigmoid(zf)
    logf = jnp.log(jnp.maximum(f, F_MIN))
    k = (1.0 - lb) * jax.nn.sigmoid(-zf)
    return _heads(logf, HG_DK), _heads(k, HG_DK)


def _chunk_scan(q, k, v, logf, s0):
    bsz, nh, t, dk = q.shape
    n = t // CHUNK

    def to_chunks(a):
        return jnp.moveaxis(a.reshape(bsz, nh, n, CHUNK, a.shape[-1]), 2, 0)

    mask = jnp.tril(jnp.ones((CHUNK, CHUNK), dtype=bool))[:, :, None]

    def step(s, inp):
        qb, kb, vb, gb = inp
        bcum = jnp.cumsum(gb.astype(jnp.float32), axis=2)
        diff = bcum[:, :, :, None, :] - bcum[:, :, None, :, :]
        decay = jnp.where(mask, jnp.exp(jnp.where(mask, diff, 0.0)), 0.0)
        scores = jnp.einsum('bhtk,bhsk,bhtsk->bhts', qb, kb, decay)
        o = (jnp.einsum('bhts,bhsv->bhtv', scores, vb)
             + jnp.einsum('bhtk,bhkv->bhtv', qb * jnp.exp(bcum), s))
        blast = bcum[:, :, -1:, :]
        s_new = (jnp.exp(blast[:, :, 0, :])[..., None] * s
                 + jnp.einsum('bhsk,bhsv->bhkv', kb * jnp.exp(blast - bcum), vb))
        return s_new, o

    s_fin, oc = lax.scan(step, s0, (to_chunks(q), to_chunks(k), to_chunks(v), to_chunks(logf)))
    o = jnp.moveaxis(oc, 0, 2).reshape(bsz, nh, t, v.shape[-1])
    return o, s_fin


def _scan_dir(q, k, v, logf, s0, reverse):
    if reverse:
        q, k, v, logf = (jnp.flip(a, axis=2) for a in (q, k, v, logf))
    o, s = _chunk_scan(q, k, v, logf, s0)
    if reverse:
        o = jnp.flip(o, axis=2)
    return o, s


def _hgrn_readout(o, og, norm_g):
    o = o * lax.rsqrt(jnp.mean(jnp.square(o), axis=-1, keepdims=True) + EPS) * norm_g.astype(jnp.float32)
    bsz, nh, t, dv = o.shape
    o = o.transpose(0, 2, 1, 3).reshape(bsz, t, nh * dv)
    return (o * jax.nn.silu(og.astype(jnp.float32))).astype(og.dtype)


def _merge(ya, yb, ga, gb, w_pa, w_pb, w_o):
    m = jax.nn.sigmoid(ga) * (ya @ w_pa) + jax.nn.sigmoid(gb) * (yb @ w_pb)
    return m @ w_o


def _token_mixer(h, hc, w_in, conv_w, conv_b, lb, norm_g, w_pa, w_pb, w_o, ctx_out):
    cb, cc, cv, q, zf, zb, vi, og, ga, gb = _split_in(h @ w_in)
    ccb, ccc, ccv, qc, zfc, zbc, vic, ogc, gac, gbc = _split_in(hc @ w_in)
    qh = _heads(jax.nn.silu(q) * HG_DK ** -0.5, HG_DK)
    vh = _heads(vi, HG_DV)
    qhc = _heads(jax.nn.silu(qc) * HG_DK ** -0.5, HG_DK)
    vhc = _heads(vic, HG_DV)
    s0 = jnp.zeros((h.shape[0], HG_HEADS, HG_DK, HG_DV), jnp.float32)
    outs_lat, outs_ctx = [], []
    for d, (z_lat, z_ctx) in enumerate(((zf, zfc), (zb, zbc))):
        rev = d == 1
        logf_c, k_c = _forget_terms(z_ctx, lb[d])
        o_c, s_c = _scan_dir(qhc, k_c, vhc, logf_c, s0, rev)
        logf_l, k_l = _forget_terms(z_lat, lb[d])
        o_l, _ = _scan_dir(qh, k_l, vh, logf_l, s_c, rev)
        outs_lat.append(o_l)
        outs_ctx.append(o_c)
    y_b = _hgrn_readout(outs_lat[0] + outs_lat[1], og, norm_g)
    y_a = _conv_branch(cb, cc, cv, conv_w, conv_b, grid=True)
    y = _merge(y_a, y_b, ga, gb, w_pa, w_pb, w_o)
    if not ctx_out:
        return y, None
    y_bc = _hgrn_readout(outs_ctx[0] + outs_ctx[1], ogc, norm_g)
    y_ac = _conv_branch(ccb, ccc, ccv, conv_w, conv_b, grid=False)
    yc = _merge(y_ac, y_bc, gac, gbc, w_pa, w_pb, w_o)
    return y, yc


def _peer_route(xf, w_q, keys):
    n = xf.shape[0]
    q = (xf @ w_q).reshape(n, PEER_HEADS, 2, D_QUERY // 2)
    s = jnp.einsum('nhpd,hpkd->nhpk', q, keys).astype(jnp.float32)
    sv, si = lax.top_k(s, TOPK_HALF)
    cand = sv[:, :, 0, :, None] + sv[:, :, 1, None, :]
    cand_idx = si[:, :, 0, :, None] * N_KEYS + si[:, :, 1, None, :]
    top_v, top_pos = lax.top_k(cand.reshape(n, PEER_HEADS, TOPK_HALF * TOPK_HALF), TOPK)
    idx = jnp.take_along_axis(cand_idx.reshape(n, PEER_HEADS, TOPK_HALF * TOPK_HALF), top_pos, axis=-1)
    g = jax.nn.softmax(top_v, axis=-1)
    return idx.reshape(n, PEER_HEADS * TOPK), g.reshape(n, PEER_HEADS * TOPK)


def _peer_ffn(x, w_q, keys, u, v):
    shape = x.shape
    xf = x.reshape(-1, D_MODEL)
    idx, g = _peer_route(xf, w_q, keys)
    nb = xf.shape[0] // PEER_BLOCK

    def block(args):
        xb, ib, gb = args
        ue = u[ib]
        act = jax.nn.gelu(jnp.einsum('nd,nkd->nk', xb, ue).astype(jnp.float32), approximate=False)
        return jnp.einsum('nk,nkd->nd', (gb * act).astype(xb.dtype), v[ib])

    out = lax.map(block, (xf.reshape(nb, PEER_BLOCK, D_MODEL),
                          idx.reshape(nb, PEER_BLOCK, -1),
                          g.reshape(nb, PEER_BLOCK, -1)))
    return out.reshape(shape)


def setup_inputs(seed: int = 0) -> dict:
    key = jax.random.key(seed)
    ks = jax.random.split(key, 22)
    D = D_MODEL

    def nrm(k, shape, s):
        return jax.random.normal(k, shape, jnp.float32) * s

    return {
        'x': nrm(ks[0], (BATCH, SEQ, D), 1.0),
        'c': nrm(ks[1], (BATCH, D), 1.0),
        'ctx': nrm(ks[2], (BATCH, CTX_LEN, D), 1.0),
        'c_ctx': nrm(ks[3], (D,), 1.0),
        'w_mod': nrm(ks[4], (DEPTH, D, 6 * D), 0.5 * D ** -0.5),
        'b_mod': nrm(ks[5], (DEPTH, 6 * D), 0.01),
        'w_in': nrm(ks[6], (DEPTH, D, IN_WIDTH), D ** -0.5),
        'conv_w': nrm(ks[7], (DEPTH, CONV_W, D_CONV), CONV_W ** -0.5),
        'conv_b': nrm(ks[8], (DEPTH, D_CONV), 0.01),
        'lb_raw': 1.0 + nrm(ks[9], (DEPTH, 2, D_F), 0.1),
        'hg_norm_g': 1.0 + nrm(ks[10], (DEPTH, HG_DV), 0.02),
        'w_pa': nrm(ks[11], (DEPTH, D_CONV, D), BETA * D_CONV ** -0.5),
        'w_pb': nrm(ks[12], (DEPTH, D_V, D), BETA * D_V ** -0.5),
        'w_o': nrm(ks[13], (DEPTH, D, D), BETA * D ** -0.5),
        'ln1_g': 1.0 + nrm(ks[14], (DEPTH, D), 0.02),
        'ln1_b': nrm(ks[15], (DEPTH, D), 0.01),
        'peer_wq': nrm(ks[16], (DEPTH, D, PEER_HEADS * D_QUERY), D ** -0.5),
        'peer_keys': nrm(ks[17], (DEPTH, PEER_HEADS, 2, N_KEYS, D_QUERY // 2), (D_QUERY // 2) ** -0.5),
        'peer_u': nrm(ks[18], (DEPTH, N_EXPERTS, D), D ** -0.5),
        'peer_v': nrm(ks[19], (DEPTH, N_EXPERTS, D), BETA * PEER_HEADS ** -0.5),
        'ln2_g': 1.0 + nrm(ks[20], (DEPTH, D), 0.02),
        'ln2_b': nrm(ks[21], (DEPTH, D), 0.01),
    }


def reference(x, c, ctx, c_ctx, w_mod, b_mod, w_in, conv_w, conv_b, lb_raw, hg_norm_g,
              w_pa, w_pb, w_o, ln1_g, ln1_b, peer_wq, peer_keys, peer_u, peer_v, ln2_g, ln2_b):
    p = jax.nn.softmax(lb_raw.astype(jnp.float32), axis=0)
    lower_bounds = jnp.cumsum(p, axis=0) - p[:1]
    sc = jax.nn.silu(c)
    scc = jax.nn.silu(c_ctx)
    for l in range(DEPTH):
        last = l == DEPTH - 1
        mod = (sc @ w_mod[l] + b_mod[l])[:, None, :]
        mod_c = scc @ w_mod[l] + b_mod[l]
        sh1, s1, g1, sh2, s2, g2 = jnp.split(mod, 6, axis=-1)
        csh1, cs1, cg1, csh2, cs2, cg2 = jnp.split(mod_c, 6, axis=-1)
        y, yc = _token_mixer(_modulate(x, sh1, s1), _modulate(ctx, csh1, cs1), w_in[l],
                             conv_w[l], conv_b[l], lower_bounds[l], hg_norm_g[l],
                             w_pa[l], w_pb[l], w_o[l], ctx_out=not last)
        x = _layer_norm(ALPHA * x + g1 * y, ln1_g[l], ln1_b[l])
        f = _peer_ffn(_modulate(x, sh2, s2), peer_wq[l], peer_keys[l], peer_u[l], peer_v[l])
        x = _layer_norm(ALPHA * x + g2 * f, ln2_g[l], ln2_b[l])
        if not last:
            ctx = _layer_norm(ALPHA * ctx + cg1 * yc, ln1_g[l], ln1_b[l])
            fc = _peer_ffn(_modulate(ctx, csh2, cs2), peer_wq[l], peer_keys[l], peer_u[l], peer_v[l])
            ctx = _layer_norm(ALPHA * ctx + cg2 * fc, ln2_g[l], ln2_b[l])
    return x
```

```cpp
#include <hip/hip_runtime.h>
#include <stdint.h>
#include <stdio.h>

#define MK_N_LAUNCHES 1
namespace pg8 {
#define PG8_LAS __attribute__((address_space(3)))
typedef unsigned short bf16_t;
typedef short bf16x8 __attribute__((ext_vector_type(8)));
typedef float f32x4 __attribute__((ext_vector_type(4)));
typedef unsigned u32x4 __attribute__((ext_vector_type(4)));
constexpr int BM = 256, BK = 64, HALF = 128, HTB = HALF * BK * 2  , STAGE_BYTES = 8 * HTB, NXCD = 8, WGM = 8;

__host__ __device__ __forceinline__ int lds_byte(int r, int c) { const int st = (r >> 4) * 2 + (c >> 5), rr = r & 15, cc = c & 31, ob = rr * 64 + cc * 2; return st * 1024 + (ob ^ (((ob >> 9) & 1) << 5)); }
__host__ __device__ __forceinline__ void stage_rc(int b, int& R, int& C) { const int st = b / 1024, sb = b % 1024, swz = sb ^ (((sb >> 9) & 1) << 5); R = (st >> 1) * 16 + swz / 64; C = (st & 1) * 32 + (swz % 64) / 2; }
__host__ __device__ __forceinline__ int perm32(int rho) { const int n = rho >> 4, i = rho & 15; return 8 * (i >> 2) + 4 * n + (i & 3); }

struct Unit { int pm, pn; };
struct Gemm { const bf16_t* A; const bf16_t* Bt; int M, N, K, lda; };

struct StaticOrder {
    int nM, nN, nwg, G, c;
    __host__ __device__ void init(int M, int N, int G_, int c_) { nM = M / BM; nN = N / BM; nwg = nM * nN; G = G_; c = c_; }
    __host__ __device__ bool next(int i, Unit& u) const {
        const long L = (long)i * G + c; if (L >= nwg) return false;
        int wgid = (int)L; { const int q = nwg / NXCD, r = nwg % NXCD, xcd = wgid % NXCD, off = wgid / NXCD; wgid = (xcd < r ? xcd * (q + 1) : r * (q + 1) + (xcd - r) * q) + off; }
        const int nig = WGM * nN, gid = wgid / nig, fm = gid * WGM, gsz = (nM - fm) < WGM ? (nM - fm) : WGM;
        u.pm = fm + ((wgid % nig) % gsz); u.pn = (wgid % nig) / gsz; return true;
    }
    __device__ __forceinline__ void a_ready(const Unit&) const {}
    __device__ __forceinline__ void done(const Unit&) const {}
};

__device__ __forceinline__ unsigned cvt_pk_bf16(float lo, float hi) { unsigned r; asm volatile("v_cvt_pk_bf16_f32 %0, %1, %2" : "=v"(r) : "v"(lo), "v"(hi)); return r; }
typedef float f32x2 __attribute__((ext_vector_type(2)));
typedef int i32x4 __attribute__((ext_vector_type(4)));
typedef int i32x8 __attribute__((ext_vector_type(8)));
__device__ __forceinline__ i32x8 cat8(bf16x8 lo, bf16x8 hi) { const i32x4 a = __builtin_bit_cast(i32x4, lo), b = __builtin_bit_cast(i32x4, hi); return __builtin_shufflevector(a, b, 0, 1, 2, 3, 4, 5, 6, 7); }
template <class Epi, class Sched, bool ALIGN_EPI = false, bool SP2 = false, bool F8 = false>
__device__ __forceinline__ void gemm_phase(PG8_LAS unsigned char* lds, const Gemm g, const Sched& S, const Epi& E, int wv) {
    int tid_ = wv * 64 + (int)__builtin_amdgcn_mbcnt_hi(~0u, __builtin_amdgcn_mbcnt_lo(~0u, 0u)); asm volatile("" : "+v"(tid_));
    const int tid = tid_, wid = __builtin_amdgcn_readfirstlane(tid >> 6), lane = tid & 63, wr = wid >> 2, wc = wid & 3, fr = lane & 15, fq = lane >> 4;
    const int K = g.K, nt = K / BK;
    unsigned voffA[2], voffB[2];
#pragma unroll
    for (int i = 0; i < 2; ++i) { int R, C; stage_rc(tid * 16 + i * 8192, R, C); const int Rb = Epi::PERM ? ((R & ~31) + perm32(R & 31)) : R;
        voffA[i] = (unsigned)(R * g.lda + C) * 2u; voffB[i] = (unsigned)(Rb * K + C) * 2u; }
    const size_t kstep = (size_t)(BK * 2);
    const size_t hstepA = (size_t)HALF * g.lda * 2, hstepB = (size_t)HALF * K * 2;
    const size_t tstepA = 2 * hstepA, tstepB = 2 * hstepB;
    const unsigned ldsw = (unsigned)wid * 1024u;
    const int aoff = lds_byte(wr * 64 + fr, fq * 8), boff = SP2 ? lds_byte((wc & 1) * 64 + fr, fq * 8) : lds_byte(wc * 32 + fr, fq * 8); const int hw = wc >> 1;
#define PG8_SA(b, h) (((b) * 2 + (h)) * HTB)
#define PG8_SB(b, h) ((4 + (b) * 2 + (h)) * HTB)
#define PG8_STAGE(bufoff, gbase, voff) do { _Pragma("unroll") for (int _i = 0; _i < 2; ++_i) \
        __builtin_amdgcn_global_load_lds((const unsigned*)((const char*)(gbase) + (voff)[_i]), (PG8_LAS unsigned*)(lds + (bufoff) + ldsw + _i * 8192), 16, 0, 0); } while (0)
#define PG8_LDA(dst, b, h) do { _Pragma("unroll") for (int m = 0; m < 4; ++m) _Pragma("unroll") for (int k = 0; k < 2; ++k) dst[m][k] = *(const PG8_LAS bf16x8*)(lds + PG8_SA(b, h) + aoff + m * 2048 + k * 1024); } while (0)
#define PG8_LDB(dst, b, h) do { _Pragma("unroll") for (int n = 0; n < 2; ++n) _Pragma("unroll") for (int k = 0; k < 2; ++k) dst[n][k] = *(const PG8_LAS bf16x8*)(lds + (SP2 ? PG8_SB(b, hw) + (h) * 4096 : PG8_SB(b, h)) + boff + n * 2048 + k * 1024); } while (0)
#define PG8_MMA(ai, bj, At, Bt) do { __builtin_amdgcn_s_setprio(1); _Pragma("unroll") for (int m = 0; m < 4; ++m) _Pragma("unroll") for (int n = 0; n < 2; ++n) { \
        if constexpr (F8) { const i32x8 _b = cat8(Bt[n][0], Bt[n][1]), _a = cat8(At[m][0], At[m][1]); asm volatile("v_mfma_f32_16x16x128_f8f6f4 %0, %1, %2, %0" : "+v"(acc[ai][bj][m][n]) : "v"(_b), "v"(_a)); } \
        else { _Pragma("unroll") for (int k = 0; k < 2; ++k) acc[ai][bj][m][n] = __builtin_amdgcn_mfma_f32_16x16x32_bf16(Bt[n][k], At[m][k], acc[ai][bj][m][n], 0, 0, 0); } } \
        __builtin_amdgcn_s_setprio(0); } while (0)
#define PG8_WAIT_V(n) asm volatile("s_waitcnt vmcnt(" #n ")" ::: "memory")
#define PG8_WAIT_L(n) asm volatile("s_waitcnt lgkmcnt(" #n ")" ::: "memory")
#define PG8_BAR __builtin_amdgcn_s_barrier()
#define PG8_SCHED __builtin_amdgcn_sched_barrier(0)
    Unit cur, nxt; int ui = 0;
    if (!S.next(0, cur)) return;
    f32x4 acc[2][2][4][2];
#pragma unroll
    for (int a = 0; a < 2; ++a)
#pragma unroll
        for (int b = 0; b < 2; ++b)
#pragma unroll
            for (int m = 0; m < 4; ++m)
#pragma unroll
                for (int n = 0; n < 2; ++n) acc[a][b][m][n] = (f32x4){0.f, 0.f, 0.f, 0.f};
    bf16x8 At[4][2], B0[2][2], B1[2][2];
    const char* cA = (const char*)g.A + (size_t)cur.pm * tstepA; const char* cB = (const char*)g.Bt + (size_t)cur.pn * tstepB;
    S.a_ready(cur);
    if constexpr (SP2) {
        PG8_STAGE(PG8_SB(0, 0), cB, voffB); PG8_STAGE(PG8_SB(0, 1), cB + hstepB, voffB); PG8_STAGE(PG8_SA(0, 0), cA, voffA); PG8_STAGE(PG8_SA(0, 1), cA + hstepA, voffA);
        if (wr == 1) PG8_BAR;
        PG8_WAIT_V(2); PG8_BAR;
        PG8_STAGE(PG8_SB(1, 0), cB + kstep, voffB); PG8_STAGE(PG8_SA(1, 0), cA + kstep, voffA); PG8_STAGE(PG8_SB(1, 1), cB + hstepB + kstep, voffB);
        PG8_WAIT_V(6); PG8_BAR;
    } else {
        PG8_STAGE(PG8_SB(0, 0), cB, voffB); PG8_STAGE(PG8_SA(0, 0), cA, voffA); PG8_STAGE(PG8_SB(0, 1), cB + hstepB, voffB); PG8_STAGE(PG8_SA(0, 1), cA + hstepA, voffA);
        if (wr == 1) PG8_BAR;
        PG8_WAIT_V(4); PG8_BAR;
        PG8_STAGE(PG8_SB(1, 0), cB + kstep, voffB); PG8_STAGE(PG8_SA(1, 0), cA + kstep, voffA); PG8_STAGE(PG8_SB(1, 1), cB + hstepB + kstep, voffB);
        PG8_WAIT_V(6); PG8_BAR;
    }
    for (;;) {
        const bool has_next = S.next(ui + 1, nxt);
        const char* nA = has_next ? (const char*)g.A + (size_t)nxt.pm * tstepA : cA; const char* nB = has_next ? (const char*)g.Bt + (size_t)nxt.pn * tstepB : cB;
        for (int t = 0; t < nt; t += 2) {
            if constexpr (Epi::MIDK) { if (t == nt / 2) { if constexpr (F8) asm volatile("s_nop 15\n\ts_nop 15" ::: "memory"); E.mid(acc, cur, wr, wc, fr, fq); } }
            const bool last = (t == nt - 2);
            const char* a1 = cA + (size_t)(t + 1) * kstep;
            const char* a2 = last ? nA : cA + (size_t)(t + 2) * kstep; const char* b2 = last ? nB : cB + (size_t)(t + 2) * kstep;
            const char* a3 = a2 + kstep; const char* b3 = b2 + kstep;
            if (last && has_next) S.a_ready(nxt);
            if constexpr (SP2) {
            PG8_LDB(B0, 0, 0); PG8_LDB(B1, 0, 1); PG8_SCHED; PG8_LDA(At, 0, 0); PG8_STAGE(PG8_SA(1, 1), a1 + hstepA, voffA);
            PG8_WAIT_V(8); PG8_WAIT_L(0); PG8_BAR; PG8_MMA(0, 0, At, B0); PG8_MMA(0, 1, At, B1); PG8_BAR; PG8_SCHED;
            PG8_LDA(At, 0, 1); PG8_STAGE(PG8_SB(0, 0), b2, voffB); PG8_STAGE(PG8_SB(0, 1), b2 + hstepB, voffB); PG8_STAGE(PG8_SA(0, 0), a2, voffA);
            PG8_WAIT_V(8); PG8_WAIT_L(0); PG8_BAR; PG8_MMA(1, 0, At, B0); PG8_MMA(1, 1, At, B1); PG8_BAR; PG8_SCHED;
            PG8_LDB(B0, 1, 0); PG8_LDB(B1, 1, 1); PG8_SCHED; PG8_LDA(At, 1, 0); PG8_STAGE(PG8_SA(0, 1), a2 + hstepA, voffA);
            PG8_WAIT_V(8); PG8_WAIT_L(0); PG8_BAR; PG8_MMA(0, 0, At, B0); PG8_MMA(0, 1, At, B1); PG8_BAR; PG8_SCHED;
            PG8_LDA(At, 1, 1); PG8_STAGE(PG8_SB(1, 0), b3, voffB); PG8_STAGE(PG8_SB(1, 1), b3 + hstepB, voffB); PG8_STAGE(PG8_SA(1, 0), a3, voffA);
            PG8_WAIT_V(8); PG8_WAIT_L(0); PG8_BAR; PG8_MMA(1, 0, At, B0); PG8_MMA(1, 1, At, B1); PG8_BAR; PG8_SCHED;
            } else {
            PG8_LDB(B0, 0, 0); PG8_SCHED; PG8_LDA(At, 0, 0); PG8_STAGE(PG8_SA(1, 1), a1 + hstepA, voffA);
            PG8_WAIT_L(8); PG8_BAR; PG8_WAIT_L(0); PG8_MMA(0, 0, At, B0); PG8_BAR; PG8_SCHED;
            PG8_LDB(B1, 0, 1); PG8_STAGE(PG8_SB(0, 0), b2, voffB);
            PG8_BAR; PG8_WAIT_L(0); PG8_MMA(0, 1, At, B1); PG8_BAR;
            PG8_LDA(At, 0, 1); PG8_STAGE(PG8_SA(0, 0), a2, voffA);
            PG8_BAR; PG8_WAIT_L(0); PG8_MMA(1, 0, At, B0); PG8_BAR; PG8_SCHED;
            PG8_STAGE(PG8_SB(0, 1), b2 + hstepB, voffB);
            PG8_WAIT_V(6); PG8_BAR; PG8_MMA(1, 1, At, B1); PG8_BAR;
            PG8_LDB(B0, 1, 0); PG8_SCHED; PG8_LDA(At, 1, 0); PG8_STAGE(PG8_SA(0, 1), a2 + hstepA, voffA);
            PG8_WAIT_L(8); PG8_BAR; PG8_WAIT_L(0); PG8_MMA(0, 0, At, B0); PG8_BAR; PG8_SCHED;
            PG8_LDB(B1, 1, 1); PG8_STAGE(PG8_SB(1, 0), b3, voffB);
            PG8_BAR; PG8_WAIT_L(0); PG8_MMA(0, 1, At, B1); PG8_BAR;
            PG8_LDA(At, 1, 1); PG8_STAGE(PG8_SA(1, 0), a3, voffA);
            PG8_BAR; PG8_WAIT_L(0); PG8_MMA(1, 0, At, B0); PG8_BAR; PG8_SCHED;
            PG8_STAGE(PG8_SB(1, 1), b3 + hstepB, voffB);
            PG8_WAIT_V(6); PG8_BAR; PG8_MMA(1, 1, At, B1); PG8_BAR;
            }
        }
        if constexpr (F8) asm volatile("s_nop 15\n\ts_nop 15" ::: "memory");
        if constexpr (ALIGN_EPI) { if (wr == 0) PG8_BAR; }
        if constexpr (!Epi::AFTER_DRAIN) { E(acc, cur, wr, wc, fr, fq); S.done(cur); }
        if (!has_next) break;
#pragma unroll
        for (int a = 0; a < 2; ++a)
#pragma unroll
            for (int b = 0; b < 2; ++b)
#pragma unroll
                for (int m = 0; m < 4; ++m)
#pragma unroll
                    for (int n = 0; n < 2; ++n) acc[a][b][m][n] = (f32x4){0.f, 0.f, 0.f, 0.f};
        cur = nxt; cA = nA; cB = nB; ++ui;
        if constexpr (ALIGN_EPI) { if (wr == 1) PG8_BAR; }
    }
    PG8_WAIT_V(0);
    if constexpr (!ALIGN_EPI) { if (wr == 0) PG8_BAR; }
    PG8_BAR;
    if constexpr (Epi::AFTER_DRAIN) { E.fused(acc, cur, wr, wc, fr, fq, lds, wid, lane); S.done(cur); }
#undef PG8_SA
#undef PG8_SB
#undef PG8_STAGE
#undef PG8_LDA
#undef PG8_LDB
#undef PG8_MMA
#undef PG8_WAIT_V
#undef PG8_WAIT_L
#undef PG8_BAR
#undef PG8_SCHED
}
}


#define LAS __attribute__((address_space(3)))
#define XB_TMO      128
#define XB_XCNT(j)  (256  + 64 * (j))
#define XB_XSUB(j)  (1280 + 64 * (j))
#define XB_XGEN(j)  (2304 + 64 * (j))
#define XB_TOP      3328
#define XB_TOPGEN   3392
#define XCD_BAR_WORDS 3456
#define XB_SPIN_CAP (1u << 20)

__device__ __forceinline__ unsigned xb_ld(unsigned* p)              { return __hip_atomic_load(p, __ATOMIC_RELAXED, __HIP_MEMORY_SCOPE_AGENT); }
__device__ __forceinline__ unsigned xb_add(unsigned* p, unsigned v) { return __hip_atomic_fetch_add(p, v, __ATOMIC_RELAXED, __HIP_MEMORY_SCOPE_AGENT); }
__device__ __forceinline__ unsigned xb_xcc_id() { return (unsigned)__builtin_amdgcn_s_getreg((3 << 11) | 20) & 0xFu; }
#define XB_SPIN(cond, bar) do { unsigned _sp = 0; while (cond) { __builtin_amdgcn_s_sleep(1); \
    if ((++_sp & 255u) == 0u) { if (xb_ld(&(bar)[XB_TMO])) break; if (_sp > XB_SPIN_CAP) { atomicAdd(&(bar)[XB_TMO], 1u); break; } } } } while (0)

struct XcdBarrier {
    unsigned* bar; unsigned x; int wv;
    volatile LAS unsigned* st;
};

__device__ __forceinline__ XcdBarrier xcd_barrier_post(unsigned* bar, volatile LAS unsigned* st, int wv) {
    XcdBarrier b; b.bar = bar; b.x = xb_xcc_id(); b.st = st; b.wv = wv;
    if (threadIdx.x == 0) (void)xb_add(&bar[XB_XCNT(b.x)], 1u);
    return b;
}
__device__ __forceinline__ void xcd_barrier_complete(unsigned* bar, unsigned x, unsigned& nloc, unsigned& nx) {
    const unsigned G = gridDim.x * gridDim.y * gridDim.z;
    unsigned sum, cnt, mine, sp = 0u;
    for (;;) {
        sum = 0u; cnt = 0u; mine = 0u;
#pragma unroll
        for (unsigned j = 0; j < 16; ++j) { const unsigned c = xb_ld(&bar[XB_XCNT(j)]); sum += c; cnt += (c > 0u) ? 1u : 0u; mine = (j == x) ? c : mine; }
        if (sum == G) break;
        __builtin_amdgcn_s_sleep(1);
        if ((++sp & 255u) == 0u) { if (xb_ld(&bar[XB_TMO])) break; if (sp > XB_SPIN_CAP) { atomicAdd(&bar[XB_TMO], 1u); break; } }
    }
    nloc = mine > 0u ? mine : 1u; nx = cnt > 0u ? cnt : 1u;
}

__device__ __forceinline__ void xcd_barrier(const XcdBarrier& b) {
    asm volatile("s_waitcnt vmcnt(0)" ::: "memory");
    __syncthreads();
    unsigned xb_z = 0u; asm volatile("" : "+v"(xb_z));
    if (b.wv == 0 && __builtin_amdgcn_mbcnt_hi(~0u, __builtin_amdgcn_mbcnt_lo(~0u, xb_z)) == 0u) {
        unsigned* bar = b.bar;
        __builtin_amdgcn_s_waitcnt(0);
        unsigned nloc = b.st[0], nx = b.st[1];
        if (nloc == 0u) { xcd_barrier_complete(bar, b.x, nloc, nx); b.st[0] = nloc; b.st[1] = nx; }
        const unsigned old = xb_add(&bar[XB_XSUB(b.x)], 1u);
        const unsigned gen = old / nloc;
        if (old + 1u == (gen + 1u) * nloc) {
            __builtin_amdgcn_fence(__ATOMIC_RELEASE, "agent");
            asm volatile("s_waitcnt vmcnt(0)" ::: "memory");
            const unsigned og = xb_add(&bar[XB_TOP], 1u);
            const unsigned tg = og / nx;
            if (og + 1u == (tg + 1u) * nx) xb_add(&bar[XB_TOPGEN], 1u);
            else XB_SPIN(xb_ld(&bar[XB_TOPGEN]) == tg, bar);
            __builtin_amdgcn_fence(__ATOMIC_ACQUIRE, "agent");
            xb_add(&bar[XB_XGEN(b.x)], 1u);
            asm volatile("s_waitcnt vmcnt(0)" ::: "memory");
        } else {
            XB_SPIN(xb_ld(&bar[XB_XGEN(b.x)]) == gen, bar);
            __builtin_amdgcn_fence(__ATOMIC_ACQUIRE, "agent");
            asm volatile("s_waitcnt vmcnt(0)" ::: "memory");
        }
    }
    __syncthreads();
}

constexpr int D = 2048, NBATCH = 8, SEQ = 2048, CTXL = 256, DEPTH = 2;
constexpr int NLAT = NBATCH * SEQ, NCTX = NBATCH * CTXL, NTOK = NLAT + NCTX;
constexpr int INW = 12288, MODW = 6 * D, DC = 1024, NH = 8, DK = 128, NEXP = 16384;
constexpr int C_CB = 0, C_CC = 1024, C_CV = 2048, C_Q = 3072, C_ZF = 4096, C_ZB = 5120, C_VI = 6144, C_OG = 7168, C_GA = 8192, C_GB = 10240;
constexpr int C_YA = 3072, C_YB = 4096;
constexpr float ALPHA = 1.41421356237309515f, LN_EPS = 1e-6f, F_MIN = 1e-30f, QSCALE = 0.08838834764831845f;
constexpr int NWAVES = 8, NTHREADS = 512;
enum { I_X = 0, I_C, I_CTX, I_CCTX, I_WMOD, I_BMOD, I_WIN, I_CONVW, I_CONVB, I_LBRAW, I_HGG, I_WPA, I_WPB, I_WO, I_LN1G, I_LN1B, I_WQ, I_KEYS, I_PU, I_PV, I_LN2G, I_LN2B, N_IN };

constexpr size_t MiB = 1u << 20;
constexpr size_t WS_CTL = 0, CTL_ZERO_BYTES = 1 * MiB;
constexpr size_t WS_MOD = 1 * MiB;
constexpr size_t WS_WIN = 2 * MiB;
constexpr size_t WS_WPA = 50 * MiB, WS_WPB = 54 * MiB;
constexpr size_t WS_WO = 58 * MiB, WS_WQ = 66 * MiB;
constexpr size_t WS_KEYS = 74 * MiB;
constexpr size_t WS_U = 76 * MiB, WS_V = 140 * MiB;
constexpr size_t WS_X = 204 * MiB;
constexpr size_t WS_H = 348 * MiB;
constexpr size_t WS_Y = 420 * MiB;
constexpr size_t WS_PROJ = 492 * MiB;
constexpr size_t WS_OSC = 924 * MiB;
constexpr size_t WS_END = 1068 * MiB;
static_assert(WS_PROJ + (size_t)NTOK * INW * 2 <= WS_OSC && WS_OSC + (size_t)2 * NTOK * DC * 4 <= WS_END, "ws map");
constexpr size_t WS_ESCALE = 75 * MiB;
constexpr size_t WS_LBT = 75 * MiB + 131072;
constexpr int EROW = 1536;
constexpr int EREC = 3072;
typedef _Float16 v32h __attribute__((ext_vector_type(32)));
typedef float v32f __attribute__((ext_vector_type(32)));
typedef int v6i __attribute__((ext_vector_type(6)));
constexpr float SW8 = 2048.0f, SA8_M = 8.0f, SA8_H = 16.0f, SA8_Y = 8.0f;
constexpr size_t WS_H8 = 1086 * MiB;
constexpr size_t WS_WIN8 = WS_WIN + 8 * MiB;
constexpr int CW_BAR = 4096;

constexpr int RING_BYTES = 131072, LDSCTL_OFF = 135168, MISC_OFF = LDSCTL_OFF + 320, LDS_BYTES = 147456;

#define DI __device__ __forceinline__
typedef unsigned short bf16;
typedef unsigned u32x4 __attribute__((ext_vector_type(4)));
typedef unsigned u32x2 __attribute__((ext_vector_type(2)));
typedef float f32x4 __attribute__((ext_vector_type(4)));
constexpr int ESEG = 192;
constexpr size_t ESLICE = (size_t)16384 * ESEG;
__device__ __forceinline__ void eseg_store(unsigned char* tbl, int e, int lane, const v6i p) {
    unsigned char* d = tbl + (size_t)(lane >> 3) * ESLICE + (size_t)e * ESEG + (lane & 7) * 24;
    *(u32x2*)d = (u32x2){(unsigned)p[0], (unsigned)p[1]}; *(u32x2*)(d + 8) = (u32x2){(unsigned)p[2], (unsigned)p[3]}; *(u32x2*)(d + 16) = (u32x2){(unsigned)p[4], (unsigned)p[5]};
}

DI float bf_lo(unsigned w) { return __uint_as_float(w << 16); }
DI float bf_hi(unsigned w) { return __uint_as_float(w & 0xffff0000u); }
DI unsigned pk2(float lo, float hi) { unsigned r; asm("v_cvt_pk_bf16_f32 %0, %1, %2" : "=v"(r) : "v"(lo), "v"(hi)); return r; }
DI float clamp448(float x) { return fminf(fmaxf(x, -448.0f), 448.0f); }
DI unsigned pk4_fp8(float a, float b, float c, float d) { int w = 0; w = __builtin_amdgcn_cvt_pk_fp8_f32(clamp448(a), clamp448(b), w, false); w = __builtin_amdgcn_cvt_pk_fp8_f32(clamp448(c), clamp448(d), w, true); return (unsigned)w; }
DI void unpack8(const u32x4 w, float (&f)[8]) { f[0] = bf_lo(w.x); f[1] = bf_hi(w.x); f[2] = bf_lo(w.y); f[3] = bf_hi(w.y); f[4] = bf_lo(w.z); f[5] = bf_hi(w.z); f[6] = bf_lo(w.w); f[7] = bf_hi(w.w); }
DI u32x4 pack8(const float (&f)[8]) { u32x4 w; w.x = pk2(f[0], f[1]); w.y = pk2(f[2], f[3]); w.z = pk2(f[4], f[5]); w.w = pk2(f[6], f[7]); return w; }
DI float wave_sum(float v) {
#pragma unroll
    for (int o = 1; o < 64; o <<= 1) v += __shfl_xor(v, o);
    return v;
}
DI float frcp(float x) { return __builtin_amdgcn_rcpf(x); }
DI float sigm(float x) { return frcp(1.0f + __expf(-x)); }
DI float silu(float x) { return x * frcp(1.0f + __expf(-x)); }
DI float gelu_erf(float x) { return 0.5f * x * (1.0f + erff(x * 0.70710678118654752f)); }

extern __shared__ __attribute__((aligned(16))) unsigned char lds_raw[];
constexpr int PTR_OFF = MISC_OFF + 256;
DI unsigned long long ld_ptr(int i) {
    const unsigned long long v = ((volatile LAS unsigned long long*)((LAS unsigned char*)lds_raw + PTR_OFF))[i];
    const unsigned lo = __builtin_amdgcn_readfirstlane((unsigned)v), hi = __builtin_amdgcn_readfirstlane((unsigned)(v >> 32));
    return ((unsigned long long)hi << 32) | lo;
}
template <class T> DI T* as_global(unsigned long long v) {
    return (T*)(__attribute__((address_space(1))) T*)v; }
DI const float* inp(int i) { return as_global<const float>(ld_ptr(i)); }
struct Frame {
    LAS unsigned char* lds;
    int tid, lane, wave, G;
    float* out; unsigned char* ws;
    float* mod; bf16 *Win, *Wpa, *Wpb, *Wo, *Wq, *Keys, *U, *V; float* X; bf16 *H, *Y, *PROJ; float* OSC;
};
DI int lane_id() { unsigned z = 0u; asm volatile("" : "+v"(z)); return (int)__builtin_amdgcn_mbcnt_hi(~0u, __builtin_amdgcn_mbcnt_lo(~0u, z)); }
DI Frame mkframe(int wv) {
    Frame F; int ln = lane_id(); asm volatile("" : "+v"(ln)); asm volatile("" : "+s"(wv));
    F.lds = (LAS unsigned char*)lds_raw; F.tid = wv * 64 + ln; F.lane = ln; F.wave = wv; F.G = gridDim.x;
    F.out = as_global<float>(ld_ptr(N_IN)); unsigned char* ws = as_global<unsigned char>(ld_ptr(N_IN + 1)); F.ws = ws;
    F.mod = (float*)(ws + WS_MOD); F.Win = (bf16*)(ws + WS_WIN); F.Wpa = (bf16*)(ws + WS_WPA); F.Wpb = (bf16*)(ws + WS_WPB); F.Wo = (bf16*)(ws + WS_WO); F.Wq = (bf16*)(ws + WS_WQ);
    F.Keys = (bf16*)(ws + WS_KEYS); F.U = (bf16*)(ws + WS_U); F.V = (bf16*)(ws + WS_V); F.X = (float*)(ws + WS_X); F.H = (bf16*)(ws + WS_H); F.Y = (bf16*)(ws + WS_Y);
    F.PROJ = (bf16*)(ws + WS_PROJ); F.OSC = (float*)(ws + WS_OSC);
    return F;
}
DI const float* xrow(const float* xin, const float* cin, const float* X, int l, int r) {
    if (l == 0) return r < NLAT ? xin + (size_t)r * D : cin + (size_t)(r - NLAT) * D;
    return X + (size_t)r * D;
}
DI int modrow(int r) { return r < NLAT ? r / SEQ : 8; }
DI float lower_bound(const float* lbraw, int l, int d, int c) {
    if (l == 0) return 0.0f;
    const float a0 = lbraw[d * DC + c], a1 = lbraw[2 * DC + d * DC + c];
    return 1.0f / (1.0f + __expf(a0 - a1));
}

DI void transpose_item(const float* W, int K, int N, bf16* WT, LAS float* scr, int item, int lane, int ldw = 0, int koff = 0, bool f8 = false, int win_split = 0) {
    if (ldw == 0) ldw = K;
    const int nblk = N / 64, kb = item / nblk, nb = item % nblk, k0 = 64 * kb, n0 = 64 * nb;
    int drow = n0;
    if (win_split) { if (n0 >= C_ZF && n0 < C_VI) { drow = n0 - C_ZF; } else { f8 = true; drow = n0 < C_ZF ? n0 : n0 - (C_VI - C_ZF); WT = (bf16*)((unsigned char*)WT + (WS_WIN8 - WS_WIN)); } }
    const int n4 = (lane & 15) * 4;
#pragma unroll 8
    for (int i = 0; i < 16; ++i) { const int kk = 4 * i + (lane >> 4); const f32x4 v = __builtin_nontemporal_load((const f32x4*)(W + (size_t)(k0 + kk) * N + n0 + n4));
        LAS float* d = scr + kk * 65 + n4; d[0] = v.x; d[1] = v.y; d[2] = v.z; d[3] = v.w; }
    __builtin_amdgcn_fence(__ATOMIC_RELEASE, "wavefront"); asm volatile("s_waitcnt lgkmcnt(0)" ::: "memory");
    const int c = lane & 7;
#pragma unroll
    for (int j = 0; j < 8; ++j) { const int n = (lane >> 3) + 8 * j; const LAS float* s = scr + (8 * c) * 65 + n;
        if (f8) { u32x2 o; o.x = pk4_fp8(s[0 * 65] * SW8, s[1 * 65] * SW8, s[2 * 65] * SW8, s[3 * 65] * SW8); o.y = pk4_fp8(s[4 * 65] * SW8, s[5 * 65] * SW8, s[6 * 65] * SW8, s[7 * 65] * SW8);
            *(u32x2*)((unsigned char*)WT + (size_t)(drow + n) * ldw + koff + k0 + 8 * c) = o; }
        else { u32x4 o; o.x = pk2(s[0 * 65], s[1 * 65]); o.y = pk2(s[2 * 65], s[3 * 65]); o.z = pk2(s[4 * 65], s[5 * 65]); o.w = pk2(s[6 * 65], s[7 * 65]);
            *(u32x4*)(WT + (size_t)(drow + n) * ldw + koff + k0 + 8 * c) = o; } }
    asm volatile("s_waitcnt lgkmcnt(0)" ::: "memory");
}
DI void cvt_copy(const Frame& F, const float* src, bf16* dst, size_t n) {
    const size_t nthreads = (size_t)F.G * NTHREADS;
    for (size_t i = (size_t)blockIdx.x * NTHREADS + F.tid; i < n / 8; i += nthreads) {
        const f32x4 a = *(const f32x4*)(src + i * 8), b = *(const f32x4*)(src + i * 8 + 4);
        u32x4 o; o.x = pk2(a.x, a.y); o.y = pk2(a.z, a.w); o.z = pk2(b.x, b.y); o.w = pk2(b.z, b.w);
        *(u32x4*)(dst + i * 8) = o;
    }
}
DI void phase_convert(int l, int wv, bool tables) {
    const Frame F = mkframe(wv);
    LAS float* scr = (LAS float*)(F.lds + F.wave * 16640);
    const int gw = blockIdx.x * NWAVES + F.wave, NGW = F.G * NWAVES;
    constexpr int IT_IN = (D / 64) * (INW / 64), IT_PA = (DC / 64) * (D / 64), IT_O = (D / 64) * (D / 64);
    constexpr int NITEMS = IT_IN + 2 * IT_PA + 2 * IT_O;
    for (int it = gw; it < NITEMS; it += NGW) {
        int r = it;
        if (r < IT_IN) { transpose_item(inp(I_WIN) + (size_t)l * D * INW, D, INW, F.Win, scr, r, F.lane, D, 0, false, 1); continue; } r -= IT_IN;
        if (r < IT_PA) { transpose_item(inp(I_WPA) + (size_t)l * DC * D, DC, D, F.Wpa, scr, r, F.lane, D, 0, true); continue; } r -= IT_PA;
        if (r < IT_PA) { transpose_item(inp(I_WPB) + (size_t)l * DC * D, DC, D, F.Wpa, scr, r, F.lane, D, DC, true); continue; } r -= IT_PA;
        if (r < IT_O)  { transpose_item(inp(I_WO) + (size_t)l * D * D, D, D, F.Wo, scr, r, F.lane, D, 0, true); continue; } r -= IT_O;
        transpose_item(inp(I_WQ) + (size_t)l * D * D, D, D, F.Wq, scr, r, F.lane);
    }
    cvt_copy(F, inp(I_KEYS) + (size_t)l * NH * 2 * 128 * 128, F.Keys, (size_t)NH * 2 * 128 * 128);
    if (blockIdx.x == 0) { const float* lbraw = inp(I_LBRAW); float* lbt = (float*)(F.ws + WS_LBT);
        for (int i = F.tid; i < 2 * DC; i += NTHREADS) lbt[i] = lower_bound(lbraw, l, i / DC, i % DC); }
    { const float* pu = inp(I_PU) + (size_t)l * NEXP * D; const float* pv = inp(I_PV) + (size_t)l * NEXP * D;
      unsigned char* U6 = (unsigned char*)F.U; unsigned char* V6 = (unsigned char*)F.V; float* SU = (float*)(F.ws + WS_ESCALE); float* SV = SU + NEXP;
      if (tables) for (int it = gw; it < 2 * NEXP; it += NGW) {
          const int e = it >> 1; const float* src = ((it & 1) ? pv : pu) + (size_t)e * D; unsigned char* dst = (it & 1) ? V6 : U6;
          f32x4 x[8]; float am = 0.f;
#pragma unroll
          for (int c = 0; c < 8; ++c) { x[c] = __builtin_nontemporal_load((const f32x4*)(src + c * 256 + F.lane * 4));
              am = fmaxf(am, fmaxf(fmaxf(fabsf(x[c].x), fabsf(x[c].y)), fmaxf(fabsf(x[c].z), fabsf(x[c].w)))); }
#pragma unroll
          for (int o = 1; o < 64; o <<= 1) am = fmaxf(am, __shfl_xor(am, o));
          const float inv = am > 0.f ? 7.0f / am : 0.f, sc = am > 0.f ? am * (1.0f / 7.0f) : 0.f;
          v32h hx;
#pragma unroll
          for (int c = 0; c < 8; ++c) { hx[c * 4 + 0] = (_Float16)(x[c].x * inv); hx[c * 4 + 1] = (_Float16)(x[c].y * inv); hx[c * 4 + 2] = (_Float16)(x[c].z * inv); hx[c * 4 + 3] = (_Float16)(x[c].w * inv); }
          const v6i p = __builtin_amdgcn_cvt_scalef32_pk32_fp6_f16(hx, 1.0f);
          eseg_store(dst, e, F.lane, p);
          if (F.lane == 0) ((it & 1) ? SV : SU)[e] = sc;
      } }
}
DI void phase_mod(int wv) {
    const Frame F = mkframe(wv);
    LAS float* sv = (LAS float*)F.lds;
    LAS float* red = (LAS float*)(F.lds + 73728);
    constexpr int NITEM = 2 * (MODW / 64);
    if ((int)blockIdx.x >= NITEM) return;
    __syncthreads();
    const float* cvec = inp(I_C); const float* cctx = inp(I_CCTX); const float* wmod = inp(I_WMOD); const float* bmod = inp(I_BMOD);
    for (int i = F.tid; i < 9 * D; i += NTHREADS) { const int r = i / D, k = i % D; const float c = r < 8 ? cvec[r * D + k] : cctx[k]; sv[i] = silu(c); }
    __syncthreads();
    for (int item = blockIdx.x; item < NITEM; item += F.G) {
        const int l = item / (MODW / 64), nb = item % (MODW / 64);
        const float* W = wmod + (size_t)l * D * MODW + nb * 64 + F.lane;
        float acc[9];
#pragma unroll
        for (int r = 0; r < 9; ++r) acc[r] = 0.f;
#pragma unroll 8
        for (int kk = 0; kk < 256; ++kk) { const int k = F.wave * 256 + kk; const float w = __builtin_nontemporal_load(W + (size_t)k * MODW);
#pragma unroll
            for (int r = 0; r < 9; ++r) acc[r] += sv[r * D + k] * w; }
#pragma unroll
        for (int r = 0; r < 9; ++r) red[(F.wave * 9 + r) * 64 + F.lane] = acc[r];
        __syncthreads();
        for (int idx = F.tid; idx < 9 * 64; idx += NTHREADS) { const int r = idx / 64, nn = idx % 64; float s = bmod[l * MODW + nb * 64 + nn];
#pragma unroll
            for (int w = 0; w < 8; ++w) s += red[(w * 9 + r) * 64 + nn];
            F.mod[((size_t)l * 9 + r) * MODW + nb * 64 + nn] = s; }
        __syncthreads();
    }
}

DI void load_row_f32(const float* src, int lane, float (&v)[32]) {
#pragma unroll
    for (int c = 0; c < 4; ++c) { const f32x4 a = *(const f32x4*)(src + c * 512 + lane * 8), b = *(const f32x4*)(src + c * 512 + lane * 8 + 4);
        v[c * 8 + 0] = a.x; v[c * 8 + 1] = a.y; v[c * 8 + 2] = a.z; v[c * 8 + 3] = a.w; v[c * 8 + 4] = b.x; v[c * 8 + 5] = b.y; v[c * 8 + 6] = b.z; v[c * 8 + 7] = b.w; }
}
DI void store_row_f32(float* dst, int lane, const float (&v)[32]) {
#pragma unroll
    for (int c = 0; c < 4; ++c) { *(f32x4*)(dst + c * 512 + lane * 8) = (f32x4){v[c * 8 + 0], v[c * 8 + 1], v[c * 8 + 2], v[c * 8 + 3]};
        *(f32x4*)(dst + c * 512 + lane * 8 + 4) = (f32x4){v[c * 8 + 4], v[c * 8 + 5], v[c * 8 + 6], v[c * 8 + 7]}; }
}
DI void load_row_bf16(const bf16* src, int lane, float (&v)[32]) {
#pragma unroll
    for (int c = 0; c < 4; ++c) { const u32x4 w = *(const u32x4*)(src + c * 512 + lane * 8);
        v[c * 8 + 0] = bf_lo(w.x); v[c * 8 + 1] = bf_hi(w.x); v[c * 8 + 2] = bf_lo(w.y); v[c * 8 + 3] = bf_hi(w.y); v[c * 8 + 4] = bf_lo(w.z); v[c * 8 + 5] = bf_hi(w.z); v[c * 8 + 6] = bf_lo(w.w); v[c * 8 + 7] = bf_hi(w.w); }
}
DI void store_row_bf16(bf16* dst, int lane, const float (&v)[32]) {
#pragma unroll
    for (int c = 0; c < 4; ++c) { u32x4 w; w.x = pk2(v[c * 8 + 0], v[c * 8 + 1]); w.y = pk2(v[c * 8 + 2], v[c * 8 + 3]); w.z = pk2(v[c * 8 + 4], v[c * 8 + 5]); w.w = pk2(v[c * 8 + 6], v[c * 8 + 7]);
        *(u32x4*)(dst + c * 512 + lane * 8) = w; }
}
DI void row_normalize(float (&v)[32]) {
    float s = 0.f;
#pragma unroll
    for (int i = 0; i < 32; ++i) s += v[i];
    const float mean = wave_sum(s) * (1.0f / D);
    float q = 0.f;
#pragma unroll
    for (int i = 0; i < 32; ++i) { v[i] -= mean; q += v[i] * v[i]; }
    const float rstd = rsqrtf(wave_sum(q) * (1.0f / D) + LN_EPS);
#pragma unroll
    for (int i = 0; i < 32; ++i) v[i] *= rstd;
}

DI void phase_modulate1(int l, int wv) {
    const Frame F = mkframe(wv);
    const float* xin = inp(I_X); const float* cin = inp(I_CTX);
    const int gw = blockIdx.x * NWAVES + F.wave, NGW = F.G * NWAVES;
    for (int r = gw; r < NTOK; r += NGW) {
        const float* md = F.mod + ((size_t)l * 9 + modrow(r)) * MODW;
        float v[32], sh[32], sc[32];
        load_row_f32(xrow(xin, cin, F.X, l, r), F.lane, v);
        load_row_f32(md + 0 * D, F.lane, sh); load_row_f32(md + 1 * D, F.lane, sc);
        row_normalize(v);
#pragma unroll
        for (int i = 0; i < 32; ++i) v[i] = v[i] * (1.0f + sc[i]) + sh[i];
        store_row_bf16(F.H + (size_t)r * D, F.lane, v);
        unsigned char* h8 = F.ws + WS_H8 + (size_t)r * D;
#pragma unroll
        for (int c = 0; c < 4; ++c) *(u32x2*)(h8 + c * 512 + F.lane * 8) = (u32x2){pk4_fp8(v[c * 8 + 0] * SA8_H, v[c * 8 + 1] * SA8_H, v[c * 8 + 2] * SA8_H, v[c * 8 + 3] * SA8_H), pk4_fp8(v[c * 8 + 4] * SA8_H, v[c * 8 + 5] * SA8_H, v[c * 8 + 6] * SA8_H, v[c * 8 + 7] * SA8_H)};
    }
}

struct EpiStore {
    static constexpr bool PERM = true, AFTER_DRAIN = false, MIDK = false;
    bf16* O; int ldc; float scale; int split_pn, shift;
    DI void operator()(const pg8::f32x4 (&acc)[2][2][4][2], const pg8::Unit& u, int wr, int wc, int fr, int fq) const {
        const int row0 = u.pm * 256 + wr * 64 + fr, col0 = u.pn * 256 + (u.pn >= split_pn ? shift : 0) + wc * 64 + 8 * fq;
#pragma unroll
        for (int ai = 0; ai < 2; ++ai)
#pragma unroll
            for (int m = 0; m < 4; ++m) { bf16* rowp = O + (size_t)(row0 + ai * 128 + m * 16) * ldc + col0;
#pragma unroll
                for (int bj = 0; bj < 2; ++bj) { const pg8::f32x4 v0 = acc[ai][bj][m][0] * scale, v1 = acc[ai][bj][m][1] * scale;
                    u32x4 w; w.x = pk2(v0[0], v0[1]); w.y = pk2(v0[2], v0[3]); w.z = pk2(v1[0], v1[1]); w.w = pk2(v1[2], v1[3]);
                    *(u32x4*)(rowp + bj * 32) = w; } }
    }
};
struct EpiMerge {
    static constexpr bool PERM = true, AFTER_DRAIN = false, MIDK = true;
    const bf16* Ga; const bf16* Gb; int ldg; bf16* O; int ldc;
    DI void mid(pg8::f32x4 (&acc)[2][2][4][2], const pg8::Unit& u, int wr, int wc, int fr, int fq) const {
        asm volatile("" : "+v"(fr), "+v"(fq));
        const int row0 = u.pm * 256 + wr * 64 + fr, col0 = u.pn * 256 + wc * 64 + 8 * fq;
#pragma unroll
        for (int ai = 0; ai < 2; ++ai)
#pragma unroll
            for (int m = 0; m < 4; ++m) { const size_t rr = (size_t)(row0 + ai * 128 + m * 16);
#pragma unroll
                for (int bj = 0; bj < 2; ++bj) { float ga[8], gb[8];
                    unpack8(*(const u32x4*)(Ga + rr * ldg + col0 + bj * 32), ga); unpack8(*(const u32x4*)(Gb + rr * ldg + col0 + bj * 32), gb);
#pragma unroll
                    for (int j = 0; j < 8; ++j) { const float ratio = (1.0f + __expf(-gb[j])) * frcp(1.0f + __expf(-ga[j])); acc[ai][bj][m][j >> 2][j & 3] *= ratio; } }
                asm volatile("" ::: "memory"); }
    }
    DI void operator()(const pg8::f32x4 (&acc)[2][2][4][2], const pg8::Unit& u, int wr, int wc, int fr, int fq) const {
        const int row0 = u.pm * 256 + wr * 64 + fr, col0 = u.pn * 256 + wc * 64 + 8 * fq;
#pragma unroll
        for (int ai = 0; ai < 2; ++ai)
#pragma unroll
            for (int m = 0; m < 4; ++m) { const size_t rr = (size_t)(row0 + ai * 128 + m * 16);
#pragma unroll
                for (int bj = 0; bj < 2; ++bj) { const pg8::f32x4 v0 = acc[ai][bj][m][0], v1 = acc[ai][bj][m][1];
                    const float a[8] = {v0[0], v0[1], v0[2], v0[3], v1[0], v1[1], v1[2], v1[3]}; float g[8], o[8];
                    unpack8(*(const u32x4*)(Gb + rr * ldg + col0 + bj * 32), g);
#pragma unroll
                    for (int j = 0; j < 8; ++j) o[j] = sigm(g[j]) * a[j] * (SA8_M / (SW8 * SA8_Y));
                    *(u32x2*)((unsigned char*)O + rr * ldc + col0 + bj * 32) = (u32x2){pk4_fp8(o[0], o[1], o[2], o[3]), pk4_fp8(o[4], o[5], o[6], o[7])}; } }
    }
};

typedef short bf16x8v __attribute__((ext_vector_type(8)));
typedef short s16x4v __attribute__((ext_vector_type(4)));
typedef float f32x16 __attribute__((ext_vector_type(16)));
DI unsigned short f2bf1(float x) { return (unsigned short)(pk2(x, 0.f) & 0xffffu); }
constexpr int C_QTF = C_CB, C_KTF = C_Q, C_QTB = C_ZF, C_KTB = C_ZB;
constexpr size_t WS_EV = 1068 * MiB;
DI float* ev_ptr(unsigned char* ws, int chunk, int h, int dir) { return (float*)(ws + WS_EV) + ((size_t)(chunk * NH + h) * 2 + dir) * 384; }
DI void phase_prep(int l, int wv, bool dry = false) {
    const Frame F = mkframe(wv);
    const float* lbt = (const float*)(F.ws + WS_LBT);
    const float* cw = inp(I_CONVW) + (size_t)l * 3 * DC; const float* cbias = inp(I_CONVB) + (size_t)l * DC;
    constexpr int O_TOTF = 0, O_TOTB = 2048, O_PRE = 4096;
    LAS unsigned char* L = F.lds;
    const int lane = F.lane, w = F.wave, pl = lane >> 3, cg = lane & 7, pp = w * 8 + pl;
    struct PrepIn { u32x4 cb, cc, cv, ccp, cvp, ccn, cvn, zf, zb, q; };
    constexpr int NITEM = (NTOK / 64) * NH * 2;
    auto item_load = [&](int item, PrepIn& P) {
        const int chunk = item >> 4, h = (item >> 1) & 7, hc = (item & 1) * 64 + cg * 8, row = chunk * 64 + pp, c0 = h * DK + hc;
        const bf16* prow = F.PROJ + (size_t)row * INW;
        bool hasp, hasn;
        if (row < NLAT) { hasp = pp != 0; hasn = pp != 63; } else { const int t = (row - NLAT) & (CTXL - 1); hasp = t != 0; hasn = t != CTXL - 1; }
        const bf16* pprev = hasp ? prow - INW : prow; const bf16* pnext = hasn ? prow + INW : prow;
        P.cb = *(const u32x4*)(prow + C_CB + c0); P.cc = *(const u32x4*)(prow + C_CC + c0); P.cv = *(const u32x4*)(prow + C_CV + c0);
        P.ccp = *(const u32x4*)(pprev + C_CC + c0); P.cvp = *(const u32x4*)(pprev + C_CV + c0); P.ccn = *(const u32x4*)(pnext + C_CC + c0); P.cvn = *(const u32x4*)(pnext + C_CV + c0);
        P.zf = *(const u32x4*)(prow + C_ZF + c0); P.zb = *(const u32x4*)(prow + C_ZB + c0); P.q = *(const u32x4*)(prow + C_Q + c0); };
    auto item_compute = [&](int item, const PrepIn& P) {
        const int chunk = item >> 4, h = (item >> 1) & 7, hc = (item & 1) * 64 + cg * 8, row = chunk * 64 + pp, c0 = h * DK + hc;
        bf16* prow = F.PROJ + (size_t)row * INW;
        bool hasp, hasn;
        if (row < NLAT) { hasp = pp != 0; hasn = pp != 63; } else { const int t = (row - NLAT) & (CTXL - 1); hasp = t != 0; hasn = t != CTXL - 1; }
        {   float cb[8], cc[8], cv[8], up[8], un[8], t0[8], t1[8], ya[8];
            unpack8(P.cb, cb); unpack8(P.cc, cc); unpack8(P.cv, cv);
            if (hasp) { unpack8(P.ccp, t0); unpack8(P.cvp, t1);
#pragma unroll
                for (int j = 0; j < 8; ++j) up[j] = t0[j] * t1[j]; }
            else {
#pragma unroll
                for (int j = 0; j < 8; ++j) up[j] = 0.f; }
            if (hasn) { unpack8(P.ccn, t0); unpack8(P.cvn, t1);
#pragma unroll
                for (int j = 0; j < 8; ++j) un[j] = t0[j] * t1[j]; }
            else {
#pragma unroll
                for (int j = 0; j < 8; ++j) un[j] = 0.f; }
            const f32x4 w0a = *(const f32x4*)(cw + c0), w0b = *(const f32x4*)(cw + c0 + 4), w1a = *(const f32x4*)(cw + DC + c0), w1b = *(const f32x4*)(cw + DC + c0 + 4);
            const f32x4 w2a = *(const f32x4*)(cw + 2 * DC + c0), w2b = *(const f32x4*)(cw + 2 * DC + c0 + 4), bia = *(const f32x4*)(cbias + c0), bib = *(const f32x4*)(cbias + c0 + 4);
#pragma unroll
            for (int j = 0; j < 8; ++j) { const float w0 = j < 4 ? w0a[j & 3] : w0b[j & 3], w1 = j < 4 ? w1a[j & 3] : w1b[j & 3], w2 = j < 4 ? w2a[j & 3] : w2b[j & 3], bi = j < 4 ? bia[j & 3] : bib[j & 3];
                ya[j] = cb[j] * (w0 * up[j] + w1 * (cc[j] * cv[j]) + w2 * un[j] + bi); }
            if (!dry) *(u32x2*)((unsigned char*)F.H + (size_t)row * D + c0) = (u32x2){pk4_fp8(ya[0] * SA8_Y, ya[1] * SA8_Y, ya[2] * SA8_Y, ya[3] * SA8_Y), pk4_fp8(ya[4] * SA8_Y, ya[5] * SA8_Y, ya[6] * SA8_Y, ya[7] * SA8_Y)};
        }
        float lff[8], lfb[8], kf[8], kb[8], qs[8];
        {   float zf[8], zb[8], q[8];
            unpack8(P.zf, zf); unpack8(P.zb, zb); unpack8(P.q, q);
            const f32x4 lfa = *(const f32x4*)(lbt + c0), lfc = *(const f32x4*)(lbt + c0 + 4), lba = *(const f32x4*)(lbt + DC + c0), lbc = *(const f32x4*)(lbt + DC + c0 + 4);
#pragma unroll
            for (int i = 0; i < 8; ++i) { const float lbf = i < 4 ? lfa[i & 3] : lfc[i & 3], lbb = i < 4 ? lba[i & 3] : lbc[i & 3];
                const float ef = __expf(fminf(fmaxf(-zf[i], -80.f), 80.f)), eb = __expf(fminf(fmaxf(-zb[i], -80.f), 80.f)), sf = frcp(1.0f + ef), sb = frcp(1.0f + eb);
                lff[i] = __logf(fmaxf(lbf + (1.0f - lbf) * sf, F_MIN)); kf[i] = (1.0f - lbf) * (ef * sf);
                lfb[i] = __logf(fmaxf(lbb + (1.0f - lbb) * sb, F_MIN)); kb[i] = (1.0f - lbb) * (eb * sb);
                qs[i] = q[i] * frcp(1.0f + __expf(-q[i])) * QSCALE; }
        }
#pragma unroll
        for (int d = 1; d < 8; d <<= 1) {
#pragma unroll
            for (int i = 0; i < 8; ++i) { const float o = __shfl_up(lff[i], 8 * d); if (pl >= d) lff[i] += o; const float o2 = __shfl_down(lfb[i], 8 * d); if (pl + d < 8) lfb[i] += o2; } }
        __syncthreads();
        if (pl == 7) { *(LAS f32x4*)(L + O_TOTF + (w * 64 + cg * 8) * 4) = (f32x4){lff[0], lff[1], lff[2], lff[3]}; *(LAS f32x4*)(L + O_TOTF + (w * 64 + cg * 8 + 4) * 4) = (f32x4){lff[4], lff[5], lff[6], lff[7]}; }
        if (pl == 0) { *(LAS f32x4*)(L + O_TOTB + (w * 64 + cg * 8) * 4) = (f32x4){lfb[0], lfb[1], lfb[2], lfb[3]}; *(LAS f32x4*)(L + O_TOTB + (w * 64 + cg * 8 + 4) * 4) = (f32x4){lfb[4], lfb[5], lfb[6], lfb[7]}; }
        __syncthreads();
        if (F.tid < 128) { const int dd = F.tid >> 6, cch = F.tid & 63; const LAS float* tp = (const LAS float*)(L + (dd ? O_TOTB : O_TOTF)) + cch; LAS float* pp_ = (LAS float*)(L + O_PRE) + dd * 640 + cch;
            float t[8];
#pragma unroll
            for (int ww = 0; ww < 8; ++ww) t[ww] = tp[ww * 64];
            float run = 0.f;
            if (dd == 0) {
#pragma unroll
                for (int ww = 0; ww < 8; ++ww) { pp_[ww * 64] = run; run += t[ww]; }
                pp_[512] = (t[0] + t[1]) + (t[2] + t[3]); }
            else {
#pragma unroll
                for (int ww = 7; ww >= 0; --ww) { pp_[ww * 64] = run; run += t[ww]; }
                pp_[512] = (t[4] + t[5]) + (t[6] + t[7]); }
            pp_[576] = run; }
        __syncthreads();
        {   float pf[8], rf[8], bf_[8], pb[8], rb[8], bb[8];
            const LAS float* PF = (const LAS float*)(L + O_PRE) + cg * 8; const LAS float* PB = PF + 640;
#pragma unroll
            for (int q4 = 0; q4 < 2; ++q4) { const f32x4 a0 = *(const LAS f32x4*)(PF + w * 64 + q4 * 4), a1 = *(const LAS f32x4*)(PF + 512 + q4 * 4), a2 = *(const LAS f32x4*)(PF + 576 + q4 * 4);
                const f32x4 b0 = *(const LAS f32x4*)(PB + w * 64 + q4 * 4), b1 = *(const LAS f32x4*)(PB + 512 + q4 * 4), b2 = *(const LAS f32x4*)(PB + 576 + q4 * 4);
#pragma unroll
                for (int e = 0; e < 4; ++e) { const int i = q4 * 4 + e; pf[i] = a0[e]; rf[i] = a1[e]; bf_[i] = a2[e]; pb[i] = b0[e]; rb[i] = b1[e]; bb[i] = b2[e]; } }
            float o0[8], o1[8], o2[8], o3[8];
#pragma unroll
            for (int i = 0; i < 8; ++i) { const float bcf = pf[i] + lff[i], bcb = pb[i] + lfb[i];
                o0[i] = qs[i] * __expf(fminf(bcf - rf[i], 80.f)); o1[i] = kf[i] * __expf(fminf(rf[i] - bcf, 80.f));
                o2[i] = qs[i] * __expf(fminf(bcb - rb[i], 80.f)); o3[i] = kb[i] * __expf(fminf(rb[i] - bcb, 80.f)); }
            if (!dry) { *(u32x4*)(prow + C_QTF + c0) = pack8(o0); *(u32x4*)(prow + C_KTF + c0) = pack8(o1);
            *(u32x4*)(prow + C_QTB + c0) = pack8(o2); *(u32x4*)(prow + C_KTB + c0) = pack8(o3); }
            if (pp == 0 && !dry) {
                float* evf = ev_ptr(F.ws, chunk, h, 0) + hc; float* evb = ev_ptr(F.ws, chunk, h, 1) + hc;
#pragma unroll
                for (int q4 = 0; q4 < 2; ++q4) {
                    *(f32x4*)(evf + q4 * 4) = (f32x4){__expf(rf[q4 * 4]), __expf(rf[q4 * 4 + 1]), __expf(rf[q4 * 4 + 2]), __expf(rf[q4 * 4 + 3])};
                    *(f32x4*)(evf + 128 + q4 * 4) = (f32x4){__expf(bf_[q4 * 4] - rf[q4 * 4]), __expf(bf_[q4 * 4 + 1] - rf[q4 * 4 + 1]), __expf(bf_[q4 * 4 + 2] - rf[q4 * 4 + 2]), __expf(bf_[q4 * 4 + 3] - rf[q4 * 4 + 3])};
                    *(f32x4*)(evf + 256 + q4 * 4) = (f32x4){__expf(bf_[q4 * 4]), __expf(bf_[q4 * 4 + 1]), __expf(bf_[q4 * 4 + 2]), __expf(bf_[q4 * 4 + 3])};
                    *(f32x4*)(evb + q4 * 4) = (f32x4){__expf(rb[q4 * 4]), __expf(rb[q4 * 4 + 1]), __expf(rb[q4 * 4 + 2]), __expf(rb[q4 * 4 + 3])};
                    *(f32x4*)(evb + 128 + q4 * 4) = (f32x4){__expf(bb[q4 * 4] - rb[q4 * 4]), __expf(bb[q4 * 4 + 1] - rb[q4 * 4 + 1]), __expf(bb[q4 * 4 + 2] - rb[q4 * 4 + 2]), __expf(bb[q4 * 4 + 3] - rb[q4 * 4 + 3])};
                    *(f32x4*)(evb + 256 + q4 * 4) = (f32x4){__expf(bb[q4 * 4]), __expf(bb[q4 * 4 + 1]), __expf(bb[q4 * 4 + 2]), __expf(bb[q4 * 4 + 3])}; }
            }
        }
    };
    PrepIn PA, PB;
    int item = blockIdx.x;
    if (item < NITEM) item_load(item, PA);
    while (item < NITEM) {
        const int n1 = item + F.G, n2 = item + 2 * F.G;
        if (n1 < NITEM) item_load(n1, PB);
        item_compute(item, PA);
        if (n1 >= NITEM) break;
        if (n2 < NITEM) item_load(n2, PA);
        item_compute(n1, PB);
        item = n2;
    }
}
DI bf16x8v tr_frag(const LAS unsigned char* tile, int stride, int s0, int cbase, int lane) {
    const int i16 = lane & 15, g16 = (lane >> 4) & 1;
    const LAS unsigned char* p = tile + (s0 + (i16 >> 2)) * stride + (cbase + 16 * g16 + 4 * (i16 & 3)) * 2;
    const s16x4v lo = __builtin_amdgcn_ds_read_tr16_b64_v4i16((LAS s16x4v*)p), hi = __builtin_amdgcn_ds_read_tr16_b64_v4i16((LAS s16x4v*)(p + 4 * stride));
    return __builtin_shufflevector(lo, hi, 0, 1, 2, 3, 4, 5, 6, 7);
}
DI void phase_scan(int l, int wv, bool fill) {
    const Frame F = mkframe(wv);
    const float* pu = inp(I_PU) + (size_t)l * NEXP * D; const float* pv = inp(I_PV) + (size_t)l * NEXP * D;
    constexpr int RS = 272, RS64 = 144;
    constexpr int O_QT = 0, O_KT = 17408, O_ST = 34816, O_V = 52224, O_PM = 61440, O_EV = 70656;
    LAS unsigned char* L = F.lds;
    const int tid = F.tid, lane = F.lane, w = F.wave, r32 = lane & 31, hh = lane >> 5;
    const int srow = tid >> 3, sc16 = (tid & 7) * 16, svc = (tid & 7) * 8;
    for (int task = blockIdx.x; task < NBATCH * NH * 4; task += F.G) {
        const int b = task >> 5, h = (task >> 2) & 7, dir = (task >> 1) & 1, vh = task & 1;
        const int cq = (dir ? C_QTB : C_QTF) + h * DK + sc16, ck = (dir ? C_KTB : C_KTF) + h * DK + sc16, cvv = C_VI + h * DK + vh * 64 + svc;
        f32x16 S;
#pragma unroll
        for (int i = 0; i < 16; ++i) S[i] = 0.f;
        auto chunk_row0 = [&](int c) { return c < 4 ? NLAT + b * CTXL + (dir ? 3 - c : c) * 64 : b * SEQ + (dir ? 35 - c : c - 4) * 64; };
        u32x4 q0, q1, k0, k1, vr; f32x4 evr = (f32x4){0.f, 0.f, 0.f, 0.f};
        f32x4 fx[8]; const int fidx = (int)blockIdx.x * 4 + w; const bool filler = fill && w < 4;
        auto fill_load = [&](int it) { const float* src = ((it & 1) ? pv : pu) + (size_t)(it >> 1) * D; const float* src2 = src + 1024;
            unsigned lo = (unsigned)lane * 4u; asm volatile("" : "+v"(lo));
#pragma unroll
            for (int c8 = 0; c8 < 4; ++c8) { fx[c8] = __builtin_nontemporal_load((const f32x4*)(src + lo + c8 * 256)); fx[4 + c8] = __builtin_nontemporal_load((const f32x4*)(src2 + lo + c8 * 256)); } };
        if (filler) fill_load(fidx);
        {   const int row0 = chunk_row0(0); const bf16* pr = F.PROJ + (size_t)(row0 + srow) * INW;
            q0 = *(const u32x4*)(pr + cq); q1 = *(const u32x4*)(pr + cq + 8); k0 = *(const u32x4*)(pr + ck); k1 = *(const u32x4*)(pr + ck + 8); vr = *(const u32x4*)(pr + cvv);
            if (tid < 96) evr = *(const f32x4*)(ev_ptr(F.ws, row0 >> 6, h, dir) + tid * 4); }
        for (int c = 0; c < 36; ++c) {
            const int row0 = chunk_row0(c);
            __syncthreads();
            *(LAS u32x4*)(L + O_QT + srow * RS + sc16 * 2) = q0; *(LAS u32x4*)(L + O_QT + srow * RS + sc16 * 2 + 16) = q1;
            *(LAS u32x4*)(L + O_KT + srow * RS + sc16 * 2) = k0; *(LAS u32x4*)(L + O_KT + srow * RS + sc16 * 2 + 16) = k1;
            *(LAS u32x4*)(L + O_V + srow * RS64 + svc * 2) = vr;
            if (tid < 96) *(LAS f32x4*)(L + O_EV + tid * 16) = evr;
            if (c + 1 < 36) { const int rown = chunk_row0(c + 1); const bf16* pr = F.PROJ + (size_t)(rown + srow) * INW;
                q0 = *(const u32x4*)(pr + cq); q1 = *(const u32x4*)(pr + cq + 8); k0 = *(const u32x4*)(pr + ck); k1 = *(const u32x4*)(pr + ck + 8); vr = *(const u32x4*)(pr + cvv);
                if (tid < 96) evr = *(const f32x4*)(ev_ptr(F.ws, rown >> 6, h, dir) + tid * 4); }
            __syncthreads();
            {   const int kb = w >> 1, vb = w & 1;
                const LAS float* er = (const LAS float*)(L + O_EV) + kb * 32 + 4 * hh; const LAS float* ebr = er + 128; const LAS float* eb = er + 256;
#pragma unroll
                for (int g = 0; g < 4; ++g) { const f32x4 e4 = *(const LAS f32x4*)(er + 8 * g);
                    u32x2 pk; pk.x = pk2(S[4 * g] * e4.x, S[4 * g + 1] * e4.y); pk.y = pk2(S[4 * g + 2] * e4.z, S[4 * g + 3] * e4.w);
                    *(LAS u32x2*)(L + O_ST + (vb * 32 + r32) * RS + (kb * 32 + 8 * g + 4 * hh) * 2) = pk; }
                f32x16 U;
#pragma unroll
                for (int i = 0; i < 16; ++i) U[i] = 0.f;
#pragma unroll
                for (int ks = 0; ks < 4; ++ks) { const bf16x8v a = tr_frag(L + O_KT, RS, ks * 16 + 8 * hh, kb * 32, lane), bv = tr_frag(L + O_V, RS64, ks * 16 + 8 * hh, vb * 32, lane);
                    U = __builtin_amdgcn_mfma_f32_32x32x16_bf16(a, bv, U, 0, 0, 0); }
#pragma unroll
                for (int g = 0; g < 4; ++g) { const f32x4 b4 = *(const LAS f32x4*)(eb + 8 * g), c4 = *(const LAS f32x4*)(ebr + 8 * g);
                    S[4 * g] = b4.x * S[4 * g] + c4.x * U[4 * g]; S[4 * g + 1] = b4.y * S[4 * g + 1] + c4.y * U[4 * g + 1]; S[4 * g + 2] = b4.z * S[4 * g + 2] + c4.z * U[4 * g + 2]; S[4 * g + 3] = b4.w * S[4 * g + 3] + c4.w * U[4 * g + 3]; }
            }
            if (w < 4) {
                const int tb = w >> 1, sb = w & 1;
                f32x16 acc;
#pragma unroll
                for (int i = 0; i < 16; ++i) acc[i] = 0.f;
#pragma unroll 4
                for (int ks = 0; ks < 8; ++ks) { const bf16x8v a = *(const LAS bf16x8v*)(L + O_QT + (tb * 32 + r32) * RS + (ks * 16 + 8 * hh) * 2), bq = *(const LAS bf16x8v*)(L + O_KT + (sb * 32 + r32) * RS + (ks * 16 + 8 * hh) * 2);
                    acc = __builtin_amdgcn_mfma_f32_32x32x16_bf16(a, bq, acc, 0, 0, 0); }
#pragma unroll
                for (int i = 0; i < 16; ++i) { const int t = tb * 32 + (i & 3) + 8 * (i >> 2) + 4 * hh, sp = sb * 32 + r32; const bool keep = dir ? (sp >= t) : (sp <= t);
                    *(LAS unsigned short*)(L + O_PM + t * RS64 + sp * 2) = f2bf1(keep ? acc[i] : 0.f); }
            }
            __syncthreads();
            if (filler && c < 32) {
                const int it = fidx + 1024 * c, e = it >> 1; unsigned char* dst = (it & 1) ? (unsigned char*)F.V : (unsigned char*)F.U;
                float am = 0.f;
#pragma unroll
                for (int c8 = 0; c8 < 8; ++c8) am = fmaxf(am, fmaxf(fmaxf(fabsf(fx[c8].x), fabsf(fx[c8].y)), fmaxf(fabsf(fx[c8].z), fabsf(fx[c8].w))));
#pragma unroll
                for (int o = 1; o < 64; o <<= 1) am = fmaxf(am, __shfl_xor(am, o));
                const float inv = am > 0.f ? 7.0f / am : 0.f, sc = am > 0.f ? am * (1.0f / 7.0f) : 0.f;
                v32h hx;
#pragma unroll
                for (int c8 = 0; c8 < 8; ++c8) { hx[c8 * 4 + 0] = (_Float16)(fx[c8].x * inv); hx[c8 * 4 + 1] = (_Float16)(fx[c8].y * inv); hx[c8 * 4 + 2] = (_Float16)(fx[c8].z * inv); hx[c8 * 4 + 3] = (_Float16)(fx[c8].w * inv); }
                const v6i p = __builtin_amdgcn_cvt_scalef32_pk32_fp6_f16(hx, 1.0f);
                eseg_store(dst, e, lane, p);
                if (lane == 0) ((float*)(F.ws + WS_ESCALE) + ((it & 1) ? NEXP : 0))[e] = sc;
                if (c + 1 < 32) fill_load(it + 1024);
            }
            if (w >= 4) {
                const int tb = (w - 4) >> 1, vb = (w - 4) & 1;
                f32x16 acc;
#pragma unroll
                for (int i = 0; i < 16; ++i) acc[i] = 0.f;
#pragma unroll
                for (int ks = 0; ks < 4; ++ks) { const bf16x8v a = *(const LAS bf16x8v*)(L + O_PM + (tb * 32 + r32) * RS64 + (ks * 16 + 8 * hh) * 2), bv = tr_frag(L + O_V, RS64, ks * 16 + 8 * hh, vb * 32, lane);
                    acc = __builtin_amdgcn_mfma_f32_32x32x16_bf16(a, bv, acc, 0, 0, 0); }
#pragma unroll 4
                for (int ks = 0; ks < 8; ++ks) { const bf16x8v a = *(const LAS bf16x8v*)(L + O_QT + (tb * 32 + r32) * RS + (ks * 16 + 8 * hh) * 2), bs = *(const LAS bf16x8v*)(L + O_ST + (vb * 32 + r32) * RS + (ks * 16 + 8 * hh) * 2);
                    acc = __builtin_amdgcn_mfma_f32_32x32x16_bf16(a, bs, acc, 0, 0, 0); }
                bf16* ob = (bf16*)F.OSC + ((size_t)dir * NTOK + row0) * DC + h * DK + vh * 64 + vb * 32 + r32;
#pragma unroll
                for (int i = 0; i < 16; ++i) { const int t = tb * 32 + (i & 3) + 8 * (i >> 2) + 4 * hh; ob[(size_t)t * DC] = f2bf1(acc[i]); }
            }
        }
    }
}

DI void phase_readout(int l, int nrows, int wv) {
    const Frame F = mkframe(wv);
    const int gw = blockIdx.x * NWAVES + F.wave, NGW = F.G * NWAVES;
    const float* ng = inp(I_HGG) + (size_t)l * DK;
    struct RowIn { u32x4 a[2], b[2]; u32x4 og[2]; };
    auto row_load = [&](int r, RowIn& R) { const bf16* prow = F.PROJ + (size_t)r * INW; const bf16* osc = (const bf16*)F.OSC;
#pragma unroll
        for (int c = 0; c < 2; ++c) { const int e0 = c * 512 + F.lane * 8;
            R.a[c] = *(const u32x4*)(osc + (size_t)r * DC + e0); R.b[c] = *(const u32x4*)(osc + ((size_t)NTOK + r) * DC + e0);
            R.og[c] = *(const u32x4*)(prow + C_OG + e0); } };
    auto row_compute = [&](int r, const RowIn& R) {
#pragma unroll
        for (int c = 0; c < 2; ++c) {
            const int e0 = c * 512 + F.lane * 8;
            float o[8], og[8], yb[8]; float ss = 0.f;
            { float fa[8], fb[8]; unpack8(R.a[c], fa); unpack8(R.b[c], fb);
#pragma unroll
              for (int j = 0; j < 8; ++j) o[j] = fa[j] + fb[j]; }
#pragma unroll
            for (int j = 0; j < 8; ++j) ss += o[j] * o[j];
            ss += __shfl_xor(ss, 1); ss += __shfl_xor(ss, 2); ss += __shfl_xor(ss, 4); ss += __shfl_xor(ss, 8);
            const float rs = rsqrtf(ss * (1.0f / DK) + LN_EPS);
            unpack8(R.og[c], og);
#pragma unroll
            for (int j = 0; j < 8; ++j) yb[j] = o[j] * rs * ng[(e0 + j) & (DK - 1)] * silu(og[j]);
            *(u32x2*)((unsigned char*)F.H + (size_t)r * D + DC + e0) = (u32x2){pk4_fp8(yb[0] * SA8_Y, yb[1] * SA8_Y, yb[2] * SA8_Y, yb[3] * SA8_Y), pk4_fp8(yb[4] * SA8_Y, yb[5] * SA8_Y, yb[6] * SA8_Y, yb[7] * SA8_Y)};
        } };
    RowIn RA, RB;
    int r = gw;
    if (r < nrows) row_load(r, RA);
    while (r < nrows) {
        const int n1 = r + NGW, n2 = r + 2 * NGW;
        if (n1 < nrows) row_load(n1, RB);
        row_compute(r, RA);
        if (n1 >= nrows) break;
        if (n2 < nrows) row_load(n2, RA);
        row_compute(n1, RB);
        r = n2;
    }
}

DI void phase_ln1(int l, int nrows, int wv) {
    const Frame F = mkframe(wv);
    const float* xin = inp(I_X); const float* cin = inp(I_CTX);
    const int gw = blockIdx.x * NWAVES + F.wave, NGW = F.G * NWAVES;
    const float* lg = inp(I_LN1G) + (size_t)l * D; const float* lbias = inp(I_LN1B) + (size_t)l * D;
    for (int r = gw; r < nrows; r += NGW) {
        const float* md = F.mod + ((size_t)l * 9 + modrow(r)) * MODW;
        float v[32], t[32];
        load_row_f32(xrow(xin, cin, F.X, l, r), F.lane, v);
        load_row_bf16(F.H + (size_t)r * D, F.lane, t);
        { float g1[32]; load_row_f32(md + 2 * D, F.lane, g1);
#pragma unroll
          for (int i = 0; i < 32; ++i) v[i] = ALPHA * v[i] + g1[i] * t[i]; }
        row_normalize(v);
        { float a[32], bb[32]; load_row_f32(lg, F.lane, a); load_row_f32(lbias, F.lane, bb);
#pragma unroll
          for (int i = 0; i < 32; ++i) v[i] = v[i] * a[i] + bb[i]; }
        store_row_f32(F.X + (size_t)r * D, F.lane, v);
        row_normalize(v);
        { float sh[32], sc[32]; load_row_f32(md + 3 * D, F.lane, sh); load_row_f32(md + 4 * D, F.lane, sc);
#pragma unroll
          for (int i = 0; i < 32; ++i) v[i] = v[i] * (1.0f + sc[i]) + sh[i]; }
        store_row_bf16(F.H + (size_t)r * D, F.lane, v);
    }
}

typedef __bf16 bf16x2v __attribute__((ext_vector_type(2)));
DI int crow32(int reg, int h) { return (reg & 3) + 8 * (reg >> 2) + 4 * h; }
#define CE_DESC(a, b) do { const float _x = (a), _y = (b); (a) = fmaxf(_x, _y); (b) = fminf(_x, _y); } while (0)
#define CE_ASC(a, b) do { const float _x = (a), _y = (b); (a) = fminf(_x, _y); (b) = fmaxf(_x, _y); } while (0)
DI void sort16_desc(float (&x)[16]) {
#pragma unroll
    for (int k = 2; k <= 16; k <<= 1)
#pragma unroll
        for (int j = k >> 1; j > 0; j >>= 1)
#pragma unroll
            for (int i = 0; i < 16; ++i) { const int l = i ^ j; if (l > i) { if ((i & k) == 0) CE_DESC(x[i], x[l]); else CE_ASC(x[i], x[l]); } }
}
DI void merge_top16(float (&a)[16], const float (&b)[16]) {
#pragma unroll
    for (int i = 0; i < 16; ++i) a[i] = fmaxf(a[i], b[15 - i]);
#pragma unroll
    for (int j = 8; j > 0; j >>= 1)
#pragma unroll
        for (int i = 0; i < 16; ++i) { const int l = i ^ j; if (l > i) CE_DESC(a[i], a[l]); }
}
DI void top16_of64(float (&x)[64], float (&t)[16]) {
    float g[4][16];
#pragma unroll
    for (int q = 0; q < 4; ++q) {
#pragma unroll
        for (int i = 0; i < 16; ++i) g[q][i] = x[q * 16 + i];
        sort16_desc(g[q]); }
    merge_top16(g[0], g[1]); merge_top16(g[2], g[3]); merge_top16(g[0], g[2]);
#pragma unroll
    for (int i = 0; i < 16; ++i) t[i] = g[0][i];
}
constexpr int cand_off(int i) { int o = 0; for (int a = 0; a < i; ++a) o += 16 / (a + 1); return o; }
static_assert(cand_off(16) == 50, "candidate count");
constexpr size_t WS_RIDX = 1068 * MiB, WS_RG = 1077 * MiB;
DI void route_block(const Frame& F, int t0, int t1) {
    const int lane = F.lane, r32 = lane & 31, hh = lane >> 5;
    unsigned short* RI = (unsigned short*)(F.ws + WS_RIDX) + (size_t)t0 * 128; float* RGl = (float*)(F.ws + WS_RG) + (size_t)t0 * 128;
    LAS unsigned* kl = (LAS unsigned*)(F.lds + 98304 + F.wave * 2048);
    const float NEG = -3.0e38f;
    const int ntile = (t1 - t0 + 31) / 32;
    for (int item = F.wave; item < ntile * NH; item += NWAVES) {
        const int tile = item >> 3, h = item & 7;
        const int tl = tile * 32 + r32; const bool valid = t0 + tl < t1;
        const int tok = valid ? t0 + tl : t1 - 1;
        float tv[2][16];
#pragma unroll
        for (int p = 0; p < 2; ++p) {
            f32x16 acc[4];
#pragma unroll
            for (int kb = 0; kb < 4; ++kb)
#pragma unroll
                for (int i = 0; i < 16; ++i) acc[kb][i] = 0.f;
            const bf16* qp = F.Y + (size_t)tok * D + (h * 2 + p) * 128 + 8 * hh;
            const bf16* kp = F.Keys + ((size_t)((h * 2 + p) * 128) + r32) * 128 + 8 * hh;
#pragma unroll 4
            for (int ks = 0; ks < 8; ++ks) {
                const bf16x8v bq = *(const bf16x8v*)(qp + ks * 16);
#pragma unroll
                for (int kb = 0; kb < 4; ++kb) { const bf16x8v ak = *(const bf16x8v*)(kp + (size_t)kb * 32 * 128 + ks * 16);
                    acc[kb] = __builtin_amdgcn_mfma_f32_32x32x16_bf16(ak, bq, acc[kb], 0, 0, 0); }
            }
            float x[64];
#pragma unroll
            for (int kb = 0; kb < 4; ++kb)
#pragma unroll
                for (int i = 0; i < 16; ++i) { const unsigned key = (unsigned)(kb * 32 + (i & 3) + 8 * (i >> 2)) + 4u * (unsigned)hh;
                    x[kb * 16 + i] = __uint_as_float((__float_as_uint(acc[kb][i]) & ~127u) | key); }
            float t[16], pb[16];
            top16_of64(x, t);
#pragma unroll
            for (int i = 0; i < 16; ++i) pb[i] = __shfl_xor(t[i], 32);
            merge_top16(t, pb);
#pragma unroll
            for (int i = 0; i < 16; ++i) tv[p][i] = t[i];
        }
#pragma unroll
        for (int w = 0; w < 8; ++w) { unsigned pk = 0;
#pragma unroll
            for (int b = 0; b < 4; ++b) { const int i = w * 4 + b; pk |= (__float_as_uint(i < 16 ? tv[0][i] : tv[1][i - 16]) & 127u) << (8 * b); }
            kl[w * 64 + lane] = pk; }
        float x[64];
#pragma unroll
        for (int i = 0; i < 64; ++i) x[i] = NEG;
#pragma unroll
        for (int i = 0; i < 16; ++i)
#pragma unroll
            for (int j = 0; j < 16; ++j) if ((i + 1) * (j + 1) <= 16) {
                const float sa = __uint_as_float(__float_as_uint(tv[0][i]) & ~127u), sb = __uint_as_float(__float_as_uint(tv[1][j]) & ~127u);
                x[cand_off(i) + j] = __uint_as_float((__float_as_uint(sa + sb) & ~255u) | (unsigned)(i * 16 + j)); }
        float c[16];
        top16_of64(x, c);
        asm volatile("s_waitcnt lgkmcnt(0)" ::: "memory");
        int eidx[16]; float ev[16]; float den = 0.f;
        const float mx = __uint_as_float(__float_as_uint(c[0]) & ~255u);
#pragma unroll
        for (int i = 0; i < 16; ++i) {
            const unsigned bits = __float_as_uint(c[i]); const int pos = bits & 255u, ia = pos >> 4, ib = 16 + (pos & 15);
            const unsigned wa = kl[(ia >> 2) * 64 + lane], wb = kl[(ib >> 2) * 64 + lane];
            const int ka = (wa >> (8 * (ia & 3))) & 127, kb2 = (wb >> (8 * (ib & 3))) & 127;
            eidx[i] = ka * 128 + kb2;
            ev[i] = __expf(__uint_as_float(bits & ~255u) - mx); den += ev[i]; }
        const float inv = 1.0f / den;
        if (valid) {
            if (hh == 0) {
#pragma unroll
                for (int q = 0; q < 2; ++q) *(u32x4*)(RI + tl * 128 + h * 16 + q * 8) = (u32x4){(unsigned)eidx[q * 8] | ((unsigned)eidx[q * 8 + 1] << 16), (unsigned)eidx[q * 8 + 2] | ((unsigned)eidx[q * 8 + 3] << 16), (unsigned)eidx[q * 8 + 4] | ((unsigned)eidx[q * 8 + 5] << 16), (unsigned)eidx[q * 8 + 6] | ((unsigned)eidx[q * 8 + 7] << 16)};
            } else {
#pragma unroll
                for (int q = 0; q < 4; ++q) *(f32x4*)(RGl + tl * 128 + h * 16 + q * 4) = (f32x4){ev[q * 4] * inv, ev[q * 4 + 1] * inv, ev[q * 4 + 2] * inv, ev[q * 4 + 3] * inv};
            }
        }
    }
}

DI float gelu_fast(float v) {
    const float av = fabsf(v), t = __builtin_amdgcn_rcpf(1.0f + 0.2316419f * av);
    float q = t * 0.5307027145f - 0.7265760135f; q = q * t + 0.7107068705f; q = q * t - 0.142248368f; q = q * t + 0.127414796f; q = q * t;
    const float m = v * (q * __builtin_amdgcn_exp2f(v * v * -0.72134752044f));
    return v < 0.f ? m : v - m;
}
constexpr size_t WS_PP = WS_OSC;
constexpr size_t WS_PW = WS_OSC + 72 * MiB;
static_assert(WS_PW + (size_t)NTOK * 128 * 4 <= WS_END, "ws map");
typedef float f32x2 __attribute__((ext_vector_type(2)));
template <int CTRL> DI float dpp_add(float x) { return x + __uint_as_float(__builtin_amdgcn_update_dpp(0u, __float_as_uint(x), CTRL, 0xf, 0xf, true)); }
struct ESeg { u32x4 a; u32x2 b; };
DI void eseg_load(ESeg& r, __amdgpu_buffer_rsrc_t rs, int voff) { r.a = __builtin_amdgcn_raw_buffer_load_b128(rs, voff, 0, 0); r.b = __builtin_amdgcn_raw_buffer_load_b64(rs, voff + 16, 0, 0); }
DI v32f eseg_unpack(const ESeg& r) { return __builtin_amdgcn_cvt_scalef32_pk32_f32_fp6((v6i){(int)r.a.x, (int)r.a.y, (int)r.a.z, (int)r.a.w, (int)r.b.x, (int)r.b.y}, 1.0f); }
DI unsigned char* uniform_ptr(unsigned char* p) {
    const unsigned long long v = (unsigned long long)p; const unsigned lo = __builtin_amdgcn_readfirstlane((unsigned)v), hi = __builtin_amdgcn_readfirstlane((unsigned)(v >> 32));
    return as_global<unsigned char>(((unsigned long long)hi << 32) | lo); }
DI void xcd_split(const Frame& F, int& x, int& wx, int& nwx) {
    if ((F.G & 7) == 0) { x = blockIdx.x & 7; wx = (blockIdx.x >> 3) * NWAVES + F.wave; nwx = (F.G >> 3) * NWAVES; }
    else { const int gw = blockIdx.x * NWAVES + F.wave, NW = F.G * NWAVES; x = gw & 7; wx = gw >> 3; nwx = (NW - x + 7) >> 3; }
}
DI void phase_peer_route(int nrows, int wv) {
    const Frame R = mkframe(wv);
    const int per0 = (nrows + R.G - 1) / R.G, s0 = blockIdx.x * per0, s1 = min(s0 + per0, nrows);
    __syncthreads();
    if (s0 < s1) route_block(R, s0, s1);
}
DI void ids_load(u32x4 (&d)[2], const unsigned short* RI16, int t, int g) { const u32x4* p = (const u32x4*)(RI16 + (size_t)t * 128 + g * 16); d[0] = p[0]; d[1] = p[1]; }
#ifndef ID_MASK
#define ID_MASK 0xffffu
#endif
DI int id_of(const u32x4 (&d)[2], int r, unsigned mask = 0xffffu) { const unsigned w = d[r >> 3][(r >> 1) & 3]; return (r & 1) ? (int)((w >> 16) & mask) : (int)(w & mask); }
template <int MODE = 0> DI void phase_peer_u(int nrows, int wv, unsigned mask = 0xffffu) {
    const Frame F = mkframe(wv);
    int x, wx, nwx; xcd_split(F, x, wx, nwx);
    const int lane = F.lane, s = lane & 7, g = lane >> 3, s24 = s * 24;
    const __amdgpu_buffer_rsrc_t US = __builtin_amdgcn_make_buffer_rsrc((void*)uniform_ptr((unsigned char*)F.U + (size_t)x * ESLICE), 0, (int)ESLICE, 0x00020000);
    const unsigned short* RI16 = (const unsigned short*)(F.ws + WS_RIDX);
    float* P = (float*)(F.ws + WS_PP) + (size_t)x * NTOK * 128;
    const bf16* Hs = F.H + (8 * x + s) * 4;
    int t = wx; if (t >= nrows) return;
    ESeg rw[16]; u32x4 idn[2], idnn[2]; u32x2 hp[8];
    { u32x4 idc[2]; ids_load(idc, RI16, t, g);
#pragma unroll
      for (int r = 0; r < 16; ++r) eseg_load(rw[r], US, id_of(idc, r, mask) * ESEG + s24); }
#pragma unroll
    for (int c = 0; c < 8; ++c) hp[c] = *(const u32x2*)(Hs + (size_t)t * D + c * 256);
    ids_load(idn, RI16, t + nwx < nrows ? t + nwx : t, g);
    __builtin_amdgcn_s_waitcnt(0);
    for (;;) {
        const int tn = t + nwx, tnn = tn + nwx, tn_c = tn < nrows ? tn : t, tnn_c = tnn < nrows ? tnn : t;
        ids_load(idnn, RI16, tnn_c, g);
        u32x2 hq[8];
#pragma unroll
        for (int c = 0; c < 8; ++c) hq[c] = hp[c];
        __builtin_amdgcn_sched_barrier(0);
#pragma unroll
        for (int c = 0; c < 8; ++c) hp[c] = *(const u32x2*)(Hs + (size_t)tn_c * D + c * 256);
        __builtin_amdgcn_sched_barrier(0);
        float o0 = 0.f, o1 = 0.f;
#pragma unroll
        for (int r = 0; r < 16; ++r) {
            if (MODE == 2) { o0 += __uint_as_float(rw[r].a.x ^ rw[r].a.w ^ rw[r].b.y); eseg_load(rw[r], US, id_of(idn, r, mask) * ESEG + s24); if (r & 1) __builtin_amdgcn_sched_barrier(0); continue; }
            typedef __bf16 bfx2 __attribute__((ext_vector_type(2))); typedef __bf16 bfx32 __attribute__((ext_vector_type(32)));
            const bfx32 rr = __builtin_amdgcn_cvt_scalef32_pk32_bf16_fp6((v6i){(int)rw[r].a.x, (int)rw[r].a.y, (int)rw[r].a.z, (int)rw[r].a.w, (int)rw[r].b.x, (int)rw[r].b.y}, 1.0f);
            float dA = 0.f, dB = 0.f;
#define DOT2(k, acc) acc = __builtin_amdgcn_fdot2_f32_bf16(__builtin_shufflevector(rr, rr, 2 * (k), 2 * (k) + 1), __builtin_bit_cast(bfx2, ((k) & 1) ? hq[(k) >> 1].y : hq[(k) >> 1].x), acc, false)
            DOT2(0, dA); DOT2(1, dB); DOT2(2, dA); DOT2(3, dB); DOT2(4, dA); DOT2(5, dB); DOT2(6, dA); DOT2(7, dB); DOT2(8, dA); DOT2(9, dB); DOT2(10, dA); DOT2(11, dB); DOT2(12, dA); DOT2(13, dB); DOT2(14, dA); DOT2(15, dB);
#undef DOT2
            float d = dA + dB;
            d = dpp_add<0xB1>(d); d = dpp_add<0x4E>(d); d = dpp_add<0x141>(d);
            if ((r >> 1) == s) { if (r & 1) o1 = d; else o0 = d; }
            if (MODE != 1) eseg_load(rw[r], US, id_of(idn, r, mask) * ESEG + s24);
            else asm volatile("" : "+v"(rw[r].a.x), "+v"(rw[r].a.y), "+v"(rw[r].a.z), "+v"(rw[r].a.w), "+v"(rw[r].b.x), "+v"(rw[r].b.y));
            if (r & 1) __builtin_amdgcn_sched_barrier(0);
        }
        *(f32x2*)(P + (size_t)t * 128 + g * 16 + 2 * s) = (f32x2){o0, o1};
        if (tn >= nrows) break;
        t = tn; idn[0] = idnn[0]; idn[1] = idnn[1];
    }
}
DI void phase_peer_w(int nrows, int wv) {
    const Frame F = mkframe(wv);
    const unsigned short* RI = (const unsigned short*)(F.ws + WS_RIDX); const float* RG = (const float*)(F.ws + WS_RG); const float* P = (const float*)(F.ws + WS_PP); float* W = (float*)(F.ws + WS_PW);
    const float* SU = (const float*)(F.ws + WS_ESCALE); const float* SV = SU + NEXP;
    const int n4 = nrows * 32;
    for (int i = blockIdx.x * NTHREADS + F.tid; i < n4; i += F.G * NTHREADS) {
        const u32x2 ep = *(const u32x2*)(RI + (size_t)i * 4); const u32x4 e = {ep.x & 0xffffu, ep.x >> 16, ep.y & 0xffffu, ep.y >> 16}; const f32x4 gt = *(const f32x4*)(RG + (size_t)i * 4);
        f32x4 sum = *(const f32x4*)(P + (size_t)i * 4);
#pragma unroll
        for (int xx = 1; xx < 8; ++xx) sum += *(const f32x4*)(P + (size_t)xx * NTOK * 128 + (size_t)i * 4);
        f32x4 w;
        w.x = gt.x * SV[e.x] * gelu_fast(SU[e.x] * sum.x); w.y = gt.y * SV[e.y] * gelu_fast(SU[e.y] * sum.y); w.z = gt.z * SV[e.z] * gelu_fast(SU[e.z] * sum.z); w.w = gt.w * SV[e.w] * gelu_fast(SU[e.w] * sum.w);
        *(f32x4*)(W + (size_t)i * 4) = w;
    }
}
DI void phase_peer_v(int l, int nrows, int wv, bool dry = false, unsigned mask = 0xffffu) {
    const Frame F = mkframe(wv);
    int x, wx, nwx; xcd_split(F, x, wx, nwx);
    const int lane = F.lane, s = lane & 7, g = lane >> 3, s24 = s * 24;
    const __amdgpu_buffer_rsrc_t VS = __builtin_amdgcn_make_buffer_rsrc((void*)uniform_ptr((unsigned char*)F.V + (size_t)x * ESLICE), 0, (int)ESLICE, 0x00020000);
    const unsigned short* RI16 = (const unsigned short*)(F.ws + WS_RIDX); const float* Wg = (const float*)(F.ws + WS_PW) + g * 16;
    const bool b3 = (lane >> 3) & 1; const int col = (((lane >> 5) * 2 + ((lane >> 4) & 1)) * 2 + (b3 ? 1 : 0)) * 256 + (8 * x + s) * 4;
    int t = wx; if (t >= nrows) return;
    ESeg rw[16]; u32x4 idn[2], idnn[2]; f32x4 wq[4];
    { u32x4 idc[2]; ids_load(idc, RI16, t, g);
#pragma unroll
      for (int r = 0; r < 16; ++r) eseg_load(rw[r], VS, id_of(idc, r, mask) * ESEG + s24); }
#pragma unroll
    for (int q = 0; q < 4; ++q) wq[q] = *(const f32x4*)(Wg + (size_t)t * 128 + q * 4);
    ids_load(idn, RI16, t + nwx < nrows ? t + nwx : t, g);
    __builtin_amdgcn_s_waitcnt(0);
    for (;;) {
        const int tn = t + nwx, tnn = tn + nwx, tn_c = tn < nrows ? tn : t, tnn_c = tnn < nrows ? tnn : t;
        ids_load(idnn, RI16, tnn_c, g);
        float wt[16];
#pragma unroll
        for (int q = 0; q < 4; ++q) { wt[q * 4] = wq[q].x; wt[q * 4 + 1] = wq[q].y; wt[q * 4 + 2] = wq[q].z; wt[q * 4 + 3] = wq[q].w; }
#pragma unroll
        for (int q = 0; q < 16; ++q) asm volatile("" : "+v"(wt[q]));
        __builtin_amdgcn_sched_barrier(0);
#pragma unroll
        for (int q = 0; q < 4; ++q) wq[q] = *(const f32x4*)(Wg + (size_t)tn_c * 128 + q * 4);
        float* xp = F.X + (size_t)t * D + col;
        const f32x4 x1 = *(const f32x4*)xp, g2 = *(const f32x4*)(F.mod + ((size_t)l * 9 + modrow(t)) * MODW + 5 * D + col);
        __builtin_amdgcn_sched_barrier(0);
        f32x2 fa[16];
#pragma unroll
        for (int j = 0; j < 16; ++j) fa[j] = (f32x2){0.f, 0.f};
#pragma unroll
        for (int r = 0; r < 16; ++r) {
            const v32f rr = eseg_unpack(rw[r]); const f32x2 w2 = {wt[r], wt[r]};
#pragma unroll
            for (int j = 0; j < 16; ++j) fa[j] = __builtin_elementwise_fma((f32x2){rr[2 * j], rr[2 * j + 1]}, w2, fa[j]);
            eseg_load(rw[r], VS, id_of(idn, r, mask) * ESEG + s24);
            if (r & 1) __builtin_amdgcn_sched_barrier(0);
        }
        float f16[16], f8[8];
#pragma unroll
        for (int j = 0; j < 16; ++j) { const float lo = (j & 1) ? fa[j >> 1].y : fa[j >> 1].x, hi = (j & 1) ? fa[8 + (j >> 1)].y : fa[8 + (j >> 1)].x;
            const auto a = __builtin_amdgcn_permlane32_swap(__float_as_uint(lo), __float_as_uint(hi), false, false); f16[j] = __uint_as_float(a[0]) + __uint_as_float(a[1]); }
#pragma unroll
        for (int j = 0; j < 8; ++j) { const auto a = __builtin_amdgcn_permlane16_swap(__float_as_uint(f16[j]), __float_as_uint(f16[j + 8]), false, false); f8[j] = __uint_as_float(a[0]) + __uint_as_float(a[1]); }
#pragma unroll
        for (int j = 0; j < 8; ++j) f8[j] = dpp_add<0x128>(f8[j]);
        f32x4 z;
        z.x = ALPHA * x1.x + g2.x * (b3 ? f8[4] : f8[0]); z.y = ALPHA * x1.y + g2.y * (b3 ? f8[5] : f8[1]); z.z = ALPHA * x1.z + g2.z * (b3 ? f8[6] : f8[2]); z.w = ALPHA * x1.w + g2.w * (b3 ? f8[7] : f8[3]);
        if (!dry) *(f32x4*)xp = z;
        if (tn >= nrows) break;
        t = tn; idn[0] = idnn[0]; idn[1] = idnn[1];
    }
}
DI void load16_f32(const float* src, int lane, float (&v)[32]) {
#pragma unroll
    for (int c = 0; c < 8; ++c) { const f32x4 a = *(const f32x4*)(src + c * 256 + lane * 4); v[c * 4 + 0] = a.x; v[c * 4 + 1] = a.y; v[c * 4 + 2] = a.z; v[c * 4 + 3] = a.w; }
}
DI void store16_f32(float* dst, int lane, const float (&v)[32]) {
#pragma unroll
    for (int c = 0; c < 8; ++c) *(f32x4*)(dst + c * 256 + lane * 4) = (f32x4){v[c * 4 + 0], v[c * 4 + 1], v[c * 4 + 2], v[c * 4 + 3]};
}
DI void phase_peer_ln2(int l, int nrows, bool last, int wv) {
    const Frame T = mkframe(wv);
    const int lane = T.lane;
    const float* lg2 = inp(I_LN2G) + (size_t)l * D; const float* lb2 = inp(I_LN2B) + (size_t)l * D;
#define CBAR() asm volatile("" ::: "memory")
    for (int r = blockIdx.x * NWAVES + T.wave; r < nrows; r += T.G * NWAVES) {
        float v[32];
        load16_f32(T.X + (size_t)r * D, lane, v);
        row_normalize(v);
        { float t[32]; load16_f32(lg2, lane, t);
#pragma unroll
          for (int i = 0; i < 32; ++i) v[i] *= t[i]; }
        CBAR();
        { float t[32]; load16_f32(lb2, lane, t);
#pragma unroll
          for (int i = 0; i < 32; ++i) v[i] += t[i]; }
        CBAR();
        store16_f32(last ? T.out + (size_t)r * D : T.X + (size_t)r * D, lane, v);
        if (!last) {
            const float* mdn = T.mod + ((size_t)(l + 1) * 9 + modrow(r)) * MODW;
            row_normalize(v);
            CBAR();
            { float t[32]; load16_f32(mdn + 1 * D, lane, t);
#pragma unroll
              for (int i = 0; i < 32; ++i) v[i] *= (1.0f + t[i]); }
            CBAR();
            { float t[32]; load16_f32(mdn + 0 * D, lane, t);
#pragma unroll
              for (int i = 0; i < 32; ++i) v[i] += t[i]; }
#pragma unroll
            for (int c = 0; c < 8; ++c) { u32x2 wv2; wv2.x = pk2(v[c * 4 + 0], v[c * 4 + 1]); wv2.y = pk2(v[c * 4 + 2], v[c * 4 + 3]);
                *(u32x2*)(T.H + (size_t)r * D + c * 256 + lane * 4) = wv2;
                *(unsigned*)(T.ws + WS_H8 + (size_t)r * D + c * 256 + lane * 4) = pk4_fp8(v[c * 4 + 0] * SA8_H, v[c * 4 + 1] * SA8_H, v[c * 4 + 2] * SA8_H, v[c * 4 + 3] * SA8_H); }
        }
        CBAR();
    }
#undef CBAR
}

#ifndef MK_N_LAUNCHES
#define MK_N_LAUNCHES 1
#endif
constexpr int PH_PER_LAYER = 15, N_PHASES = DEPTH * PH_PER_LAYER;
struct Args { const float* in[N_IN]; float* out; unsigned char* ws; int ph_lo, ph_hi; };
static_assert(sizeof(Args) == N_IN * 8 + 8 + 8 + 8, "Args has no padding");

struct OrderW8 : pg8::StaticOrder {
    int base, c_lo, nctx;
    __device__ void init3(int M_, int N_, int G_, int c_, int base_, int c_lo_, int nctx_) { init(M_, N_, G_, c_); base = base_; c_lo = c_lo_; nctx = nctx_; }
    __device__ bool unit_of(long L, pg8::Unit& u) const {
        if (L < nwg) { pg8::StaticOrder t = *this; t.c = (int)(L % G); return t.pg8::StaticOrder::next((int)(L / G), u); }
        const int r = (int)(L - nwg); if (r >= nctx) return false;
        u.pm = NLAT / 256 + (r & 7); u.pn = C_ZF / 256 + (r >> 3); return true;
    }
    __device__ bool next(int i, pg8::Unit& u) const {
        if (i < base) return unit_of((long)i * G + c, u);
        if (c < c_lo) return false;
        return unit_of((long)base * G + (long)(i - base) * (G - c_lo) + (c - c_lo), u);
    }
};
__global__ void __launch_bounds__(NTHREADS, 2) mk_fwd(Args args) {
    LAS unsigned char* ldsl = (LAS unsigned char*)lds_raw;
    for (int u = threadIdx.x; u < (LDS_BYTES - LDSCTL_OFF) / 4; u += NTHREADS) ((LAS unsigned*)(ldsl + LDSCTL_OFF))[u] = 0u;
    __syncthreads();
    if (threadIdx.x < N_IN + 2) { const int i = threadIdx.x; const unsigned long long v = i < N_IN ? (unsigned long long)args.in[i] : (i == N_IN ? (unsigned long long)args.out : (unsigned long long)args.ws);
        ((volatile LAS unsigned long long*)(ldsl + PTR_OFF))[i] = v; }
    __syncthreads();
    unsigned char* ws = as_global<unsigned char>(ld_ptr(N_IN + 1));
    const int wv = __builtin_amdgcn_readfirstlane(threadIdx.x >> 6);
    const int lo = args.ph_lo, hi = args.ph_hi;
    const bool multi = (hi - lo) > 1;
    XcdBarrier bar; bar.bar = (unsigned*)(ws + WS_CTL) + CW_BAR; bar.x = 0; bar.st = nullptr; bar.wv = wv;
    if (multi) bar = xcd_barrier_post((unsigned*)(ws + WS_CTL) + CW_BAR, (volatile LAS unsigned*)(ldsl + MISC_OFF) + 8, wv);
#ifndef PH_MASK
#define PH_MASK 0x7fff
#endif
#define IN(k) (((PH_MASK >> ((k) % PH_PER_LAYER)) & 1) && lo <= (k) && (k) < hi)
#define WSO() ({ unsigned long long _w = (unsigned long long)ws; asm volatile("" : "+s"(_w)); as_global<unsigned char>(_w); })
#define SEAM(k) do { if (IN(k) && IN((k) + 1)) xcd_barrier(bar); } while (0)

    for (int l = 0; l < DEPTH; ++l) {
        const int pb = l * PH_PER_LAYER;
        const bool last = (l == DEPTH - 1);
        const int nrows = last ? NLAT : NTOK;
        if (IN(pb + 0)) { phase_convert(l, wv, gridDim.x != 256); if (l == 0) phase_mod(wv);
#ifdef DUP_P0
            if (l == 0) { __syncthreads(); phase_convert(l, wv, gridDim.x != 256); phase_mod(wv); }
#endif
        }
        SEAM(pb + 0);
        if (IN(pb + 1) && l == 0) { phase_modulate1(l, wv);
#ifdef DUP_P1
            if (l == 0) { phase_modulate1(l, wv); phase_modulate1(l, wv); phase_modulate1(l, wv); phase_modulate1(l, wv); }
#endif
        }
        if (l == 0) SEAM(pb + 1);
        if (IN(pb + 2)) { unsigned char* wsl = WSO();
            {
                pg8::Gemm g{(bf16*)(wsl + WS_H), (bf16*)(wsl + WS_WIN), NTOK, 2 * DC, D, D}; pg8::StaticOrder S; S.init(NTOK, 2 * DC, (int)gridDim.x, (int)blockIdx.x);
                EpiStore E{(bf16*)(wsl + WS_PROJ) + C_ZF, INW, 1.0f, 1 << 30, 0};
                pg8::gemm_phase<EpiStore, pg8::StaticOrder, true, true>(ldsl, g, S, E, wv); }
            {
                const int mrows = last ? NLAT : NTOK;
                pg8::Gemm g{(bf16*)(wsl + WS_H8), (bf16*)(wsl + WS_WIN8), mrows, 10 * DC, D / 2, D / 2}; OrderW8 S;
                if (gridDim.x == 256) S.init3(mrows, 10 * DC, 256, (int)blockIdx.x, 9, 64, last ? 32 : 0);
                else S.init3(mrows, 10 * DC, (int)gridDim.x, (int)blockIdx.x, 1 << 20, 0, last ? 32 : 0);
                EpiStore E{(bf16*)(wsl + WS_PROJ), INW, 1.0f / (SW8 * SA8_H), C_ZF / 256, C_VI - C_ZF};
                pg8::gemm_phase<EpiStore, OrderW8, true, true, true>(ldsl, g, S, E, wv); }
        }
        SEAM(pb + 2);
        if (IN(pb + 3)) {
#ifdef DUP_PREP
            if (l == 0) phase_prep(l, wv, gridDim.x != 1);
#endif
            phase_prep(l, wv); }
        SEAM(pb + 3);
        if (IN(pb + 4)) { phase_scan(l, wv, gridDim.x == 256);
#ifdef DUP_P3
            if (l == 0) phase_scan(l, wv, gridDim.x == 256);
#endif
        }
        SEAM(pb + 4);
        if (IN(pb + 5)) phase_readout(l, nrows, wv);
        SEAM(pb + 5);
        if (IN(pb + 6)) { unsigned char* wsl = WSO(); pg8::Gemm g{(bf16*)(wsl + WS_H), (bf16*)(wsl + WS_WPA), nrows, D, D / 2, D / 2}; pg8::StaticOrder S; S.init(nrows, D, (int)gridDim.x, (int)blockIdx.x);
            EpiMerge E{(bf16*)(wsl + WS_PROJ) + C_GA, (bf16*)(wsl + WS_PROJ) + C_GB, INW, (bf16*)(wsl + WS_Y), D};
            pg8::gemm_phase<EpiMerge, pg8::StaticOrder, true, true, true>(ldsl, g, S, E, wv); }
        SEAM(pb + 6);
        if (IN(pb + 7)) { unsigned char* wsl = WSO(); pg8::Gemm g{(bf16*)(wsl + WS_Y), (bf16*)(wsl + WS_WO), nrows, D, D / 2, D / 2}; pg8::StaticOrder S; S.init(nrows, D, (int)gridDim.x, (int)blockIdx.x); EpiStore E{(bf16*)(wsl + WS_H), D, 1.0f / (SW8 * SA8_M), 1 << 30, 0};
            pg8::gemm_phase<EpiStore, pg8::StaticOrder, true, true, true>(ldsl, g, S, E, wv); }
        SEAM(pb + 7);
        if (IN(pb + 8)) phase_ln1(l, nrows, wv);
        SEAM(pb + 8);
        if (IN(pb + 9)) { unsigned char* wsl = WSO(); pg8::Gemm g{(bf16*)(wsl + WS_H), (bf16*)(wsl + WS_WQ), nrows, D, D, D}; pg8::StaticOrder S; S.init(nrows, D, (int)gridDim.x, (int)blockIdx.x); EpiStore E{(bf16*)(wsl + WS_Y), D, 1.0f, 1 << 30, 0};
            pg8::gemm_phase<EpiStore, pg8::StaticOrder, true, true>(ldsl, g, S, E, wv); }
        SEAM(pb + 9);

        if (IN(pb + 10)) { phase_peer_route(nrows, wv);
#ifdef DUP_RT
            if (last) phase_peer_route(nrows, wv);
#endif
        }
        SEAM(pb + 10);
        if (IN(pb + 11)) {
#ifdef DUP_PU
            if (last) phase_peer_u(nrows, wv, DUP_PU);
#endif
            phase_peer_u(nrows, wv); }
        SEAM(pb + 11);
        if (IN(pb + 12)) phase_peer_w(nrows, wv);
        SEAM(pb + 12);
        if (IN(pb + 13)) {
#ifdef DUP_PV
            if (last) phase_peer_v(l, nrows, wv, gridDim.x != 1, DUP_PV);
#endif
            phase_peer_v(l, nrows, wv); }
        SEAM(pb + 13);
        if (IN(pb + 14)) { phase_peer_ln2(l, nrows, last, wv);
#ifdef DUP_LN2
            if (last) { phase_peer_ln2(l, nrows, last, wv); phase_peer_ln2(l, nrows, last, wv); }
#endif
        }
        SEAM(pb + 14);
    }
#undef IN
#undef SEAM
}

extern "C" void kernel_launch(void* const* d_in, const int* in_sizes, int n_in, void* d_out, int out_size, void* d_ws, size_t ws_size, hipStream_t stream) {
    static int grid = 0;
    if (grid == 0) {
        if (n_in != N_IN || in_sizes[I_X] != NLAT * D || out_size != NLAT * D || ws_size < WS_H8 + 36 * MiB) { fprintf(stderr, "kernel_launch: unexpected shapes (n_in %d, ws %zu); nothing launched\n", n_in, ws_size); grid = -1; return; }
        int dev = 0, cus = 0, per_cu = 0;
        if (hipGetDevice(&dev) != hipSuccess || hipDeviceGetAttribute(&cus, hipDeviceAttributeMultiprocessorCount, dev) != hipSuccess) { grid = -1; return; }
        if (hipFuncSetAttribute((const void*)mk_fwd, hipFuncAttributeMaxDynamicSharedMemorySize, LDS_BYTES) != hipSuccess) { fprintf(stderr, "kernel_launch: hipFuncSetAttribute failed\n"); grid = -1; return; }
        if (hipOccupancyMaxActiveBlocksPerMultiprocessor(&per_cu, (const void*)mk_fwd, NTHREADS, LDS_BYTES) != hipSuccess || per_cu < 1) { fprintf(stderr, "kernel_launch: occupancy query says %d\n", per_cu); per_cu = 1; }
        (void)hipGetLastError();
        grid = cus;
        if ((NTOK + grid - 1) / grid > 96) { fprintf(stderr, "kernel_launch: %d CUs: the PEER phase holds at most 96 tokens per workgroup in LDS; nothing launched\n", cus); grid = -1; return; }
    }
    if (grid < 0) return;
    if (hipMemsetAsync((char*)d_ws + WS_CTL + (size_t)CW_BAR * 4, 0, (size_t)XCD_BAR_WORDS * 4, stream) != hipSuccess) return;
    Args a{};
    for (int i = 0; i < N_IN; ++i) a.in[i] = (const float*)d_in[i];
    a.out = (float*)d_out; a.ws = (unsigned char*)d_ws;
#if MK_N_LAUNCHES == 1
    a.ph_lo = 0; a.ph_hi = N_PHASES;
    hipLaunchKernelGGL(mk_fwd, dim3(grid), dim3(NTHREADS), LDS_BYTES, stream, a);
#else
    for (int p = 0; p < N_PHASES; ++p) { a.ph_lo = p; a.ph_hi = p + 1; hipLaunchKernelGGL(mk_fwd, dim3(grid), dim3(NTHREADS), LDS_BYTES, stream, a); }
#endif
}
```

```cpp
#include <hip/hip_runtime.h>
#include <stdint.h>
#include <stdio.h>

#define MK_N_LAUNCHES 1
namespace pg8 {
#define PG8_LAS __attribute__((address_space(3)))
typedef unsigned short bf16_t;
typedef short bf16x8 __attribute__((ext_vector_type(8)));
typedef float f32x4 __attribute__((ext_vector_type(4)));
typedef unsigned u32x4 __attribute__((ext_vector_type(4)));
constexpr int BM = 256, BK = 64, HALF = 128, HTB = HALF * BK * 2  , STAGE_BYTES = 8 * HTB, NXCD = 8, WGM = 8;

__host__ __device__ __forceinline__ int lds_byte(int r, int c) { const int st = (r >> 4) * 2 + (c >> 5), rr = r & 15, cc = c & 31, ob = rr * 64 + cc * 2; return st * 1024 + (ob ^ (((ob >> 9) & 1) << 5)); }
__host__ __device__ __forceinline__ void stage_rc(int b, int& R, int& C) { const int st = b / 1024, sb = b % 1024, swz = sb ^ (((sb >> 9) & 1) << 5); R = (st >> 1) * 16 + swz / 64; C = (st & 1) * 32 + (swz % 64) / 2; }
__host__ __device__ __forceinline__ int perm32(int rho) { const int n = rho >> 4, i = rho & 15; return 8 * (i >> 2) + 4 * n + (i & 3); }

struct Unit { int pm, pn; };
struct Gemm { const bf16_t* A; const bf16_t* Bt; int M, N, K, lda; };

struct StaticOrder {
    int nM, nN, nwg, G, c;
    __host__ __device__ void init(int M, int N, int G_, int c_) { nM = M / BM; nN = N / BM; nwg = nM * nN; G = G_; c = c_; }
    __host__ __device__ bool next(int i, Unit& u) const {
        const long L = (long)i * G + c; if (L >= nwg) return false;
        int wgid = (int)L; { const int q = nwg / NXCD, r = nwg % NXCD, xcd = wgid % NXCD, off = wgid / NXCD; wgid = (xcd < r ? xcd * (q + 1) : r * (q + 1) + (xcd - r) * q) + off; }
        const int nig = WGM * nN, gid = wgid / nig, fm = gid * WGM, gsz = (nM - fm) < WGM ? (nM - fm) : WGM;
        u.pm = fm + ((wgid % nig) % gsz); u.pn = (wgid % nig) / gsz; return true;
    }
    __device__ __forceinline__ void a_ready(const Unit&) const {}
    __device__ __forceinline__ void done(const Unit&) const {}
};

__device__ __forceinline__ unsigned cvt_pk_bf16(float lo, float hi) { unsigned r; asm volatile("v_cvt_pk_bf16_f32 %0, %1, %2" : "=v"(r) : "v"(lo), "v"(hi)); return r; }
typedef float f32x2 __attribute__((ext_vector_type(2)));
typedef int i32x4 __attribute__((ext_vector_type(4)));
typedef int i32x8 __attribute__((ext_vector_type(8)));
__device__ __forceinline__ i32x8 cat8(bf16x8 lo, bf16x8 hi) { const i32x4 a = __builtin_bit_cast(i32x4, lo), b = __builtin_bit_cast(i32x4, hi); return __builtin_shufflevector(a, b, 0, 1, 2, 3, 4, 5, 6, 7); }
template <class Epi, class Sched, bool ALIGN_EPI = false, bool SP2 = false, bool F8 = false>
__device__ __forceinline__ void gemm_phase(PG8_LAS unsigned char* lds, const Gemm g, const Sched& S, const Epi& E, int wv) {
    int tid_ = wv * 64 + (int)__builtin_amdgcn_mbcnt_hi(~0u, __builtin_amdgcn_mbcnt_lo(~0u, 0u)); asm volatile("" : "+v"(tid_));
    const int tid = tid_, wid = __builtin_amdgcn_readfirstlane(tid >> 6), lane = tid & 63, wr = wid >> 2, wc = wid & 3, fr = lane & 15, fq = lane >> 4;
    const int K = g.K, nt = K / BK;
    unsigned voffA[2], voffB[2];
#pragma unroll
    for (int i = 0; i < 2; ++i) { int R, C; stage_rc(tid * 16 + i * 8192, R, C); const int Rb = Epi::PERM ? ((R & ~31) + perm32(R & 31)) : R;
        voffA[i] = (unsigned)(R * g.lda + C) * 2u; voffB[i] = (unsigned)(Rb * K + C) * 2u; }
    const size_t kstep = (size_t)(BK * 2);
    const size_t hstepA = (size_t)HALF * g.lda * 2, hstepB = (size_t)HALF * K * 2;
    const size_t tstepA = 2 * hstepA, tstepB = 2 * hstepB;
    const unsigned ldsw = (unsigned)wid * 1024u;
    const int aoff = lds_byte(wr * 64 + fr, fq * 8), boff = SP2 ? lds_byte((wc & 1) * 64 + fr, fq * 8) : lds_byte(wc * 32 + fr, fq * 8); const int hw = wc >> 1;
#define PG8_SA(b, h) (((b) * 2 + (h)) * HTB)
#define PG8_SB(b, h) ((4 + (b) * 2 + (h)) * HTB)
#define PG8_STAGE(bufoff, gbase, voff) do { _Pragma("unroll") for (int _i = 0; _i < 2; ++_i) \
        __builtin_amdgcn_global_load_lds((const unsigned*)((const char*)(gbase) + (voff)[_i]), (PG8_LAS unsigned*)(lds + (bufoff) + ldsw + _i * 8192), 16, 0, 0); } while (0)
#define PG8_LDA(dst, b, h) do { _Pragma("unroll") for (int m = 0; m < 4; ++m) _Pragma("unroll") for (int k = 0; k < 2; ++k) dst[m][k] = *(const PG8_LAS bf16x8*)(lds + PG8_SA(b, h) + aoff + m * 2048 + k * 1024); } while (0)
#define PG8_LDB(dst, b, h) do { _Pragma("unroll") for (int n = 0; n < 2; ++n) _Pragma("unroll") for (int k = 0; k < 2; ++k) dst[n][k] = *(const PG8_LAS bf16x8*)(lds + (SP2 ? PG8_SB(b, hw) + (h) * 4096 : PG8_SB(b, h)) + boff + n * 2048 + k * 1024); } while (0)
#define PG8_MMA(ai, bj, At, Bt) do { __builtin_amdgcn_s_setprio(1); _Pragma("unroll") for (int m = 0; m < 4; ++m) _Pragma("unroll") for (int n = 0; n < 2; ++n) { \
        if constexpr (F8) { const i32x8 _b = cat8(Bt[n][0], Bt[n][1]), _a = cat8(At[m][0], At[m][1]); asm volatile("v_mfma_f32_16x16x128_f8f6f4 %0, %1, %2, %0" : "+v"(acc[ai][bj][m][n]) : "v"(_b), "v"(_a)); } \
        else { _Pragma("unroll") for (int k = 0; k < 2; ++k) acc[ai][bj][m][n] = __builtin_amdgcn_mfma_f32_16x16x32_bf16(Bt[n][k], At[m][k], acc[ai][bj][m][n], 0, 0, 0); } } \
        __builtin_amdgcn_s_setprio(0); } while (0)
#define PG8_WAIT_V(n) asm volatile("s_waitcnt vmcnt(" #n ")" ::: "memory")
#define PG8_WAIT_L(n) asm volatile("s_waitcnt lgkmcnt(" #n ")" ::: "memory")
#define PG8_BAR __builtin_amdgcn_s_barrier()
#define PG8_SCHED __builtin_amdgcn_sched_barrier(0)
    Unit cur, nxt; int ui = 0;
    if (!S.next(0, cur)) return;
    f32x4 acc[2][2][4][2];
#pragma unroll
    for (int a = 0; a < 2; ++a)
#pragma unroll
        for (int b = 0; b < 2; ++b)
#pragma unroll
            for (int m = 0; m < 4; ++m)
#pragma unroll
                for (int n = 0; n < 2; ++n) acc[a][b][m][n] = (f32x4){0.f, 0.f, 0.f, 0.f};
    bf16x8 At[4][2], B0[2][2], B1[2][2];
    const char* cA = (const char*)g.A + (size_t)cur.pm * tstepA; const char* cB = (const char*)g.Bt + (size_t)cur.pn * tstepB;
    S.a_ready(cur);
    if constexpr (SP2) {
        PG8_STAGE(PG8_SB(0, 0), cB, voffB); PG8_STAGE(PG8_SB(0, 1), cB + hstepB, voffB); PG8_STAGE(PG8_SA(0, 0), cA, voffA); PG8_STAGE(PG8_SA(0, 1), cA + hstepA, voffA);
        if (wr == 1) PG8_BAR;
        PG8_WAIT_V(2); PG8_BAR;
        PG8_STAGE(PG8_SB(1, 0), cB + kstep, voffB); PG8_STAGE(PG8_SA(1, 0), cA + kstep, voffA); PG8_STAGE(PG8_SB(1, 1), cB + hstepB + kstep, voffB);
        PG8_WAIT_V(6); PG8_BAR;
    } else {
        PG8_STAGE(PG8_SB(0, 0), cB, voffB); PG8_STAGE(PG8_SA(0, 0), cA, voffA); PG8_STAGE(PG8_SB(0, 1), cB + hstepB, voffB); PG8_STAGE(PG8_SA(0, 1), cA + hstepA, voffA);
        if (wr == 1) PG8_BAR;
        PG8_WAIT_V(4); PG8_BAR;
        PG8_STAGE(PG8_SB(1, 0), cB + kstep, voffB); PG8_STAGE(PG8_SA(1, 0), cA + kstep, voffA); PG8_STAGE(PG8_SB(1, 1), cB + hstepB + kstep, voffB);
        PG8_WAIT_V(6); PG8_BAR;
    }
    for (;;) {
        const bool has_next = S.next(ui + 1, nxt);
        const char* nA = has_next ? (const char*)g.A + (size_t)nxt.pm * tstepA : cA; const char* nB = has_next ? (const char*)g.Bt + (size_t)nxt.pn * tstepB : cB;
        for (int t = 0; t < nt; t += 2) {
            if constexpr (Epi::MIDK) { if (t == nt / 2) { if constexpr (F8) asm volatile("s_nop 15\n\ts_nop 15" ::: "memory"); E.mid(acc, cur, wr, wc, fr, fq); } }
            const bool last = (t == nt - 2);
            const char* a1 = cA + (size_t)(t + 1) * kstep;
            const char* a2 = last ? nA : cA + (size_t)(t + 2) * kstep; const char* b2 = last ? nB : cB + (size_t)(t + 2) * kstep;
            const char* a3 = a2 + kstep; const char* b3 = b2 + kstep;
            if (last && has_next) S.a_ready(nxt);
            if constexpr (SP2) {
            PG8_LDB(B0, 0, 0); PG8_LDB(B1, 0, 1); PG8_SCHED; PG8_LDA(At, 0, 0); PG8_STAGE(PG8_SA(1, 1), a1 + hstepA, voffA);
            PG8_WAIT_V(8); PG8_WAIT_L(0); PG8_BAR; PG8_MMA(0, 0, At, B0); PG8_MMA(0, 1, At, B1); PG8_BAR; PG8_SCHED;
            PG8_LDA(At, 0, 1); PG8_STAGE(PG8_SB(0, 0), b2, voffB); PG8_STAGE(PG8_SB(0, 1), b2 + hstepB, voffB); PG8_STAGE(PG8_SA(0, 0), a2, voffA);
            PG8_WAIT_V(8); PG8_WAIT_L(0); PG8_BAR; PG8_MMA(1, 0, At, B0); PG8_MMA(1, 1, At, B1); PG8_BAR; PG8_SCHED;
            PG8_LDB(B0, 1, 0); PG8_LDB(B1, 1, 1); PG8_SCHED; PG8_LDA(At, 1, 0); PG8_STAGE(PG8_SA(0, 1), a2 + hstepA, voffA);
            PG8_WAIT_V(8); PG8_WAIT_L(0); PG8_BAR; PG8_MMA(0, 0, At, B0); PG8_MMA(0, 1, At, B1); PG8_BAR; PG8_SCHED;
            PG8_LDA(At, 1, 1); PG8_STAGE(PG8_SB(1, 0), b3, voffB); PG8_STAGE(PG8_SB(1, 1), b3 + hstepB, voffB); PG8_STAGE(PG8_SA(1, 0), a3, voffA);
            PG8_WAIT_V(8); PG8_WAIT_L(0); PG8_BAR; PG8_MMA(1, 0, At, B0); PG8_MMA(1, 1, At, B1); PG8_BAR; PG8_SCHED;
            } else {
            PG8_LDB(B0, 0, 0); PG8_SCHED; PG8_LDA(At, 0, 0); PG8_STAGE(PG8_SA(1, 1), a1 + hstepA, voffA);
            PG8_WAIT_L(8); PG8_BAR; PG8_WAIT_L(0); PG8_MMA(0, 0, At, B0); PG8_BAR; PG8_SCHED;
            PG8_LDB(B1, 0, 1); PG8_STAGE(PG8_SB(0, 0), b2, voffB);
            PG8_BAR; PG8_WAIT_L(0); PG8_MMA(0, 1, At, B1); PG8_BAR;
            PG8_LDA(At, 0, 1); PG8_STAGE(PG8_SA(0, 0), a2, voffA);
            PG8_BAR; PG8_WAIT_L(0); PG8_MMA(1, 0, At, B0); PG8_BAR; PG8_SCHED;
            PG8_STAGE(PG8_SB(0, 1), b2 + hstepB, voffB);
            PG8_WAIT_V(6); PG8_BAR; PG8_MMA(1, 1, At, B1); PG8_BAR;
            PG8_LDB(B0, 1, 0); PG8_SCHED; PG8_LDA(At, 1, 0); PG8_STAGE(PG8_SA(0, 1), a2 + hstepA, voffA);
            PG8_WAIT_L(8); PG8_BAR; PG8_WAIT_L(0); PG8_MMA(0, 0, At, B0); PG8_BAR; PG8_SCHED;
            PG8_LDB(B1, 1, 1); PG8_STAGE(PG8_SB(1, 0), b3, voffB);
            PG8_BAR; PG8_WAIT_L(0); PG8_MMA(0, 1, At, B1); PG8_BAR;
            PG8_LDA(At, 1, 1); PG8_STAGE(PG8_SA(1, 0), a3, voffA);
            PG8_BAR; PG8_WAIT_L(0); PG8_MMA(1, 0, At, B0); PG8_BAR; PG8_SCHED;
            PG8_STAGE(PG8_SB(1, 1), b3 + hstepB, voffB);
            PG8_WAIT_V(6); PG8_BAR; PG8_MMA(1, 1, At, B1); PG8_BAR;
            }
        }
        if constexpr (F8) asm volatile("s_nop 15\n\ts_nop 15" ::: "memory");
        if constexpr (ALIGN_EPI) { if (wr == 0) PG8_BAR; }
        if constexpr (!Epi::AFTER_DRAIN) { E(acc, cur, wr, wc, fr, fq); S.done(cur); }
        if (!has_next) break;
#pragma unroll
        for (int a = 0; a < 2; ++a)
#pragma unroll
            for (int b = 0; b < 2; ++b)
#pragma unroll
                for (int m = 0; m < 4; ++m)
#pragma unroll
                    for (int n = 0; n < 2; ++n) acc[a][b][m][n] = (f32x4){0.f, 0.f, 0.f, 0.f};
        cur = nxt; cA = nA; cB = nB; ++ui;
        if constexpr (ALIGN_EPI) { if (wr == 1) PG8_BAR; }
    }
    PG8_WAIT_V(0);
    if constexpr (!ALIGN_EPI) { if (wr == 0) PG8_BAR; }
    PG8_BAR;
    if constexpr (Epi::AFTER_DRAIN) { E.fused(acc, cur, wr, wc, fr, fq, lds, wid, lane); S.done(cur); }
#undef PG8_SA
#undef PG8_SB
#undef PG8_STAGE
#undef PG8_LDA
#undef PG8_LDB
#undef PG8_MMA
#undef PG8_WAIT_V
#undef PG8_WAIT_L
#undef PG8_BAR
#undef PG8_SCHED
}
}


#define LAS __attribute__((address_space(3)))
#define XB_TMO      128
#define XB_XCNT(j)  (256  + 64 * (j))
#define XB_XSUB(j)  (1280 + 64 * (j))
#define XB_XGEN(j)  (2304 + 64 * (j))
#define XB_TOP      3328
#define XB_TOPGEN   3392
#define XCD_BAR_WORDS 3456
#define XB_SPIN_CAP (1u << 20)

__device__ __forceinline__ unsigned xb_ld(unsigned* p)              { return __hip_atomic_load(p, __ATOMIC_RELAXED, __HIP_MEMORY_SCOPE_AGENT); }
__device__ __forceinline__ unsigned xb_add(unsigned* p, unsigned v) { return __hip_atomic_fetch_add(p, v, __ATOMIC_RELAXED, __HIP_MEMORY_SCOPE_AGENT); }
__device__ __forceinline__ unsigned xb_xcc_id() { return (unsigned)__builtin_amdgcn_s_getreg((3 << 11) | 20) & 0xFu; }
#define XB_SPIN(cond, bar) do { unsigned _sp = 0; while (cond) { __builtin_amdgcn_s_sleep(1); \
    if ((++_sp & 255u) == 0u) { if (xb_ld(&(bar)[XB_TMO])) break; if (_sp > XB_SPIN_CAP) { atomicAdd(&(bar)[XB_TMO], 1u); break; } } } } while (0)

struct XcdBarrier {
    unsigned* bar; unsigned x; int wv;
    volatile LAS unsigned* st;
};

__device__ __forceinline__ XcdBarrier xcd_barrier_post(unsigned* bar, volatile LAS unsigned* st, int wv) {
    XcdBarrier b; b.bar = bar; b.x = xb_xcc_id(); b.st = st; b.wv = wv;
    if (threadIdx.x == 0) (void)xb_add(&bar[XB_XCNT(b.x)], 1u);
    return b;
}
__device__ __forceinline__ void xcd_barrier_complete(unsigned* bar, unsigned x, unsigned& nloc, unsigned& nx) {
    const unsigned G = gridDim.x * gridDim.y * gridDim.z;
    unsigned sum, cnt, mine, sp = 0u;
    for (;;) {
        sum = 0u; cnt = 0u; mine = 0u;
#pragma unroll
        for (unsigned j = 0; j < 16; ++j) { const unsigned c = xb_ld(&bar[XB_XCNT(j)]); sum += c; cnt += (c > 0u) ? 1u : 0u; mine = (j == x) ? c : mine; }
        if (sum == G) break;
        __builtin_amdgcn_s_sleep(1);
        if ((++sp & 255u) == 0u) { if (xb_ld(&bar[XB_TMO])) break; if (sp > XB_SPIN_CAP) { atomicAdd(&bar[XB_TMO], 1u); break; } }
    }
    nloc = mine > 0u ? mine : 1u; nx = cnt > 0u ? cnt : 1u;
}

__device__ __forceinline__ void xcd_barrier(const XcdBarrier& b) {
    asm volatile("s_waitcnt vmcnt(0)" ::: "memory");
    __syncthreads();
    unsigned xb_z = 0u; asm volatile("" : "+v"(xb_z));
    if (b.wv == 0 && __builtin_amdgcn_mbcnt_hi(~0u, __builtin_amdgcn_mbcnt_lo(~0u, xb_z)) == 0u) {
        unsigned* bar = b.bar;
        __builtin_amdgcn_s_waitcnt(0);
        unsigned nloc = b.st[0], nx = b.st[1];
        if (nloc == 0u) { xcd_barrier_complete(bar, b.x, nloc, nx); b.st[0] = nloc; b.st[1] = nx; }
        const unsigned old = xb_add(&bar[XB_XSUB(b.x)], 1u);
        const unsigned gen = old / nloc;
        if (old + 1u == (gen + 1u) * nloc) {
            __builtin_amdgcn_fence(__ATOMIC_RELEASE, "agent");
            asm volatile("s_waitcnt vmcnt(0)" ::: "memory");
            const unsigned og = xb_add(&bar[XB_TOP], 1u);
            const unsigned tg = og / nx;
            if (og + 1u == (tg + 1u) * nx) xb_add(&bar[XB_TOPGEN], 1u);
            else XB_SPIN(xb_ld(&bar[XB_TOPGEN]) == tg, bar);
            __builtin_amdgcn_fence(__ATOMIC_ACQUIRE, "agent");
            xb_add(&bar[XB_XGEN(b.x)], 1u);
            asm volatile("s_waitcnt vmcnt(0)" ::: "memory");
        } else {
            XB_SPIN(xb_ld(&bar[XB_XGEN(b.x)]) == gen, bar);
            __builtin_amdgcn_fence(__ATOMIC_ACQUIRE, "agent");
            asm volatile("s_waitcnt vmcnt(0)" ::: "memory");
        }
    }
    __syncthreads();
}

constexpr int D = 2048, NBATCH = 8, SEQ = 2048, CTXL = 256, DEPTH = 2;
constexpr int NLAT = NBATCH * SEQ, NCTX = NBATCH * CTXL, NTOK = NLAT + NCTX;
constexpr int INW = 12288, MODW = 6 * D, DC = 1024, NH = 8, DK = 128, NEXP = 16384;
constexpr int C_CB = 0, C_CC = 1024, C_CV = 2048, C_Q = 3072, C_ZF = 4096, C_ZB = 5120, C_VI = 6144, C_OG = 7168, C_GA = 8192, C_GB = 10240;
constexpr int C_YA = 3072, C_YB = 4096;
constexpr float ALPHA = 1.41421356237309515f, LN_EPS = 1e-6f, F_MIN = 1e-30f, QSCALE = 0.08838834764831845f;
constexpr int NWAVES = 8, NTHREADS = 512;
enum { I_X = 0, I_C, I_CTX, I_CCTX, I_WMOD, I_BMOD, I_WIN, I_CONVW, I_CONVB, I_LBRAW, I_HGG, I_WPA, I_WPB, I_WO, I_LN1G, I_LN1B, I_WQ, I_KEYS, I_PU, I_PV, I_LN2G, I_LN2B, N_IN };

constexpr size_t MiB = 1u << 20;
constexpr size_t WS_CTL = 0, CTL_ZERO_BYTES = 4 * MiB;
constexpr size_t WS_MOD = 1 * MiB;
constexpr size_t WS_WIN = 2 * MiB;
constexpr size_t WS_WPA = 50 * MiB, WS_WPB = 54 * MiB;
constexpr size_t WS_WO = 58 * MiB, WS_WQ = 66 * MiB;
constexpr size_t WS_KEYS = 74 * MiB;
constexpr size_t WS_U = 76 * MiB, WS_V = 140 * MiB;
constexpr size_t WS_X = 204 * MiB;
constexpr size_t WS_H = 348 * MiB;
constexpr size_t WS_Y = 420 * MiB;
constexpr size_t WS_PROJ = 492 * MiB;
constexpr size_t WS_OSC = 924 * MiB;
constexpr size_t WS_END = 1068 * MiB;
static_assert(WS_PROJ + (size_t)NTOK * INW * 2 <= WS_OSC && WS_OSC + (size_t)2 * NTOK * DC * 4 <= WS_END, "ws map");
constexpr size_t WS_ESCALE = 75 * MiB;
constexpr size_t WS_LBT = 75 * MiB + 131072;
constexpr int EROW = 1536;
constexpr int EREC = 3072;
typedef _Float16 v32h __attribute__((ext_vector_type(32)));
typedef float v32f __attribute__((ext_vector_type(32)));
typedef int v6i __attribute__((ext_vector_type(6)));
constexpr float SW8 = 2048.0f, SA8_M = 8.0f, SA8_H = 16.0f, SA8_Y = 8.0f;
constexpr size_t WS_H8 = 1086 * MiB;
constexpr size_t WS_WIN8 = WS_WIN + 8 * MiB;
constexpr int CW_BAR = 4096;

constexpr int RING_BYTES = 131072, LDSCTL_OFF = 135168, MISC_OFF = LDSCTL_OFF + 320, LDS_BYTES = 147456;

#define DI __device__ __forceinline__
typedef unsigned short bf16;
typedef unsigned u32x4 __attribute__((ext_vector_type(4)));
typedef unsigned u32x2 __attribute__((ext_vector_type(2)));
typedef float f32x4 __attribute__((ext_vector_type(4)));
constexpr int ESEG = 192;
constexpr size_t ESLICE = (size_t)16384 * ESEG;
__device__ __forceinline__ void eseg_store(unsigned char* tbl, int e, int lane, const v6i p) {
    unsigned char* d = tbl + (size_t)(lane >> 3) * ESLICE + (size_t)e * ESEG + (lane & 7) * 24;
    *(u32x2*)d = (u32x2){(unsigned)p[0], (unsigned)p[1]}; *(u32x2*)(d + 8) = (u32x2){(unsigned)p[2], (unsigned)p[3]}; *(u32x2*)(d + 16) = (u32x2){(unsigned)p[4], (unsigned)p[5]};
}

DI float bf_lo(unsigned w) { return __uint_as_float(w << 16); }
DI float bf_hi(unsigned w) { return __uint_as_float(w & 0xffff0000u); }
DI unsigned pk2(float lo, float hi) { unsigned r; asm("v_cvt_pk_bf16_f32 %0, %1, %2" : "=v"(r) : "v"(lo), "v"(hi)); return r; }
DI float clamp448(float x) { return fminf(fmaxf(x, -448.0f), 448.0f); }
DI unsigned pk4_fp8(float a, float b, float c, float d) { int w = 0; w = __builtin_amdgcn_cvt_pk_fp8_f32(clamp448(a), clamp448(b), w, false); w = __builtin_amdgcn_cvt_pk_fp8_f32(clamp448(c), clamp448(d), w, true); return (unsigned)w; }
DI void unpack8(const u32x4 w, float (&f)[8]) { f[0] = bf_lo(w.x); f[1] = bf_hi(w.x); f[2] = bf_lo(w.y); f[3] = bf_hi(w.y); f[4] = bf_lo(w.z); f[5] = bf_hi(w.z); f[6] = bf_lo(w.w); f[7] = bf_hi(w.w); }
DI u32x4 pack8(const float (&f)[8]) { u32x4 w; w.x = pk2(f[0], f[1]); w.y = pk2(f[2], f[3]); w.z = pk2(f[4], f[5]); w.w = pk2(f[6], f[7]); return w; }
DI float wave_sum(float v) {
#pragma unroll
    for (int o = 1; o < 64; o <<= 1) v += __shfl_xor(v, o);
    return v;
}
DI float frcp(float x) { return __builtin_amdgcn_rcpf(x); }
DI float sigm(float x) { return frcp(1.0f + __expf(-x)); }
DI float silu(float x) { return x * frcp(1.0f + __expf(-x)); }
DI float gelu_erf(float x) { return 0.5f * x * (1.0f + erff(x * 0.70710678118654752f)); }

extern __shared__ __attribute__((aligned(16))) unsigned char lds_raw[];
constexpr int PTR_OFF = MISC_OFF + 256;
DI unsigned long long ld_ptr(int i) {
    const unsigned long long v = ((volatile LAS unsigned long long*)((LAS unsigned char*)lds_raw + PTR_OFF))[i];
    const unsigned lo = __builtin_amdgcn_readfirstlane((unsigned)v), hi = __builtin_amdgcn_readfirstlane((unsigned)(v >> 32));
    return ((unsigned long long)hi << 32) | lo;
}
template <class T> DI T* as_global(unsigned long long v) {
    return (T*)(__attribute__((address_space(1))) T*)v; }
DI const float* inp(int i) { return as_global<const float>(ld_ptr(i)); }
struct Frame {
    LAS unsigned char* lds;
    int tid, lane, wave, G;
    float* out; unsigned char* ws;
    float* mod; bf16 *Win, *Wpa, *Wpb, *Wo, *Wq, *Keys, *U, *V; float* X; bf16 *H, *Y, *PROJ; float* OSC;
};
DI int lane_id() { unsigned z = 0u; asm volatile("" : "+v"(z)); return (int)__builtin_amdgcn_mbcnt_hi(~0u, __builtin_amdgcn_mbcnt_lo(~0u, z)); }
DI Frame mkframe(int wv) {
    Frame F; int ln = lane_id(); asm volatile("" : "+v"(ln)); asm volatile("" : "+s"(wv));
    F.lds = (LAS unsigned char*)lds_raw; F.tid = wv * 64 + ln; F.lane = ln; F.wave = wv; F.G = gridDim.x;
    F.out = as_global<float>(ld_ptr(N_IN)); unsigned char* ws = as_global<unsigned char>(ld_ptr(N_IN + 1)); F.ws = ws;
    F.mod = (float*)(ws + WS_MOD); F.Win = (bf16*)(ws + WS_WIN); F.Wpa = (bf16*)(ws + WS_WPA); F.Wpb = (bf16*)(ws + WS_WPB); F.Wo = (bf16*)(ws + WS_WO); F.Wq = (bf16*)(ws + WS_WQ);
    F.Keys = (bf16*)(ws + WS_KEYS); F.U = (bf16*)(ws + WS_U); F.V = (bf16*)(ws + WS_V); F.X = (float*)(ws + WS_X); F.H = (bf16*)(ws + WS_H); F.Y = (bf16*)(ws + WS_Y);
    F.PROJ = (bf16*)(ws + WS_PROJ); F.OSC = (float*)(ws + WS_OSC);
    return F;
}
DI const float* xrow(const float* xin, const float* cin, const float* X, int l, int r) {
    if (l == 0) return r < NLAT ? xin + (size_t)r * D : cin + (size_t)(r - NLAT) * D;
    return X + (size_t)r * D;
}
DI int modrow(int r) { return r < NLAT ? r / SEQ : 8; }
DI float lower_bound(const float* lbraw, int l, int d, int c) {
    if (l == 0) return 0.0f;
    const float a0 = lbraw[d * DC + c], a1 = lbraw[2 * DC + d * DC + c];
    return 1.0f / (1.0f + __expf(a0 - a1));
}

DI void transpose_item(const float* W, int K, int N, bf16* WT, LAS float* scr, int item, int lane, int ldw = 0, int koff = 0, bool f8 = false, int win_split = 0) {
    if (ldw == 0) ldw = K;
    const int nblk = N / 64, kb = item / nblk, nb = item % nblk, k0 = 64 * kb, n0 = 64 * nb;
    int drow = n0;
    if (win_split) { if (n0 >= C_ZF && n0 < C_VI) { drow = n0 - C_ZF; } else { f8 = true; drow = n0 < C_ZF ? n0 : n0 - (C_VI - C_ZF); WT = (bf16*)((unsigned char*)WT + (WS_WIN8 - WS_WIN)); } }
    const int n4 = (lane & 15) * 4;
#pragma unroll 8
    for (int i = 0; i < 16; ++i) { const int kk = 4 * i + (lane >> 4); const f32x4 v = __builtin_nontemporal_load((const f32x4*)(W + (size_t)(k0 + kk) * N + n0 + n4));
        LAS float* d = scr + kk * 65 + n4; d[0] = v.x; d[1] = v.y; d[2] = v.z; d[3] = v.w; }
    __builtin_amdgcn_fence(__ATOMIC_RELEASE, "wavefront"); asm volatile("s_waitcnt lgkmcnt(0)" ::: "memory");
    const int c = lane & 7;
#pragma unroll
    for (int j = 0; j < 8; ++j) { const int n = (lane >> 3) + 8 * j; const LAS float* s = scr + (8 * c) * 65 + n;
        if (f8) { u32x2 o; o.x = pk4_fp8(s[0 * 65] * SW8, s[1 * 65] * SW8, s[2 * 65] * SW8, s[3 * 65] * SW8); o.y = pk4_fp8(s[4 * 65] * SW8, s[5 * 65] * SW8, s[6 * 65] * SW8, s[7 * 65] * SW8);
            *(u32x2*)((unsigned char*)WT + (size_t)(drow + n) * ldw + koff + k0 + 8 * c) = o; }
        else { u32x4 o; o.x = pk2(s[0 * 65], s[1 * 65]); o.y = pk2(s[2 * 65], s[3 * 65]); o.z = pk2(s[4 * 65], s[5 * 65]); o.w = pk2(s[6 * 65], s[7 * 65]);
            *(u32x4*)(WT + (size_t)(drow + n) * ldw + koff + k0 + 8 * c) = o; } }
    asm volatile("s_waitcnt lgkmcnt(0)" ::: "memory");
}
DI void cvt_copy(const Frame& F, const float* src, bf16* dst, size_t n) {
    const size_t nthreads = (size_t)F.G * NTHREADS;
    for (size_t i = (size_t)blockIdx.x * NTHREADS + F.tid; i < n / 8; i += nthreads) {
        const f32x4 a = *(const f32x4*)(src + i * 8), b = *(const f32x4*)(src + i * 8 + 4);
        u32x4 o; o.x = pk2(a.x, a.y); o.y = pk2(a.z, a.w); o.z = pk2(b.x, b.y); o.w = pk2(b.z, b.w);
        *(u32x4*)(dst + i * 8) = o;
    }
}
DI void phase_convert(int l, int wv, bool tables) {
    const Frame F = mkframe(wv);
    LAS float* scr = (LAS float*)(F.lds + F.wave * 16640);
    const int gw = blockIdx.x * NWAVES + F.wave, NGW = F.G * NWAVES;
    constexpr int IT_IN = (D / 64) * (INW / 64), IT_PA = (DC / 64) * (D / 64), IT_O = (D / 64) * (D / 64);
    constexpr int NITEMS = IT_IN + 2 * IT_PA + 2 * IT_O;
    for (int it = gw; it < NITEMS; it += NGW) {
        int r = it;
        if (r < IT_IN) { transpose_item(inp(I_WIN) + (size_t)l * D * INW, D, INW, F.Win, scr, r, F.lane, D, 0, false, 1); continue; } r -= IT_IN;
        if (r < IT_PA) { transpose_item(inp(I_WPA) + (size_t)l * DC * D, DC, D, F.Wpa, scr, r, F.lane, D, 0, true); continue; } r -= IT_PA;
        if (r < IT_PA) { transpose_item(inp(I_WPB) + (size_t)l * DC * D, DC, D, F.Wpa, scr, r, F.lane, D, DC, true); continue; } r -= IT_PA;
        if (r < IT_O)  { transpose_item(inp(I_WO) + (size_t)l * D * D, D, D, F.Wo, scr, r, F.lane, D, 0, true); continue; } r -= IT_O;
        transpose_item(inp(I_WQ) + (size_t)l * D * D, D, D, F.Wq, scr, r, F.lane);
    }
    cvt_copy(F, inp(I_KEYS) + (size_t)l * NH * 2 * 128 * 128, F.Keys, (size_t)NH * 2 * 128 * 128);
    if (blockIdx.x == 0) { const float* lbraw = inp(I_LBRAW); float* lbt = (float*)(F.ws + WS_LBT);
        for (int i = F.tid; i < 2 * DC; i += NTHREADS) lbt[i] = lower_bound(lbraw, l, i / DC, i % DC); }
    { const float* pu = inp(I_PU) + (size_t)l * NEXP * D; const float* pv = inp(I_PV) + (size_t)l * NEXP * D;
      unsigned char* U6 = (unsigned char*)F.U; unsigned char* V6 = (unsigned char*)F.V; float* SU = (float*)(F.ws + WS_ESCALE); float* SV = SU + NEXP;
      if (tables) for (int it = gw; it < 2 * NEXP; it += NGW) {
          const int e = it >> 1; const float* src = ((it & 1) ? pv : pu) + (size_t)e * D; unsigned char* dst = (it & 1) ? V6 : U6;
          f32x4 x[8]; float am = 0.f;
#pragma unroll
          for (int c = 0; c < 8; ++c) { x[c] = __builtin_nontemporal_load((const f32x4*)(src + c * 256 + F.lane * 4));
              am = fmaxf(am, fmaxf(fmaxf(fabsf(x[c].x), fabsf(x[c].y)), fmaxf(fabsf(x[c].z), fabsf(x[c].w)))); }
#pragma unroll
          for (int o = 1; o < 64; o <<= 1) am = fmaxf(am, __shfl_xor(am, o));
          const float inv = am > 0.f ? 7.0f / am : 0.f, sc = am > 0.f ? am * (1.0f / 7.0f) : 0.f;
          v32h hx;
#pragma unroll
          for (int c = 0; c < 8; ++c) { hx[c * 4 + 0] = (_Float16)(x[c].x * inv); hx[c * 4 + 1] = (_Float16)(x[c].y * inv); hx[c * 4 + 2] = (_Float16)(x[c].z * inv); hx[c * 4 + 3] = (_Float16)(x[c].w * inv); }
          const v6i p = __builtin_amdgcn_cvt_scalef32_pk32_fp6_f16(hx, 1.0f);
          eseg_store(dst, e, F.lane, p);
          if (F.lane == 0) ((it & 1) ? SV : SU)[e] = sc;
      } }
}
DI void phase_mod(int wv) {
    const Frame F = mkframe(wv);
    LAS float* sv = (LAS float*)F.lds;
    LAS float* red = (LAS float*)(F.lds + 73728);
    constexpr int NITEM = 2 * (MODW / 64);
    if ((int)blockIdx.x >= NITEM) return;
    __syncthreads();
    const float* cvec = inp(I_C); const float* cctx = inp(I_CCTX); const float* wmod = inp(I_WMOD); const float* bmod = inp(I_BMOD);
    for (int i = F.tid; i < 9 * D; i += NTHREADS) { const int r = i / D, k = i % D; const float c = r < 8 ? cvec[r * D + k] : cctx[k]; sv[i] = silu(c); }
    __syncthreads();
    for (int item = blockIdx.x; item < NITEM; item += F.G) {
        const int l = item / (MODW / 64), nb = item % (MODW / 64);
        const float* W = wmod + (size_t)l * D * MODW + nb * 64 + F.lane;
        float acc[9];
#pragma unroll
        for (int r = 0; r < 9; ++r) acc[r] = 0.f;
#pragma unroll 8
        for (int kk = 0; kk < 256; ++kk) { const int k = F.wave * 256 + kk; const float w = __builtin_nontemporal_load(W + (size_t)k * MODW);
#pragma unroll
            for (int r = 0; r < 9; ++r) acc[r] += sv[r * D + k] * w; }
#pragma unroll
        for (int r = 0; r < 9; ++r) red[(F.wave * 9 + r) * 64 + F.lane] = acc[r];
        __syncthreads();
        for (int idx = F.tid; idx < 9 * 64; idx += NTHREADS) { const int r = idx / 64, nn = idx % 64; float s = bmod[l * MODW + nb * 64 + nn];
#pragma unroll
            for (int w = 0; w < 8; ++w) s += red[(w * 9 + r) * 64 + nn];
            F.mod[((size_t)l * 9 + r) * MODW + nb * 64 + nn] = s; }
        __syncthreads();
    }
}

DI void load_row_f32(const float* src, int lane, float (&v)[32]) {
#pragma unroll
    for (int c = 0; c < 4; ++c) { const f32x4 a = *(const f32x4*)(src + c * 512 + lane * 8), b = *(const f32x4*)(src + c * 512 + lane * 8 + 4);
        v[c * 8 + 0] = a.x; v[c * 8 + 1] = a.y; v[c * 8 + 2] = a.z; v[c * 8 + 3] = a.w; v[c * 8 + 4] = b.x; v[c * 8 + 5] = b.y; v[c * 8 + 6] = b.z; v[c * 8 + 7] = b.w; }
}
DI void store_row_f32(float* dst, int lane, const float (&v)[32]) {
#pragma unroll
    for (int c = 0; c < 4; ++c) { *(f32x4*)(dst + c * 512 + lane * 8) = (f32x4){v[c * 8 + 0], v[c * 8 + 1], v[c * 8 + 2], v[c * 8 + 3]};
        *(f32x4*)(dst + c * 512 + lane * 8 + 4) = (f32x4){v[c * 8 + 4], v[c * 8 + 5], v[c * 8 + 6], v[c * 8 + 7]}; }
}
DI void load_row_bf16(const bf16* src, int lane, float (&v)[32]) {
#pragma unroll
    for (int c = 0; c < 4; ++c) { const u32x4 w = *(const u32x4*)(src + c * 512 + lane * 8);
        v[c * 8 + 0] = bf_lo(w.x); v[c * 8 + 1] = bf_hi(w.x); v[c * 8 + 2] = bf_lo(w.y); v[c * 8 + 3] = bf_hi(w.y); v[c * 8 + 4] = bf_lo(w.z); v[c * 8 + 5] = bf_hi(w.z); v[c * 8 + 6] = bf_lo(w.w); v[c * 8 + 7] = bf_hi(w.w); }
}
DI void store_row_bf16(bf16* dst, int lane, const float (&v)[32]) {
#pragma unroll
    for (int c = 0; c < 4; ++c) { u32x4 w; w.x = pk2(v[c * 8 + 0], v[c * 8 + 1]); w.y = pk2(v[c * 8 + 2], v[c * 8 + 3]); w.z = pk2(v[c * 8 + 4], v[c * 8 + 5]); w.w = pk2(v[c * 8 + 6], v[c * 8 + 7]);
        *(u32x4*)(dst + c * 512 + lane * 8) = w; }
}
DI void row_normalize(float (&v)[32]) {
    float s = 0.f;
#pragma unroll
    for (int i = 0; i < 32; ++i) s += v[i];
    const float mean = wave_sum(s) * (1.0f / D);
    float q = 0.f;
#pragma unroll
    for (int i = 0; i < 32; ++i) { v[i] -= mean; q += v[i] * v[i]; }
    const float rstd = rsqrtf(wave_sum(q) * (1.0f / D) + LN_EPS);
#pragma unroll
    for (int i = 0; i < 32; ++i) v[i] *= rstd;
}

DI void phase_modulate1(int l, int wv) {
    const Frame F = mkframe(wv);
    const float* xin = inp(I_X); const float* cin = inp(I_CTX);
    const int gw = blockIdx.x * NWAVES + F.wave, NGW = F.G * NWAVES;
    for (int r = gw; r < NTOK; r += NGW) {
        const float* md = F.mod + ((size_t)l * 9 + modrow(r)) * MODW;
        float v[32], sh[32], sc[32];
        load_row_f32(xrow(xin, cin, F.X, l, r), F.lane, v);
        load_row_f32(md + 0 * D, F.lane, sh); load_row_f32(md + 1 * D, F.lane, sc);
        row_normalize(v);
#pragma unroll
        for (int i = 0; i < 32; ++i) v[i] = v[i] * (1.0f + sc[i]) + sh[i];
        store_row_bf16(F.H + (size_t)r * D, F.lane, v);
        unsigned char* h8 = F.ws + WS_H8 + (size_t)r * D;
#pragma unroll
        for (int c = 0; c < 4; ++c) *(u32x2*)(h8 + c * 512 + F.lane * 8) = (u32x2){pk4_fp8(v[c * 8 + 0] * SA8_H, v[c * 8 + 1] * SA8_H, v[c * 8 + 2] * SA8_H, v[c * 8 + 3] * SA8_H), pk4_fp8(v[c * 8 + 4] * SA8_H, v[c * 8 + 5] * SA8_H, v[c * 8 + 6] * SA8_H, v[c * 8 + 7] * SA8_H)};
    }
}

struct EpiStore {
    static constexpr bool PERM = true, AFTER_DRAIN = false, MIDK = false;
    bf16* O; int ldc; float scale; int split_pn, shift;
    DI void operator()(const pg8::f32x4 (&acc)[2][2][4][2], const pg8::Unit& u, int wr, int wc, int fr, int fq) const {
        const int row0 = u.pm * 256 + wr * 64 + fr, col0 = u.pn * 256 + (u.pn >= split_pn ? shift : 0) + wc * 64 + 8 * fq;
#pragma unroll
        for (int ai = 0; ai < 2; ++ai)
#pragma unroll
            for (int m = 0; m < 4; ++m) { bf16* rowp = O + (size_t)(row0 + ai * 128 + m * 16) * ldc + col0;
#pragma unroll
                for (int bj = 0; bj < 2; ++bj) { const pg8::f32x4 v0 = acc[ai][bj][m][0] * scale, v1 = acc[ai][bj][m][1] * scale;
                    u32x4 w; w.x = pk2(v0[0], v0[1]); w.y = pk2(v0[2], v0[3]); w.z = pk2(v1[0], v1[1]); w.w = pk2(v1[2], v1[3]);
                    *(u32x4*)(rowp + bj * 32) = w; } }
    }
};
struct EpiMerge {
    static constexpr bool PERM = true, AFTER_DRAIN = false, MIDK = true;
    const bf16* Ga; const bf16* Gb; int ldg; bf16* O; int ldc;
    DI void mid(pg8::f32x4 (&acc)[2][2][4][2], const pg8::Unit& u, int wr, int wc, int fr, int fq) const {
        asm volatile("" : "+v"(fr), "+v"(fq));
        const int row0 = u.pm * 256 + wr * 64 + fr, col0 = u.pn * 256 + wc * 64 + 8 * fq;
#pragma unroll
        for (int ai = 0; ai < 2; ++ai)
#pragma unroll
            for (int m = 0; m < 4; ++m) { const size_t rr = (size_t)(row0 + ai * 128 + m * 16);
#pragma unroll
                for (int bj = 0; bj < 2; ++bj) { float ga[8], gb[8];
                    unpack8(*(const u32x4*)(Ga + rr * ldg + col0 + bj * 32), ga); unpack8(*(const u32x4*)(Gb + rr * ldg + col0 + bj * 32), gb);
#pragma unroll
                    for (int j = 0; j < 8; ++j) { const float ratio = (1.0f + __expf(-gb[j])) * frcp(1.0f + __expf(-ga[j])); acc[ai][bj][m][j >> 2][j & 3] *= ratio; } }
                asm volatile("" ::: "memory"); }
    }
    DI void operator()(const pg8::f32x4 (&acc)[2][2][4][2], const pg8::Unit& u, int wr, int wc, int fr, int fq) const {
        const int row0 = u.pm * 256 + wr * 64 + fr, col0 = u.pn * 256 + wc * 64 + 8 * fq;
#pragma unroll
        for (int ai = 0; ai < 2; ++ai)
#pragma unroll
            for (int m = 0; m < 4; ++m) { const size_t rr = (size_t)(row0 + ai * 128 + m * 16);
#pragma unroll
                for (int bj = 0; bj < 2; ++bj) { const pg8::f32x4 v0 = acc[ai][bj][m][0], v1 = acc[ai][bj][m][1];
                    const float a[8] = {v0[0], v0[1], v0[2], v0[3], v1[0], v1[1], v1[2], v1[3]}; float g[8], o[8];
                    unpack8(*(const u32x4*)(Gb + rr * ldg + col0 + bj * 32), g);
#pragma unroll
                    for (int j = 0; j < 8; ++j) o[j] = sigm(g[j]) * a[j] * (SA8_M / (SW8 * SA8_Y));
                    *(u32x2*)((unsigned char*)O + rr * ldc + col0 + bj * 32) = (u32x2){pk4_fp8(o[0], o[1], o[2], o[3]), pk4_fp8(o[4], o[5], o[6], o[7])}; } }
    }
};

typedef short bf16x8v __attribute__((ext_vector_type(8)));
typedef short s16x4v __attribute__((ext_vector_type(4)));
typedef float f32x16 __attribute__((ext_vector_type(16)));
DI unsigned short f2bf1(float x) { return (unsigned short)(pk2(x, 0.f) & 0xffffu); }
constexpr int C_QTF = C_CB, C_KTF = C_Q, C_QTB = C_ZF, C_KTB = C_ZB;
constexpr size_t WS_EV = 1068 * MiB;
DI float* ev_ptr(unsigned char* ws, int chunk, int h, int dir) { return (float*)(ws + WS_EV) + ((size_t)(chunk * NH + h) * 2 + dir) * 384; }
DI void phase_prep(int l, int wv, bool dry = false) {
    const Frame F = mkframe(wv);
    const float* lbt = (const float*)(F.ws + WS_LBT);
    const float* cw = inp(I_CONVW) + (size_t)l * 3 * DC; const float* cbias = inp(I_CONVB) + (size_t)l * DC;
    constexpr int O_TOTF = 0, O_TOTB = 2048, O_PRE = 4096;
    LAS unsigned char* L = F.lds;
    const int lane = F.lane, w = F.wave, pl = lane >> 3, cg = lane & 7, pp = w * 8 + pl;
    struct PrepIn { u32x4 cb, cc, cv, ccp, cvp, ccn, cvn, zf, zb, q; };
    constexpr int NITEM = (NTOK / 64) * NH * 2;
    auto item_load = [&](int item, PrepIn& P) {
        const int chunk = item >> 4, h = (item >> 1) & 7, hc = (item & 1) * 64 + cg * 8, row = chunk * 64 + pp, c0 = h * DK + hc;
        const bf16* prow = F.PROJ + (size_t)row * INW;
        bool hasp, hasn;
        if (row < NLAT) { hasp = pp != 0; hasn = pp != 63; } else { const int t = (row - NLAT) & (CTXL - 1); hasp = t != 0; hasn = t != CTXL - 1; }
        const bf16* pprev = hasp ? prow - INW : prow; const bf16* pnext = hasn ? prow + INW : prow;
        P.cb = *(const u32x4*)(prow + C_CB + c0); P.cc = *(const u32x4*)(prow + C_CC + c0); P.cv = *(const u32x4*)(prow + C_CV + c0);
        P.ccp = *(const u32x4*)(pprev + C_CC + c0); P.cvp = *(const u32x4*)(pprev + C_CV + c0); P.ccn = *(const u32x4*)(pnext + C_CC + c0); P.cvn = *(const u32x4*)(pnext + C_CV + c0);
        P.zf = *(const u32x4*)(prow + C_ZF + c0); P.zb = *(const u32x4*)(prow + C_ZB + c0); P.q = *(const u32x4*)(prow + C_Q + c0); };
    auto item_compute = [&](int item, const PrepIn& P) {
        const int chunk = item >> 4, h = (item >> 1) & 7, hc = (item & 1) * 64 + cg * 8, row = chunk * 64 + pp, c0 = h * DK + hc;
        bf16* prow = F.PROJ + (size_t)row * INW;
        bool hasp, hasn;
        if (row < NLAT) { hasp = pp != 0; hasn = pp != 63; } else { const int t = (row - NLAT) & (CTXL - 1); hasp = t != 0; hasn = t != CTXL - 1; }
        {   float cb[8], cc[8], cv[8], up[8], un[8], t0[8], t1[8], ya[8];
            unpack8(P.cb, cb); unpack8(P.cc, cc); unpack8(P.cv, cv);
            if (hasp) { unpack8(P.ccp, t0); unpack8(P.cvp, t1);
#pragma unroll
                for (int j = 0; j < 8; ++j) up[j] = t0[j] * t1[j]; }
            else {
#pragma unroll
                for (int j = 0; j < 8; ++j) up[j] = 0.f; }
            if (hasn) { unpack8(P.ccn, t0); unpack8(P.cvn, t1);
#pragma unroll
                for (int j = 0; j < 8; ++j) un[j] = t0[j] * t1[j]; }
            else {
#pragma unroll
                for (int j = 0; j < 8; ++j) un[j] = 0.f; }
            const f32x4 w0a = *(const f32x4*)(cw + c0), w0b = *(const f32x4*)(cw + c0 + 4), w1a = *(const f32x4*)(cw + DC + c0), w1b = *(const f32x4*)(cw + DC + c0 + 4);
            const f32x4 w2a = *(const f32x4*)(cw + 2 * DC + c0), w2b = *(const f32x4*)(cw + 2 * DC + c0 + 4), bia = *(const f32x4*)(cbias + c0), bib = *(const f32x4*)(cbias + c0 + 4);
#pragma unroll
            for (int j = 0; j < 8; ++j) { const float w0 = j < 4 ? w0a[j & 3] : w0b[j & 3], w1 = j < 4 ? w1a[j & 3] : w1b[j & 3], w2 = j < 4 ? w2a[j & 3] : w2b[j & 3], bi = j < 4 ? bia[j & 3] : bib[j & 3];
                ya[j] = cb[j] * (w0 * up[j] + w1 * (cc[j] * cv[j]) + w2 * un[j] + bi); }
            if (!dry) *(u32x2*)((unsigned char*)F.H + (size_t)row * D + c0) = (u32x2){pk4_fp8(ya[0] * SA8_Y, ya[1] * SA8_Y, ya[2] * SA8_Y, ya[3] * SA8_Y), pk4_fp8(ya[4] * SA8_Y, ya[5] * SA8_Y, ya[6] * SA8_Y, ya[7] * SA8_Y)};
        }
        float lff[8], lfb[8], kf[8], kb[8], qs[8];
        {   float zf[8], zb[8], q[8];
            unpack8(P.zf, zf); unpack8(P.zb, zb); unpack8(P.q, q);
            const f32x4 lfa = *(const f32x4*)(lbt + c0), lfc = *(const f32x4*)(lbt + c0 + 4), lba = *(const f32x4*)(lbt + DC + c0), lbc = *(const f32x4*)(lbt + DC + c0 + 4);
#pragma unroll
            for (int i = 0; i < 8; ++i) { const float lbf = i < 4 ? lfa[i & 3] : lfc[i & 3], lbb = i < 4 ? lba[i & 3] : lbc[i & 3];
                const float ef = __expf(fminf(fmaxf(-zf[i], -80.f), 80.f)), eb = __expf(fminf(fmaxf(-zb[i], -80.f), 80.f)), sf = frcp(1.0f + ef), sb = frcp(1.0f + eb);
                lff[i] = __logf(fmaxf(lbf + (1.0f - lbf) * sf, F_MIN)); kf[i] = (1.0f - lbf) * (ef * sf);
                lfb[i] = __logf(fmaxf(lbb + (1.0f - lbb) * sb, F_MIN)); kb[i] = (1.0f - lbb) * (eb * sb);
                qs[i] = q[i] * frcp(1.0f + __expf(-q[i])) * QSCALE; }
        }
#pragma unroll
        for (int d = 1; d < 8; d <<= 1) {
#pragma unroll
            for (int i = 0; i < 8; ++i) { const float o = __shfl_up(lff[i], 8 * d); if (pl >= d) lff[i] += o; const float o2 = __shfl_down(lfb[i], 8 * d); if (pl + d < 8) lfb[i] += o2; } }
        __syncthreads();
        if (pl == 7) { *(LAS f32x4*)(L + O_TOTF + (w * 64 + cg * 8) * 4) = (f32x4){lff[0], lff[1], lff[2], lff[3]}; *(LAS f32x4*)(L + O_TOTF + (w * 64 + cg * 8 + 4) * 4) = (f32x4){lff[4], lff[5], lff[6], lff[7]}; }
        if (pl == 0) { *(LAS f32x4*)(L + O_TOTB + (w * 64 + cg * 8) * 4) = (f32x4){lfb[0], lfb[1], lfb[2], lfb[3]}; *(LAS f32x4*)(L + O_TOTB + (w * 64 + cg * 8 + 4) * 4) = (f32x4){lfb[4], lfb[5], lfb[6], lfb[7]}; }
        __syncthreads();
        if (F.tid < 128) { const int dd = F.tid >> 6, cch = F.tid & 63; const LAS float* tp = (const LAS float*)(L + (dd ? O_TOTB : O_TOTF)) + cch; LAS float* pp_ = (LAS float*)(L + O_PRE) + dd * 640 + cch;
            float t[8];
#pragma unroll
            for (int ww = 0; ww < 8; ++ww) t[ww] = tp[ww * 64];
            float run = 0.f;
            if (dd == 0) {
#pragma unroll
                for (int ww = 0; ww < 8; ++ww) { pp_[ww * 64] = run; run += t[ww]; }
                pp_[512] = (t[0] + t[1]) + (t[2] + t[3]); }
            else {
#pragma unroll
                for (int ww = 7; ww >= 0; --ww) { pp_[ww * 64] = run; run += t[ww]; }
                pp_[512] = (t[4] + t[5]) + (t[6] + t[7]); }
            pp_[576] = run; }
        __syncthreads();
        {   float pf[8], rf[8], bf_[8], pb[8], rb[8], bb[8];
            const LAS float* PF = (const LAS float*)(L + O_PRE) + cg * 8; const LAS float* PB = PF + 640;
#pragma unroll
            for (int q4 = 0; q4 < 2; ++q4) { const f32x4 a0 = *(const LAS f32x4*)(PF + w * 64 + q4 * 4), a1 = *(const LAS f32x4*)(PF + 512 + q4 * 4), a2 = *(const LAS f32x4*)(PF + 576 + q4 * 4);
                const f32x4 b0 = *(const LAS f32x4*)(PB + w * 64 + q4 * 4), b1 = *(const LAS f32x4*)(PB + 512 + q4 * 4), b2 = *(const LAS f32x4*)(PB + 576 + q4 * 4);
#pragma unroll
                for (int e = 0; e < 4; ++e) { const int i = q4 * 4 + e; pf[i] = a0[e]; rf[i] = a1[e]; bf_[i] = a2[e]; pb[i] = b0[e]; rb[i] = b1[e]; bb[i] = b2[e]; } }
            float o0[8], o1[8], o2[8], o3[8];
#pragma unroll
            for (int i = 0; i < 8; ++i) { const float bcf = pf[i] + lff[i], bcb = pb[i] + lfb[i];
                o0[i] = qs[i] * __expf(fminf(bcf - rf[i], 80.f)); o1[i] = kf[i] * __expf(fminf(rf[i] - bcf, 80.f));
                o2[i] = qs[i] * __expf(fminf(bcb - rb[i], 80.f)); o3[i] = kb[i] * __expf(fminf(rb[i] - bcb, 80.f)); }
            if (!dry) { *(u32x4*)(prow + C_QTF + c0) = pack8(o0); *(u32x4*)(prow + C_KTF + c0) = pack8(o1);
            *(u32x4*)(prow + C_QTB + c0) = pack8(o2); *(u32x4*)(prow + C_KTB + c0) = pack8(o3); }
            if (pp == 0 && !dry) {
                float* evf = ev_ptr(F.ws, chunk, h, 0) + hc; float* evb = ev_ptr(F.ws, chunk, h, 1) + hc;
#pragma unroll
                for (int q4 = 0; q4 < 2; ++q4) {
                    *(f32x4*)(evf + q4 * 4) = (f32x4){__expf(rf[q4 * 4]), __expf(rf[q4 * 4 + 1]), __expf(rf[q4 * 4 + 2]), __expf(rf[q4 * 4 + 3])};
                    *(f32x4*)(evf + 128 + q4 * 4) = (f32x4){__expf(bf_[q4 * 4] - rf[q4 * 4]), __expf(bf_[q4 * 4 + 1] - rf[q4 * 4 + 1]), __expf(bf_[q4 * 4 + 2] - rf[q4 * 4 + 2]), __expf(bf_[q4 * 4 + 3] - rf[q4 * 4 + 3])};
                    *(f32x4*)(evf + 256 + q4 * 4) = (f32x4){__expf(bf_[q4 * 4]), __expf(bf_[q4 * 4 + 1]), __expf(bf_[q4 * 4 + 2]), __expf(bf_[q4 * 4 + 3])};
                    *(f32x4*)(evb + q4 * 4) = (f32x4){__expf(rb[q4 * 4]), __expf(rb[q4 * 4 + 1]), __expf(rb[q4 * 4 + 2]), __expf(rb[q4 * 4 + 3])};
                    *(f32x4*)(evb + 128 + q4 * 4) = (f32x4){__expf(bb[q4 * 4] - rb[q4 * 4]), __expf(bb[q4 * 4 + 1] - rb[q4 * 4 + 1]), __expf(bb[q4 * 4 + 2] - rb[q4 * 4 + 2]), __expf(bb[q4 * 4 + 3] - rb[q4 * 4 + 3])};
                    *(f32x4*)(evb + 256 + q4 * 4) = (f32x4){__expf(bb[q4 * 4]), __expf(bb[q4 * 4 + 1]), __expf(bb[q4 * 4 + 2]), __expf(bb[q4 * 4 + 3])}; }
            }
        }
    };
    PrepIn PA, PB;
    int item = blockIdx.x;
    if (item < NITEM) item_load(item, PA);
    while (item < NITEM) {
        const int n1 = item + F.G, n2 = item + 2 * F.G;
        if (n1 < NITEM) item_load(n1, PB);
        item_compute(item, PA);
        if (n1 >= NITEM) break;
        if (n2 < NITEM) item_load(n2, PA);
        item_compute(n1, PB);
        item = n2;
    }
}
DI bf16x8v tr_frag(const LAS unsigned char* tile, int stride, int s0, int cbase, int lane) {
    const int i16 = lane & 15, g16 = (lane >> 4) & 1;
    const LAS unsigned char* p = tile + (s0 + (i16 >> 2)) * stride + (cbase + 16 * g16 + 4 * (i16 & 3)) * 2;
    const s16x4v lo = __builtin_amdgcn_ds_read_tr16_b64_v4i16((LAS s16x4v*)p), hi = __builtin_amdgcn_ds_read_tr16_b64_v4i16((LAS s16x4v*)(p + 4 * stride));
    return __builtin_shufflevector(lo, hi, 0, 1, 2, 3, 4, 5, 6, 7);
}
DI void phase_scan(int l, int wv, bool fill) {
    const Frame F = mkframe(wv);
    const float* pu = inp(I_PU) + (size_t)l * NEXP * D; const float* pv = inp(I_PV) + (size_t)l * NEXP * D;
    constexpr int RS = 272, RS64 = 144;
    constexpr int O_QT = 0, O_KT = 17408, O_ST = 34816, O_V = 52224, O_PM = 61440, O_EV = 70656;
    LAS unsigned char* L = F.lds;
    const int tid = F.tid, lane = F.lane, w = F.wave, r32 = lane & 31, hh = lane >> 5;
    const int srow = tid >> 3, sc16 = (tid & 7) * 16, svc = (tid & 7) * 8;
    for (int task = blockIdx.x; task < NBATCH * NH * 4; task += F.G) {
        const int b = task >> 5, h = (task >> 2) & 7, dir = (task >> 1) & 1, vh = task & 1;
        const int cq = (dir ? C_QTB : C_QTF) + h * DK + sc16, ck = (dir ? C_KTB : C_KTF) + h * DK + sc16, cvv = C_VI + h * DK + vh * 64 + svc;
        f32x16 S;
#pragma unroll
        for (int i = 0; i < 16; ++i) S[i] = 0.f;
        auto chunk_row0 = [&](int c) { return c < 4 ? NLAT + b * CTXL + (dir ? 3 - c : c) * 64 : b * SEQ + (dir ? 35 - c : c - 4) * 64; };
        u32x4 q0, q1, k0, k1, vr; f32x4 evr = (f32x4){0.f, 0.f, 0.f, 0.f};
        f32x4 fx[8]; const int fidx = (int)blockIdx.x * 4 + w; const bool filler = fill && w < 4;
        auto fill_load = [&](int it) { const float* src = ((it & 1) ? pv : pu) + (size_t)(it >> 1) * D; const float* src2 = src + 1024;
            unsigned lo = (unsigned)lane * 4u; asm volatile("" : "+v"(lo));
#pragma unroll
            for (int c8 = 0; c8 < 4; ++c8) { fx[c8] = __builtin_nontemporal_load((const f32x4*)(src + lo + c8 * 256)); fx[4 + c8] = __builtin_nontemporal_load((const f32x4*)(src2 + lo + c8 * 256)); } };
        if (filler) fill_load(fidx);
        {   const int row0 = chunk_row0(0); const bf16* pr = F.PROJ + (size_t)(row0 + srow) * INW;
            q0 = *(const u32x4*)(pr + cq); q1 = *(const u32x4*)(pr + cq + 8); k0 = *(const u32x4*)(pr + ck); k1 = *(const u32x4*)(pr + ck + 8); vr = *(const u32x4*)(pr + cvv);
            if (tid < 96) evr = *(const f32x4*)(ev_ptr(F.ws, row0 >> 6, h, dir) + tid * 4); }
        for (int c = 0; c < 36; ++c) {
            const int row0 = chunk_row0(c);
            __syncthreads();
            *(LAS u32x4*)(L + O_QT + srow * RS + sc16 * 2) = q0; *(LAS u32x4*)(L + O_QT + srow * RS + sc16 * 2 + 16) = q1;
            *(LAS u32x4*)(L + O_KT + srow * RS + sc16 * 2) = k0; *(LAS u32x4*)(L + O_KT + srow * RS + sc16 * 2 + 16) = k1;
            *(LAS u32x4*)(L + O_V + srow * RS64 + svc * 2) = vr;
            if (tid < 96) *(LAS f32x4*)(L + O_EV + tid * 16) = evr;
            if (c + 1 < 36) { const int rown = chunk_row0(c + 1); const bf16* pr = F.PROJ + (size_t)(rown + srow) * INW;
                q0 = *(const u32x4*)(pr + cq); q1 = *(const u32x4*)(pr + cq + 8); k0 = *(const u32x4*)(pr + ck); k1 = *(const u32x4*)(pr + ck + 8); vr = *(const u32x4*)(pr + cvv);
                if (tid < 96) evr = *(const f32x4*)(ev_ptr(F.ws, rown >> 6, h, dir) + tid * 4); }
            __syncthreads();
            {   const int kb = w >> 1, vb = w & 1;
                const LAS float* er = (const LAS float*)(L + O_EV) + kb * 32 + 4 * hh; const LAS float* ebr = er + 128; const LAS float* eb = er + 256;
#pragma unroll
                for (int g = 0; g < 4; ++g) { const f32x4 e4 = *(const LAS f32x4*)(er + 8 * g);
                    u32x2 pk; pk.x = pk2(S[4 * g] * e4.x, S[4 * g + 1] * e4.y); pk.y = pk2(S[4 * g + 2] * e4.z, S[4 * g + 3] * e4.w);
                    *(LAS u32x2*)(L + O_ST + (vb * 32 + r32) * RS + (kb * 32 + 8 * g + 4 * hh) * 2) = pk; }
                f32x16 U;
#pragma unroll
                for (int i = 0; i < 16; ++i) U[i] = 0.f;
#pragma unroll
                for (int ks = 0; ks < 4; ++ks) { const bf16x8v a = tr_frag(L + O_KT, RS, ks * 16 + 8 * hh, kb * 32, lane), bv = tr_frag(L + O_V, RS64, ks * 16 + 8 * hh, vb * 32, lane);
                    U = __builtin_amdgcn_mfma_f32_32x32x16_bf16(a, bv, U, 0, 0, 0); }
#pragma unroll
                for (int g = 0; g < 4; ++g) { const f32x4 b4 = *(const LAS f32x4*)(eb + 8 * g), c4 = *(const LAS f32x4*)(ebr + 8 * g);
                    S[4 * g] = b4.x * S[4 * g] + c4.x * U[4 * g]; S[4 * g + 1] = b4.y * S[4 * g + 1] + c4.y * U[4 * g + 1]; S[4 * g + 2] = b4.z * S[4 * g + 2] + c4.z * U[4 * g + 2]; S[4 * g + 3] = b4.w * S[4 * g + 3] + c4.w * U[4 * g + 3]; }
            }
            if (w < 4) {
                const int tb = w >> 1, sb = w & 1;
                f32x16 acc;
#pragma unroll
                for (int i = 0; i < 16; ++i) acc[i] = 0.f;
#pragma unroll 4
                for (int ks = 0; ks < 8; ++ks) { const bf16x8v a = *(const LAS bf16x8v*)(L + O_QT + (tb * 32 + r32) * RS + (ks * 16 + 8 * hh) * 2), bq = *(const LAS bf16x8v*)(L + O_KT + (sb * 32 + r32) * RS + (ks * 16 + 8 * hh) * 2);
                    acc = __builtin_amdgcn_mfma_f32_32x32x16_bf16(a, bq, acc, 0, 0, 0); }
#pragma unroll
                for (int i = 0; i < 16; ++i) { const int t = tb * 32 + (i & 3) + 8 * (i >> 2) + 4 * hh, sp = sb * 32 + r32; const bool keep = dir ? (sp >= t) : (sp <= t);
                    *(LAS unsigned short*)(L + O_PM + t * RS64 + sp * 2) = f2bf1(keep ? acc[i] : 0.f); }
            }
            __syncthreads();
            if (filler && c < 32) {
                const int it = fidx + 1024 * c, e = it >> 1; unsigned char* dst = (it & 1) ? (unsigned char*)F.V : (unsigned char*)F.U;
                float am = 0.f;
#pragma unroll
                for (int c8 = 0; c8 < 8; ++c8) am = fmaxf(am, fmaxf(fmaxf(fabsf(fx[c8].x), fabsf(fx[c8].y)), fmaxf(fabsf(fx[c8].z), fabsf(fx[c8].w))));
#pragma unroll
                for (int o = 1; o < 64; o <<= 1) am = fmaxf(am, __shfl_xor(am, o));
                const float inv = am > 0.f ? 7.0f / am : 0.f, sc = am > 0.f ? am * (1.0f / 7.0f) : 0.f;
                v32h hx;
#pragma unroll
                for (int c8 = 0; c8 < 8; ++c8) { hx[c8 * 4 + 0] = (_Float16)(fx[c8].x * inv); hx[c8 * 4 + 1] = (_Float16)(fx[c8].y * inv); hx[c8 * 4 + 2] = (_Float16)(fx[c8].z * inv); hx[c8 * 4 + 3] = (_Float16)(fx[c8].w * inv); }
                const v6i p = __builtin_amdgcn_cvt_scalef32_pk32_fp6_f16(hx, 1.0f);
                eseg_store(dst, e, lane, p);
                if (lane == 0) ((float*)(F.ws + WS_ESCALE) + ((it & 1) ? NEXP : 0))[e] = sc;
                if (c + 1 < 32) fill_load(it + 1024);
            }
            if (w >= 4) {
                const int tb = (w - 4) >> 1, vb = (w - 4) & 1;
                f32x16 acc;
#pragma unroll
                for (int i = 0; i < 16; ++i) acc[i] = 0.f;
#pragma unroll
                for (int ks = 0; ks < 4; ++ks) { const bf16x8v a = *(const LAS bf16x8v*)(L + O_PM + (tb * 32 + r32) * RS64 + (ks * 16 + 8 * hh) * 2), bv = tr_frag(L + O_V, RS64, ks * 16 + 8 * hh, vb * 32, lane);
                    acc = __builtin_amdgcn_mfma_f32_32x32x16_bf16(a, bv, acc, 0, 0, 0); }
#pragma unroll 4
                for (int ks = 0; ks < 8; ++ks) { const bf16x8v a = *(const LAS bf16x8v*)(L + O_QT + (tb * 32 + r32) * RS + (ks * 16 + 8 * hh) * 2), bs = *(const LAS bf16x8v*)(L + O_ST + (vb * 32 + r32) * RS + (ks * 16 + 8 * hh) * 2);
                    acc = __builtin_amdgcn_mfma_f32_32x32x16_bf16(a, bs, acc, 0, 0, 0); }
                bf16* ob = (bf16*)F.OSC + ((size_t)dir * NTOK + row0) * DC + h * DK + vh * 64 + vb * 32 + r32;
#pragma unroll
                for (int i = 0; i < 16; ++i) { const int t = tb * 32 + (i & 3) + 8 * (i >> 2) + 4 * hh; ob[(size_t)t * DC] = f2bf1(acc[i]); }
            }
        }
    }
}

DI void phase_readout(int l, int nrows, int wv) {
    const Frame F = mkframe(wv);
    const int gw = blockIdx.x * NWAVES + F.wave, NGW = F.G * NWAVES;
    const float* ng = inp(I_HGG) + (size_t)l * DK;
    struct RowIn { u32x4 a[2], b[2]; u32x4 og[2]; };
    auto row_load = [&](int r, RowIn& R) { const bf16* prow = F.PROJ + (size_t)r * INW; const bf16* osc = (const bf16*)F.OSC;
#pragma unroll
        for (int c = 0; c < 2; ++c) { const int e0 = c * 512 + F.lane * 8;
            R.a[c] = *(const u32x4*)(osc + (size_t)r * DC + e0); R.b[c] = *(const u32x4*)(osc + ((size_t)NTOK + r) * DC + e0);
            R.og[c] = *(const u32x4*)(prow + C_OG + e0); } };
    auto row_compute = [&](int r, const RowIn& R) {
#pragma unroll
        for (int c = 0; c < 2; ++c) {
            const int e0 = c * 512 + F.lane * 8;
            float o[8], og[8], yb[8]; float ss = 0.f;
            { float fa[8], fb[8]; unpack8(R.a[c], fa); unpack8(R.b[c], fb);
#pragma unroll
              for (int j = 0; j < 8; ++j) o[j] = fa[j] + fb[j]; }
#pragma unroll
            for (int j = 0; j < 8; ++j) ss += o[j] * o[j];
            ss += __shfl_xor(ss, 1); ss += __shfl_xor(ss, 2); ss += __shfl_xor(ss, 4); ss += __shfl_xor(ss, 8);
            const float rs = rsqrtf(ss * (1.0f / DK) + LN_EPS);
            unpack8(R.og[c], og);
#pragma unroll
            for (int j = 0; j < 8; ++j) yb[j] = o[j] * rs * ng[(e0 + j) & (DK - 1)] * silu(og[j]);
            *(u32x2*)((unsigned char*)F.H + (size_t)r * D + DC + e0) = (u32x2){pk4_fp8(yb[0] * SA8_Y, yb[1] * SA8_Y, yb[2] * SA8_Y, yb[3] * SA8_Y), pk4_fp8(yb[4] * SA8_Y, yb[5] * SA8_Y, yb[6] * SA8_Y, yb[7] * SA8_Y)};
        } };
    RowIn RA, RB;
    int r = gw;
    if (r < nrows) row_load(r, RA);
    while (r < nrows) {
        const int n1 = r + NGW, n2 = r + 2 * NGW;
        if (n1 < nrows) row_load(n1, RB);
        row_compute(r, RA);
        if (n1 >= nrows) break;
        if (n2 < nrows) row_load(n2, RA);
        row_compute(n1, RB);
        r = n2;
    }
}

DI void phase_ln1(int l, int nrows, int wv) {
    const Frame F = mkframe(wv);
    const float* xin = inp(I_X); const float* cin = inp(I_CTX);
    const int gw = blockIdx.x * NWAVES + F.wave, NGW = F.G * NWAVES;
    const float* lg = inp(I_LN1G) + (size_t)l * D; const float* lbias = inp(I_LN1B) + (size_t)l * D;
    for (int r = gw; r < nrows; r += NGW) {
        const float* md = F.mod + ((size_t)l * 9 + modrow(r)) * MODW;
        float v[32], t[32];
        load_row_f32(xrow(xin, cin, F.X, l, r), F.lane, v);
        load_row_bf16(F.H + (size_t)r * D, F.lane, t);
        { float g1[32]; load_row_f32(md + 2 * D, F.lane, g1);
#pragma unroll
          for (int i = 0; i < 32; ++i) v[i] = ALPHA * v[i] + g1[i] * t[i]; }
        row_normalize(v);
        { float a[32], bb[32]; load_row_f32(lg, F.lane, a); load_row_f32(lbias, F.lane, bb);
#pragma unroll
          for (int i = 0; i < 32; ++i) v[i] = v[i] * a[i] + bb[i]; }
        store_row_f32(F.X + (size_t)r * D, F.lane, v);
        row_normalize(v);
        { float sh[32], sc[32]; load_row_f32(md + 3 * D, F.lane, sh); load_row_f32(md + 4 * D, F.lane, sc);
#pragma unroll
          for (int i = 0; i < 32; ++i) v[i] = v[i] * (1.0f + sc[i]) + sh[i]; }
        store_row_bf16(F.H + (size_t)r * D, F.lane, v);
    }
}

typedef __bf16 bf16x2v __attribute__((ext_vector_type(2)));
DI int crow32(int reg, int h) { return (reg & 3) + 8 * (reg >> 2) + 4 * h; }
#define CE_DESC(a, b) do { const float _x = (a), _y = (b); (a) = fmaxf(_x, _y); (b) = fminf(_x, _y); } while (0)
#define CE_ASC(a, b) do { const float _x = (a), _y = (b); (a) = fminf(_x, _y); (b) = fmaxf(_x, _y); } while (0)
DI void sort16_desc(float (&x)[16]) {
#pragma unroll
    for (int k = 2; k <= 16; k <<= 1)
#pragma unroll
        for (int j = k >> 1; j > 0; j >>= 1)
#pragma unroll
            for (int i = 0; i < 16; ++i) { const int l = i ^ j; if (l > i) { if ((i & k) == 0) CE_DESC(x[i], x[l]); else CE_ASC(x[i], x[l]); } }
}
DI void merge_top16(float (&a)[16], const float (&b)[16]) {
#pragma unroll
    for (int i = 0; i < 16; ++i) a[i] = fmaxf(a[i], b[15 - i]);
#pragma unroll
    for (int j = 8; j > 0; j >>= 1)
#pragma unroll
        for (int i = 0; i < 16; ++i) { const int l = i ^ j; if (l > i) CE_DESC(a[i], a[l]); }
}
DI void top16_of64(float (&x)[64], float (&t)[16]) {
    float g[4][16];
#pragma unroll
    for (int q = 0; q < 4; ++q) {
#pragma unroll
        for (int i = 0; i < 16; ++i) g[q][i] = x[q * 16 + i];
        sort16_desc(g[q]); }
    merge_top16(g[0], g[1]); merge_top16(g[2], g[3]); merge_top16(g[0], g[2]);
#pragma unroll
    for (int i = 0; i < 16; ++i) t[i] = g[0][i];
}
constexpr int cand_off(int i) { int o = 0; for (int a = 0; a < i; ++a) o += 16 / (a + 1); return o; }
static_assert(cand_off(16) == 50, "candidate count");
constexpr size_t WS_RIDX = 1068 * MiB, WS_RG = 1077 * MiB;
DI void route_block(const Frame& F, int t0, int t1) {
    const int lane = F.lane, r32 = lane & 31, hh = lane >> 5;
    unsigned short* RI = (unsigned short*)(F.ws + WS_RIDX) + (size_t)t0 * 128; float* RGl = (float*)(F.ws + WS_RG) + (size_t)t0 * 128;
    LAS unsigned* kl = (LAS unsigned*)(F.lds + 98304 + F.wave * 2048);
    const float NEG = -3.0e38f;
    const int ntile = (t1 - t0 + 31) / 32;
    for (int item = F.wave; item < ntile * NH; item += NWAVES) {
        const int tile = item >> 3, h = item & 7;
        const int tl = tile * 32 + r32; const bool valid = t0 + tl < t1;
        const int tok = valid ? t0 + tl : t1 - 1;
        float tv[2][16];
#pragma unroll
        for (int p = 0; p < 2; ++p) {
            f32x16 acc[4];
#pragma unroll
            for (int kb = 0; kb < 4; ++kb)
#pragma unroll
                for (int i = 0; i < 16; ++i) acc[kb][i] = 0.f;
            const bf16* qp = F.Y + (size_t)tok * D + (h * 2 + p) * 128 + 8 * hh;
            const bf16* kp = F.Keys + ((size_t)((h * 2 + p) * 128) + r32) * 128 + 8 * hh;
#pragma unroll 4
            for (int ks = 0; ks < 8; ++ks) {
                const bf16x8v bq = *(const bf16x8v*)(qp + ks * 16);
#pragma unroll
                for (int kb = 0; kb < 4; ++kb) { const bf16x8v ak = *(const bf16x8v*)(kp + (size_t)kb * 32 * 128 + ks * 16);
                    acc[kb] = __builtin_amdgcn_mfma_f32_32x32x16_bf16(ak, bq, acc[kb], 0, 0, 0); }
            }
            float x[64];
#pragma unroll
            for (int kb = 0; kb < 4; ++kb)
#pragma unroll
                for (int i = 0; i < 16; ++i) { const unsigned key = (unsigned)(kb * 32 + (i & 3) + 8 * (i >> 2)) + 4u * (unsigned)hh;
                    x[kb * 16 + i] = __uint_as_float((__float_as_uint(acc[kb][i]) & ~127u) | key); }
            float t[16], pb[16];
            top16_of64(x, t);
#pragma unroll
            for (int i = 0; i < 16; ++i) pb[i] = __shfl_xor(t[i], 32);
            merge_top16(t, pb);
#pragma unroll
            for (int i = 0; i < 16; ++i) tv[p][i] = t[i];
        }
#pragma unroll
        for (int w = 0; w < 8; ++w) { unsigned pk = 0;
#pragma unroll
            for (int b = 0; b < 4; ++b) { const int i = w * 4 + b; pk |= (__float_as_uint(i < 16 ? tv[0][i] : tv[1][i - 16]) & 127u) << (8 * b); }
            kl[w * 64 + lane] = pk; }
        float x[64];
#pragma unroll
        for (int i = 0; i < 64; ++i) x[i] = NEG;
#pragma unroll
        for (int i = 0; i < 16; ++i)
#pragma unroll
            for (int j = 0; j < 16; ++j) if ((i + 1) * (j + 1) <= 16) {
                const float sa = __uint_as_float(__float_as_uint(tv[0][i]) & ~127u), sb = __uint_as_float(__float_as_uint(tv[1][j]) & ~127u);
                x[cand_off(i) + j] = __uint_as_float((__float_as_uint(sa + sb) & ~255u) | (unsigned)(i * 16 + j)); }
        float c[16];
        top16_of64(x, c);
        asm volatile("s_waitcnt lgkmcnt(0)" ::: "memory");
        int eidx[16]; float ev[16]; float den = 0.f;
        const float mx = __uint_as_float(__float_as_uint(c[0]) & ~255u);
#pragma unroll
        for (int i = 0; i < 16; ++i) {
            const unsigned bits = __float_as_uint(c[i]); const int pos = bits & 255u, ia = pos >> 4, ib = 16 + (pos & 15);
            const unsigned wa = kl[(ia >> 2) * 64 + lane], wb = kl[(ib >> 2) * 64 + lane];
            const int ka = (wa >> (8 * (ia & 3))) & 127, kb2 = (wb >> (8 * (ib & 3))) & 127;
            eidx[i] = ka * 128 + kb2;
            ev[i] = __expf(__uint_as_float(bits & ~255u) - mx); den += ev[i]; }
        const float inv = 1.0f / den;
        if (valid) {
            if (hh == 0) {
#pragma unroll
                for (int q = 0; q < 2; ++q) *(u32x4*)(RI + tl * 128 + h * 16 + q * 8) = (u32x4){(unsigned)eidx[q * 8] | ((unsigned)eidx[q * 8 + 1] << 16), (unsigned)eidx[q * 8 + 2] | ((unsigned)eidx[q * 8 + 3] << 16), (unsigned)eidx[q * 8 + 4] | ((unsigned)eidx[q * 8 + 5] << 16), (unsigned)eidx[q * 8 + 6] | ((unsigned)eidx[q * 8 + 7] << 16)};
            } else {
#pragma unroll
                for (int q = 0; q < 4; ++q) *(f32x4*)(RGl + tl * 128 + h * 16 + q * 4) = (f32x4){ev[q * 4] * inv, ev[q * 4 + 1] * inv, ev[q * 4 + 2] * inv, ev[q * 4 + 3] * inv};
            }
        }
    }
}

DI float gelu_fast(float v) {
    const float av = fabsf(v), t = __builtin_amdgcn_rcpf(1.0f + 0.2316419f * av);
    float q = t * 0.5307027145f - 0.7265760135f; q = q * t + 0.7107068705f; q = q * t - 0.142248368f; q = q * t + 0.127414796f; q = q * t;
    const float m = v * (q * __builtin_amdgcn_exp2f(v * v * -0.72134752044f));
    return v < 0.f ? m : v - m;
}
constexpr size_t WS_PP = WS_OSC;
constexpr size_t WS_PW = WS_OSC + 72 * MiB;
static_assert(WS_PW + (size_t)NTOK * 128 * 4 <= WS_END, "ws map");
typedef float f32x2 __attribute__((ext_vector_type(2)));
template <int CTRL> DI float dpp_add(float x) { return x + __uint_as_float(__builtin_amdgcn_update_dpp(0u, __float_as_uint(x), CTRL, 0xf, 0xf, true)); }
struct ESeg { u32x4 a; u32x2 b; };
DI void eseg_load(ESeg& r, __amdgpu_buffer_rsrc_t rs, int voff) { r.a = __builtin_amdgcn_raw_buffer_load_b128(rs, voff, 0, 0); r.b = __builtin_amdgcn_raw_buffer_load_b64(rs, voff + 16, 0, 0); }
DI v32f eseg_unpack(const ESeg& r) { return __builtin_amdgcn_cvt_scalef32_pk32_f32_fp6((v6i){(int)r.a.x, (int)r.a.y, (int)r.a.z, (int)r.a.w, (int)r.b.x, (int)r.b.y}, 1.0f); }
DI unsigned char* uniform_ptr(unsigned char* p) {
    const unsigned long long v = (unsigned long long)p; const unsigned lo = __builtin_amdgcn_readfirstlane((unsigned)v), hi = __builtin_amdgcn_readfirstlane((unsigned)(v >> 32));
    return as_global<unsigned char>(((unsigned long long)hi << 32) | lo); }
DI void xcd_split(const Frame& F, int& x, int& wx, int& nwx) {
    if ((F.G & 7) == 0) { x = blockIdx.x & 7; wx = (blockIdx.x >> 3) * NWAVES + F.wave; nwx = (F.G >> 3) * NWAVES; }
    else { const int gw = blockIdx.x * NWAVES + F.wave, NW = F.G * NWAVES; x = gw & 7; wx = gw >> 3; nwx = (NW - x + 7) >> 3; }
}
DI void phase_peer_route(int nrows, int wv) {
    const Frame R = mkframe(wv);
    const int per0 = (nrows + R.G - 1) / R.G, s0 = blockIdx.x * per0, s1 = min(s0 + per0, nrows);
    __syncthreads();
    if (s0 < s1) route_block(R, s0, s1);
}
DI void ids_load(u32x4 (&d)[2], const unsigned short* RI16, int t, int g) { const u32x4* p = (const u32x4*)(RI16 + (size_t)t * 128 + g * 16); d[0] = p[0]; d[1] = p[1]; }
#ifndef ID_MASK
#define ID_MASK 0xffffu
#endif
DI int id_of(const u32x4 (&d)[2], int r, unsigned mask = 0xffffu) { const unsigned w = d[r >> 3][(r >> 1) & 3]; return (r & 1) ? (int)((w >> 16) & mask) : (int)(w & mask); }
template <int MODE = 0> DI void phase_peer_u(int nrows, int wv, unsigned mask = 0xffffu) {
    const Frame F = mkframe(wv);
    int x, wx, nwx; xcd_split(F, x, wx, nwx);
    const int lane = F.lane, s = lane & 7, g = lane >> 3, s24 = s * 24;
    const __amdgpu_buffer_rsrc_t US = __builtin_amdgcn_make_buffer_rsrc((void*)uniform_ptr((unsigned char*)F.U + (size_t)x * ESLICE), 0, (int)ESLICE, 0x00020000);
    const unsigned short* RI16 = (const unsigned short*)(F.ws + WS_RIDX);
    float* P = (float*)(F.ws + WS_PP) + (size_t)x * NTOK * 128;
    const bf16* Hs = F.H + (8 * x + s) * 4;
    int t = wx; if (t >= nrows) return;
    ESeg rw[16]; u32x4 idn[2], idnn[2]; u32x2 hp[8];
    { u32x4 idc[2]; ids_load(idc, RI16, t, g);
#pragma unroll
      for (int r = 0; r < 16; ++r) eseg_load(rw[r], US, id_of(idc, r, mask) * ESEG + s24); }
#pragma unroll
    for (int c = 0; c < 8; ++c) hp[c] = *(const u32x2*)(Hs + (size_t)t * D + c * 256);
    ids_load(idn, RI16, t + nwx < nrows ? t + nwx : t, g);
    __builtin_amdgcn_s_waitcnt(0);
    for (;;) {
        const int tn = t + nwx, tnn = tn + nwx, tn_c = tn < nrows ? tn : t, tnn_c = tnn < nrows ? tnn : t;
        ids_load(idnn, RI16, tnn_c, g);
        u32x2 hq[8];
#pragma unroll
        for (int c = 0; c < 8; ++c) hq[c] = hp[c];
        __builtin_amdgcn_sched_barrier(0);
#pragma unroll
        for (int c = 0; c < 8; ++c) hp[c] = *(const u32x2*)(Hs + (size_t)tn_c * D + c * 256);
        __builtin_amdgcn_sched_barrier(0);
        float o0 = 0.f, o1 = 0.f;
#pragma unroll
        for (int r = 0; r < 16; ++r) {
            if (MODE == 2) { o0 += __uint_as_float(rw[r].a.x ^ rw[r].a.w ^ rw[r].b.y); eseg_load(rw[r], US, id_of(idn, r, mask) * ESEG + s24); if (r & 1) __builtin_amdgcn_sched_barrier(0); continue; }
            typedef __bf16 bfx2 __attribute__((ext_vector_type(2))); typedef __bf16 bfx32 __attribute__((ext_vector_type(32)));
            const bfx32 rr = __builtin_amdgcn_cvt_scalef32_pk32_bf16_fp6((v6i){(int)rw[r].a.x, (int)rw[r].a.y, (int)rw[r].a.z, (int)rw[r].a.w, (int)rw[r].b.x, (int)rw[r].b.y}, 1.0f);
            float dA = 0.f, dB = 0.f;
#define DOT2(k, acc) acc = __builtin_amdgcn_fdot2_f32_bf16(__builtin_shufflevector(rr, rr, 2 * (k), 2 * (k) + 1), __builtin_bit_cast(bfx2, ((k) & 1) ? hq[(k) >> 1].y : hq[(k) >> 1].x), acc, false)
            DOT2(0, dA); DOT2(1, dB); DOT2(2, dA); DOT2(3, dB); DOT2(4, dA); DOT2(5, dB); DOT2(6, dA); DOT2(7, dB); DOT2(8, dA); DOT2(9, dB); DOT2(10, dA); DOT2(11, dB); DOT2(12, dA); DOT2(13, dB); DOT2(14, dA); DOT2(15, dB);
#undef DOT2
            float d = dA + dB;
            d = dpp_add<0xB1>(d); d = dpp_add<0x4E>(d); d = dpp_add<0x141>(d);
            if ((r >> 1) == s) { if (r & 1) o1 = d; else o0 = d; }
            if (MODE != 1) eseg_load(rw[r], US, id_of(idn, r, mask) * ESEG + s24);
            else asm volatile("" : "+v"(rw[r].a.x), "+v"(rw[r].a.y), "+v"(rw[r].a.z), "+v"(rw[r].a.w), "+v"(rw[r].b.x), "+v"(rw[r].b.y));
            if (r & 1) __builtin_amdgcn_sched_barrier(0);
        }
        *(f32x2*)(P + (size_t)t * 128 + g * 16 + 2 * s) = (f32x2){o0, o1};
        if (tn >= nrows) break;
        t = tn; idn[0] = idnn[0]; idn[1] = idnn[1];
    }
}
DI void phase_peer_w(int nrows, int wv) {
    const Frame F = mkframe(wv);
    const unsigned short* RI = (const unsigned short*)(F.ws + WS_RIDX); const float* RG = (const float*)(F.ws + WS_RG); const float* P = (const float*)(F.ws + WS_PP); float* W = (float*)(F.ws + WS_PW);
    const float* SU = (const float*)(F.ws + WS_ESCALE); const float* SV = SU + NEXP;
    const int n4 = nrows * 32;
    for (int i = blockIdx.x * NTHREADS + F.tid; i < n4; i += F.G * NTHREADS) {
        const u32x2 ep = *(const u32x2*)(RI + (size_t)i * 4); const u32x4 e = {ep.x & 0xffffu, ep.x >> 16, ep.y & 0xffffu, ep.y >> 16}; const f32x4 gt = *(const f32x4*)(RG + (size_t)i * 4);
        f32x4 sum = *(const f32x4*)(P + (size_t)i * 4);
#pragma unroll
        for (int xx = 1; xx < 8; ++xx) sum += *(const f32x4*)(P + (size_t)xx * NTOK * 128 + (size_t)i * 4);
        f32x4 w;
        w.x = gt.x * SV[e.x] * gelu_fast(SU[e.x] * sum.x); w.y = gt.y * SV[e.y] * gelu_fast(SU[e.y] * sum.y); w.z = gt.z * SV[e.z] * gelu_fast(SU[e.z] * sum.z); w.w = gt.w * SV[e.w] * gelu_fast(SU[e.w] * sum.w);
        *(f32x4*)(W + (size_t)i * 4) = w;
    }
}
DI void phase_peer_v(int l, int nrows, int wv, bool dry = false, unsigned mask = 0xffffu) {
    const Frame F = mkframe(wv);
    int x, wx, nwx; xcd_split(F, x, wx, nwx);
    const int lane = F.lane, s = lane & 7, g = lane >> 3, s24 = s * 24;
    const __amdgpu_buffer_rsrc_t VS = __builtin_amdgcn_make_buffer_rsrc((void*)uniform_ptr((unsigned char*)F.V + (size_t)x * ESLICE), 0, (int)ESLICE, 0x00020000);
    const unsigned short* RI16 = (const unsigned short*)(F.ws + WS_RIDX); const float* Wg = (const float*)(F.ws + WS_PW) + g * 16;
    const bool b3 = (lane >> 3) & 1; const int col = (((lane >> 5) * 2 + ((lane >> 4) & 1)) * 2 + (b3 ? 1 : 0)) * 256 + (8 * x + s) * 4;
    int t = wx; if (t >= nrows) return;
    ESeg rw[16]; u32x4 idn[2], idnn[2]; f32x4 wq[4];
    { u32x4 idc[2]; ids_load(idc, RI16, t, g);
#pragma unroll
      for (int r = 0; r < 16; ++r) eseg_load(rw[r], VS, id_of(idc, r, mask) * ESEG + s24); }
#pragma unroll
    for (int q = 0; q < 4; ++q) wq[q] = *(const f32x4*)(Wg + (size_t)t * 128 + q * 4);
    ids_load(idn, RI16, t + nwx < nrows ? t + nwx : t, g);
    __builtin_amdgcn_s_waitcnt(0);
    for (;;) {
        const int tn = t + nwx, tnn = tn + nwx, tn_c = tn < nrows ? tn : t, tnn_c = tnn < nrows ? tnn : t;
        ids_load(idnn, RI16, tnn_c, g);
        float wt[16];
#pragma unroll
        for (int q = 0; q < 4; ++q) { wt[q * 4] = wq[q].x; wt[q * 4 + 1] = wq[q].y; wt[q * 4 + 2] = wq[q].z; wt[q * 4 + 3] = wq[q].w; }
#pragma unroll
        for (int q = 0; q < 16; ++q) asm volatile("" : "+v"(wt[q]));
        __builtin_amdgcn_sched_barrier(0);
#pragma unroll
        for (int q = 0; q < 4; ++q) wq[q] = *(const f32x4*)(Wg + (size_t)tn_c * 128 + q * 4);
        float* xp = F.X + (size_t)t * D + col;
        const f32x4 x1 = *(const f32x4*)xp, g2 = *(const f32x4*)(F.mod + ((size_t)l * 9 + modrow(t)) * MODW + 5 * D + col);
        __builtin_amdgcn_sched_barrier(0);
        f32x2 fa[16];
#pragma unroll
        for (int j = 0; j < 16; ++j) fa[j] = (f32x2){0.f, 0.f};
#pragma unroll
        for (int r = 0; r < 16; ++r) {
            const v32f rr = eseg_unpack(rw[r]); const f32x2 w2 = {wt[r], wt[r]};
#pragma unroll
            for (int j = 0; j < 16; ++j) fa[j] = __builtin_elementwise_fma((f32x2){rr[2 * j], rr[2 * j + 1]}, w2, fa[j]);
            eseg_load(rw[r], VS, id_of(idn, r, mask) * ESEG + s24);
            if (r & 1) __builtin_amdgcn_sched_barrier(0);
        }
        float f16[16], f8[8];
#pragma unroll
        for (int j = 0; j < 16; ++j) { const float lo = (j & 1) ? fa[j >> 1].y : fa[j >> 1].x, hi = (j & 1) ? fa[8 + (j >> 1)].y : fa[8 + (j >> 1)].x;
            const auto a = __builtin_amdgcn_permlane32_swap(__float_as_uint(lo), __float_as_uint(hi), false, false); f16[j] = __uint_as_float(a[0]) + __uint_as_float(a[1]); }
#pragma unroll
        for (int j = 0; j < 8; ++j) { const auto a = __builtin_amdgcn_permlane16_swap(__float_as_uint(f16[j]), __float_as_uint(f16[j + 8]), false, false); f8[j] = __uint_as_float(a[0]) + __uint_as_float(a[1]); }
#pragma unroll
        for (int j = 0; j < 8; ++j) f8[j] = dpp_add<0x128>(f8[j]);
        f32x4 z;
        z.x = ALPHA * x1.x + g2.x * (b3 ? f8[4] : f8[0]); z.y = ALPHA * x1.y + g2.y * (b3 ? f8[5] : f8[1]); z.z = ALPHA * x1.z + g2.z * (b3 ? f8[6] : f8[2]); z.w = ALPHA * x1.w + g2.w * (b3 ? f8[7] : f8[3]);
        if (!dry) *(f32x4*)xp = z;
        if (tn >= nrows) break;
        t = tn; idn[0] = idnn[0]; idn[1] = idnn[1];
    }
}
DI void load16_f32(const float* src, int lane, float (&v)[32]) {
#pragma unroll
    for (int c = 0; c < 8; ++c) { const f32x4 a = *(const f32x4*)(src + c * 256 + lane * 4); v[c * 4 + 0] = a.x; v[c * 4 + 1] = a.y; v[c * 4 + 2] = a.z; v[c * 4 + 3] = a.w; }
}
DI void store16_f32(float* dst, int lane, const float (&v)[32]) {
#pragma unroll
    for (int c = 0; c < 8; ++c) *(f32x4*)(dst + c * 256 + lane * 4) = (f32x4){v[c * 4 + 0], v[c * 4 + 1], v[c * 4 + 2], v[c * 4 + 3]};
}
DI void phase_peer_ln2(int l, int nrows, bool last, int wv) {
    const Frame T = mkframe(wv);
    const int lane = T.lane;
    const float* lg2 = inp(I_LN2G) + (size_t)l * D; const float* lb2 = inp(I_LN2B) + (size_t)l * D;
#define CBAR() asm volatile("" ::: "memory")
    for (int r = blockIdx.x * NWAVES + T.wave; r < nrows; r += T.G * NWAVES) {
        float v[32];
        load16_f32(T.X + (size_t)r * D, lane, v);
        row_normalize(v);
        { float t[32]; load16_f32(lg2, lane, t);
#pragma unroll
          for (int i = 0; i < 32; ++i) v[i] *= t[i]; }
        CBAR();
        { float t[32]; load16_f32(lb2, lane, t);
#pragma unroll
          for (int i = 0; i < 32; ++i) v[i] += t[i]; }
        CBAR();
        store16_f32(last ? T.out + (size_t)r * D : T.X + (size_t)r * D, lane, v);
        if (!last) {
            const float* mdn = T.mod + ((size_t)(l + 1) * 9 + modrow(r)) * MODW;
            row_normalize(v);
            CBAR();
            { float t[32]; load16_f32(mdn + 1 * D, lane, t);
#pragma unroll
              for (int i = 0; i < 32; ++i) v[i] *= (1.0f + t[i]); }
            CBAR();
            { float t[32]; load16_f32(mdn + 0 * D, lane, t);
#pragma unroll
              for (int i = 0; i < 32; ++i) v[i] += t[i]; }
#pragma unroll
            for (int c = 0; c < 8; ++c) { u32x2 wv2; wv2.x = pk2(v[c * 4 + 0], v[c * 4 + 1]); wv2.y = pk2(v[c * 4 + 2], v[c * 4 + 3]);
                *(u32x2*)(T.H + (size_t)r * D + c * 256 + lane * 4) = wv2;
                *(unsigned*)(T.ws + WS_H8 + (size_t)r * D + c * 256 + lane * 4) = pk4_fp8(v[c * 4 + 0] * SA8_H, v[c * 4 + 1] * SA8_H, v[c * 4 + 2] * SA8_H, v[c * 4 + 3] * SA8_H); }
        }
        CBAR();
    }
#undef CBAR
}

#ifndef MK_N_LAUNCHES
#define MK_N_LAUNCHES 1
#endif
constexpr int PH_PER_LAYER = 15, N_PHASES = DEPTH * PH_PER_LAYER;
struct Args { const float* in[N_IN]; float* out; unsigned char* ws; int ph_lo, ph_hi; };
static_assert(sizeof(Args) == N_IN * 8 + 8 + 8 + 8, "Args has no padding");

struct OrderW8 : pg8::StaticOrder {
    int base, c_lo, nctx;
    __device__ void init3(int M_, int N_, int G_, int c_, int base_, int c_lo_, int nctx_) { init(M_, N_, G_, c_); base = base_; c_lo = c_lo_; nctx = nctx_; }
    __device__ bool unit_of(long L, pg8::Unit& u) const {
        if (L < nwg) { pg8::StaticOrder t = *this; t.c = (int)(L % G); return t.pg8::StaticOrder::next((int)(L / G), u); }
        const int r = (int)(L - nwg); if (r >= nctx) return false;
        u.pm = NLAT / 256 + (r & 7); u.pn = C_ZF / 256 + (r >> 3); return true;
    }
    __device__ bool next(int i, pg8::Unit& u) const {
        if (i < base) return unit_of((long)i * G + c, u);
        if (c < c_lo) return false;
        return unit_of((long)base * G + (long)(i - base) * (G - c_lo) + (c - c_lo), u);
    }
};
__global__ void __launch_bounds__(NTHREADS, 2) mk_fwd(Args args) {
    LAS unsigned char* ldsl = (LAS unsigned char*)lds_raw;
    for (int u = threadIdx.x; u < (LDS_BYTES - LDSCTL_OFF) / 4; u += NTHREADS) ((LAS unsigned*)(ldsl + LDSCTL_OFF))[u] = 0u;
    __syncthreads();
    if (threadIdx.x < N_IN + 2) { const int i = threadIdx.x; const unsigned long long v = i < N_IN ? (unsigned long long)args.in[i] : (i == N_IN ? (unsigned long long)args.out : (unsigned long long)args.ws);
        ((volatile LAS unsigned long long*)(ldsl + PTR_OFF))[i] = v; }
    __syncthreads();
    unsigned char* ws = as_global<unsigned char>(ld_ptr(N_IN + 1));
    const int wv = __builtin_amdgcn_readfirstlane(threadIdx.x >> 6);
    const int lo = args.ph_lo, hi = args.ph_hi;
    const bool multi = (hi - lo) > 1;
    XcdBarrier bar; bar.bar = (unsigned*)(ws + WS_CTL) + CW_BAR; bar.x = 0; bar.st = nullptr; bar.wv = wv;
    if (multi) bar = xcd_barrier_post((unsigned*)(ws + WS_CTL) + CW_BAR, (volatile LAS unsigned*)(ldsl + MISC_OFF) + 8, wv);
#ifndef PH_MASK
#define PH_MASK 0x7fff
#endif
#define IN(k) (((PH_MASK >> ((k) % PH_PER_LAYER)) & 1) && lo <= (k) && (k) < hi)
#define WSO() ({ unsigned long long _w = (unsigned long long)ws; asm volatile("" : "+s"(_w)); as_global<unsigned char>(_w); })
#define SEAM(k) do { if (IN(k) && IN((k) + 1)) xcd_barrier(bar); } while (0)

    for (int l = 0; l < DEPTH; ++l) {
        const int pb = l * PH_PER_LAYER;
        const bool last = (l == DEPTH - 1);
        const int nrows = last ? NLAT : NTOK;
        if (IN(pb + 0)) { phase_convert(l, wv, gridDim.x != 256); if (l == 0) phase_mod(wv);
#ifdef DUP_P0
            if (l == 0) { __syncthreads(); phase_convert(l, wv, gridDim.x != 256); phase_mod(wv); }
#endif
        }
        SEAM(pb + 0);
        if (IN(pb + 1) && l == 0) { phase_modulate1(l, wv);
#ifdef DUP_P1
            if (l == 0) { phase_modulate1(l, wv); phase_modulate1(l, wv); phase_modulate1(l, wv); phase_modulate1(l, wv); }
#endif
        }
        if (l == 0) SEAM(pb + 1);
        if (IN(pb + 2)) { unsigned char* wsl = WSO();
            {
                pg8::Gemm g{(bf16*)(wsl + WS_H), (bf16*)(wsl + WS_WIN), NTOK, 2 * DC, D, D}; pg8::StaticOrder S; S.init(NTOK, 2 * DC, (int)gridDim.x, (int)blockIdx.x);
                EpiStore E{(bf16*)(wsl + WS_PROJ) + C_ZF, INW, 1.0f, 1 << 30, 0};
                pg8::gemm_phase<EpiStore, pg8::StaticOrder, true, true>(ldsl, g, S, E, wv); }
            {
                const int mrows = last ? NLAT : NTOK;
                pg8::Gemm g{(bf16*)(wsl + WS_H8), (bf16*)(wsl + WS_WIN8), mrows, 10 * DC, D / 2, D / 2}; OrderW8 S;
                if (gridDim.x == 256) S.init3(mrows, 10 * DC, 256, (int)blockIdx.x, 9, 64, last ? 32 : 0);
                else S.init3(mrows, 10 * DC, (int)gridDim.x, (int)blockIdx.x, 1 << 20, 0, last ? 32 : 0);
                EpiStore E{(bf16*)(wsl + WS_PROJ), INW, 1.0f / (SW8 * SA8_H), C_ZF / 256, C_VI - C_ZF};
                pg8::gemm_phase<EpiStore, OrderW8, true, true, true>(ldsl, g, S, E, wv); }
        }
        SEAM(pb + 2);
        if (IN(pb + 3)) {
#ifdef DUP_PREP
            if (l == 0) phase_prep(l, wv, gridDim.x != 1);
#endif
            phase_prep(l, wv); }
        SEAM(pb + 3);
        if (IN(pb + 4)) { phase_scan(l, wv, gridDim.x == 256);
#ifdef DUP_P3
            if (l == 0) phase_scan(l, wv, gridDim.x == 256);
#endif
        }
        SEAM(pb + 4);
        if (IN(pb + 5)) phase_readout(l, nrows, wv);
        SEAM(pb + 5);
        if (IN(pb + 6)) { unsigned char* wsl = WSO(); pg8::Gemm g{(bf16*)(wsl + WS_H), (bf16*)(wsl + WS_WPA), nrows, D, D / 2, D / 2}; pg8::StaticOrder S; S.init(nrows, D, (int)gridDim.x, (int)blockIdx.x);
            EpiMerge E{(bf16*)(wsl + WS_PROJ) + C_GA, (bf16*)(wsl + WS_PROJ) + C_GB, INW, (bf16*)(wsl + WS_Y), D};
            pg8::gemm_phase<EpiMerge, pg8::StaticOrder, true, true, true>(ldsl, g, S, E, wv); }
        SEAM(pb + 6);
        if (IN(pb + 7)) { unsigned char* wsl = WSO(); pg8::Gemm g{(bf16*)(wsl + WS_Y), (bf16*)(wsl + WS_WO), nrows, D, D / 2, D / 2}; pg8::StaticOrder S; S.init(nrows, D, (int)gridDim.x, (int)blockIdx.x); EpiStore E{(bf16*)(wsl + WS_H), D, 1.0f / (SW8 * SA8_M), 1 << 30, 0};
            pg8::gemm_phase<EpiStore, pg8::StaticOrder, true, true, true>(ldsl, g, S, E, wv); }
        SEAM(pb + 7);
        if (IN(pb + 8)) phase_ln1(l, nrows, wv);
        SEAM(pb + 8);
        if (IN(pb + 9)) { unsigned char* wsl = WSO(); pg8::Gemm g{(bf16*)(wsl + WS_H), (bf16*)(wsl + WS_WQ), nrows, D, D, D}; pg8::StaticOrder S; S.init(nrows, D, (int)gridDim.x, (int)blockIdx.x); EpiStore E{(bf16*)(wsl + WS_Y), D, 1.0f, 1 << 30, 0};
            pg8::gemm_phase<EpiStore, pg8::StaticOrder, true, true>(ldsl, g, S, E, wv); }
        SEAM(pb + 9);

        if (IN(pb + 10)) { phase_peer_route(nrows, wv);
#ifdef DUP_RT
            if (last) phase_peer_route(nrows, wv);
#endif
        }
        SEAM(pb + 10);
        if (IN(pb + 11)) {
#ifdef DUP_PU
            if (last) phase_peer_u(nrows, wv, DUP_PU);
#endif
            phase_peer_u(nrows, wv); }
        SEAM(pb + 11);
        if (IN(pb + 12)) phase_peer_w(nrows, wv);
        SEAM(pb + 12);
        if (IN(pb + 13)) {
#ifdef DUP_PV
            if (last) phase_peer_v(l, nrows, wv, gridDim.x != 1, DUP_PV);
#endif
            phase_peer_v(l, nrows, wv); }
        SEAM(pb + 13);
        if (IN(pb + 14)) { phase_peer_ln2(l, nrows, last, wv);
#ifdef DUP_LN2
            if (last) { phase_peer_ln2(l, nrows, last, wv); phase_peer_ln2(l, nrows, last, wv); }
#endif
        }
        SEAM(pb + 14);
    }
#undef IN
#undef SEAM
}

extern "C" void kernel_launch(void* const* d_in, const int* in_sizes, int n_in, void* d_out, int out_size, void* d_ws, size_t ws_size, hipStream_t stream) {
    static int grid = 0;
    if (grid == 0) {
        if (n_in != N_IN || in_sizes[I_X] != NLAT * D || out_size != NLAT * D || ws_size < WS_H8 + 36 * MiB) { fprintf(stderr, "kernel_launch: unexpected shapes (n_in %d, ws %zu); nothing launched\n", n_in, ws_size); grid = -1; return; }
        int dev = 0, cus = 0, per_cu = 0;
        if (hipGetDevice(&dev) != hipSuccess || hipDeviceGetAttribute(&cus, hipDeviceAttributeMultiprocessorCount, dev) != hipSuccess) { grid = -1; return; }
        if (hipFuncSetAttribute((const void*)mk_fwd, hipFuncAttributeMaxDynamicSharedMemorySize, LDS_BYTES) != hipSuccess) { fprintf(stderr, "kernel_launch: hipFuncSetAttribute failed\n"); grid = -1; return; }
        if (hipOccupancyMaxActiveBlocksPerMultiprocessor(&per_cu, (const void*)mk_fwd, NTHREADS, LDS_BYTES) != hipSuccess || per_cu < 1) { fprintf(stderr, "kernel_launch: occupancy query says %d\n", per_cu); per_cu = 1; }
        (void)hipGetLastError();
        grid = cus;
        if ((NTOK + grid - 1) / grid > 96) { fprintf(stderr, "kernel_launch: %d CUs: the PEER phase holds at most 96 tokens per workgroup in LDS; nothing launched\n", cus); grid = -1; return; }
    }
    if (grid < 0) return;
    if (hipMemsetAsync((char*)d_ws + WS_CTL, 0, CTL_ZERO_BYTES, stream) != hipSuccess) return;
    Args a{};
    for (int i = 0; i < N_IN; ++i) a.in[i] = (const float*)d_in[i];
    a.out = (float*)d_out; a.ws = (unsigned char*)d_ws;
#if MK_N_LAUNCHES == 1
    a.ph_lo = 0; a.ph_hi = N_PHASES;
    hipLaunchKernelGGL(mk_fwd, dim3(grid), dim3(NTHREADS), LDS_BYTES, stream, a);
#else
    for (int p = 0; p < N_PHASES; ++p) { a.ph_lo = p; a.ph_hi = p + 1; hipLaunchKernelGGL(mk_fwd, dim3(grid), dim3(NTHREADS), LDS_BYTES, stream, a); }
#endif
}
```

```cpp
#include <hip/hip_runtime.h>
#include <stdint.h>
#include <stdio.h>

#define MK_N_LAUNCHES 1
namespace pg8 {
#define PG8_LAS __attribute__((address_space(3)))
typedef unsigned short bf16_t;
typedef short bf16x8 __attribute__((ext_vector_type(8)));
typedef float f32x4 __attribute__((ext_vector_type(4)));
typedef unsigned u32x4 __attribute__((ext_vector_type(4)));
constexpr int BM = 256, BK = 64, HALF = 128, HTB = HALF * BK * 2  , STAGE_BYTES = 8 * HTB, NXCD = 8, WGM = 8;

__host__ __device__ __forceinline__ int lds_byte(int r, int c) { const int st = (r >> 4) * 2 + (c >> 5), rr = r & 15, cc = c & 31, ob = rr * 64 + cc * 2; return st * 1024 + (ob ^ (((ob >> 9) & 1) << 5)); }
__host__ __device__ __forceinline__ void stage_rc(int b, int& R, int& C) { const int st = b / 1024, sb = b % 1024, swz = sb ^ (((sb >> 9) & 1) << 5); R = (st >> 1) * 16 + swz / 64; C = (st & 1) * 32 + (swz % 64) / 2; }
__host__ __device__ __forceinline__ int perm32(int rho) { const int n = rho >> 4, i = rho & 15; return 8 * (i >> 2) + 4 * n + (i & 3); }

struct Unit { int pm, pn; };
struct Gemm { const bf16_t* A; const bf16_t* Bt; int M, N, K, lda; };

struct StaticOrder {
    int nM, nN, nwg, G, c;
    __host__ __device__ void init(int M, int N, int G_, int c_) { nM = M / BM; nN = N / BM; nwg = nM * nN; G = G_; c = c_; }
    __host__ __device__ bool next(int i, Unit& u) const {
        const long L = (long)i * G + c; if (L >= nwg) return false;
        int wgid = (int)L; { const int q = nwg / NXCD, r = nwg % NXCD, xcd = wgid % NXCD, off = wgid / NXCD; wgid = (xcd < r ? xcd * (q + 1) : r * (q + 1) + (xcd - r) * q) + off; }
        const int nig = WGM * nN, gid = wgid / nig, fm = gid * WGM, gsz = (nM - fm) < WGM ? (nM - fm) : WGM;
        u.pm = fm + ((wgid % nig) % gsz); u.pn = (wgid % nig) / gsz; return true;
    }
    __device__ __forceinline__ void a_ready(const Unit&) const {}
    __device__ __forceinline__ void done(const Unit&) const {}
};

__device__ __forceinline__ unsigned cvt_pk_bf16(float lo, float hi) { unsigned r; asm volatile("v_cvt_pk_bf16_f32 %0, %1, %2" : "=v"(r) : "v"(lo), "v"(hi)); return r; }
typedef float f32x2 __attribute__((ext_vector_type(2)));
typedef int i32x4 __attribute__((ext_vector_type(4)));
typedef int i32x8 __attribute__((ext_vector_type(8)));
__device__ __forceinline__ i32x8 cat8(bf16x8 lo, bf16x8 hi) { const i32x4 a = __builtin_bit_cast(i32x4, lo), b = __builtin_bit_cast(i32x4, hi); return __builtin_shufflevector(a, b, 0, 1, 2, 3, 4, 5, 6, 7); }
template <class Epi, class Sched, bool ALIGN_EPI = false, bool SP2 = false, bool F8 = false>
__device__ __forceinline__ void gemm_phase(PG8_LAS unsigned char* lds, const Gemm g, const Sched& S, const Epi& E, int wv) {
    int tid_ = wv * 64 + (int)__builtin_amdgcn_mbcnt_hi(~0u, __builtin_amdgcn_mbcnt_lo(~0u, 0u)); asm volatile("" : "+v"(tid_));
    const int tid = tid_, wid = __builtin_amdgcn_readfirstlane(tid >> 6), lane = tid & 63, wr = wid >> 2, wc = wid & 3, fr = lane & 15, fq = lane >> 4;
    const int K = g.K, nt = K / BK;
    unsigned voffA[2], voffB[2];
#pragma unroll
    for (int i = 0; i < 2; ++i) { int R, C; stage_rc(tid * 16 + i * 8192, R, C); const int Rb = Epi::PERM ? ((R & ~31) + perm32(R & 31)) : R;
        voffA[i] = (unsigned)(R * g.lda + C) * 2u; voffB[i] = (unsigned)(Rb * K + C) * 2u; }
    const size_t kstep = (size_t)(BK * 2);
    const size_t hstepA = (size_t)HALF * g.lda * 2, hstepB = (size_t)HALF * K * 2;
    const size_t tstepA = 2 * hstepA, tstepB = 2 * hstepB;
    const unsigned ldsw = (unsigned)wid * 1024u;
    const int aoff = lds_byte(wr * 64 + fr, fq * 8), boff = SP2 ? lds_byte((wc & 1) * 64 + fr, fq * 8) : lds_byte(wc * 32 + fr, fq * 8); const int hw = wc >> 1;
#define PG8_SA(b, h) (((b) * 2 + (h)) * HTB)
#define PG8_SB(b, h) ((4 + (b) * 2 + (h)) * HTB)
#define PG8_STAGE(bufoff, gbase, voff) do { _Pragma("unroll") for (int _i = 0; _i < 2; ++_i) \
        __builtin_amdgcn_global_load_lds((const unsigned*)((const char*)(gbase) + (voff)[_i]), (PG8_LAS unsigned*)(lds + (bufoff) + ldsw + _i * 8192), 16, 0, 0); } while (0)
#define PG8_LDA(dst, b, h) do { _Pragma("unroll") for (int m = 0; m < 4; ++m) _Pragma("unroll") for (int k = 0; k < 2; ++k) dst[m][k] = *(const PG8_LAS bf16x8*)(lds + PG8_SA(b, h) + aoff + m * 2048 + k * 1024); } while (0)
#define PG8_LDB(dst, b, h) do { _Pragma("unroll") for (int n = 0; n < 2; ++n) _Pragma("unroll") for (int k = 0; k < 2; ++k) dst[n][k] = *(const PG8_LAS bf16x8*)(lds + (SP2 ? PG8_SB(b, hw) + (h) * 4096 : PG8_SB(b, h)) + boff + n * 2048 + k * 1024); } while (0)
#define PG8_MMA(ai, bj, At, Bt) do { __builtin_amdgcn_s_setprio(1); _Pragma("unroll") for (int m = 0; m < 4; ++m) _Pragma("unroll") for (int n = 0; n < 2; ++n) { \
        if constexpr (F8) { const i32x8 _b = cat8(Bt[n][0], Bt[n][1]), _a = cat8(At[m][0], At[m][1]); asm volatile("v_mfma_f32_16x16x128_f8f6f4 %0, %1, %2, %0" : "+v"(acc[ai][bj][m][n]) : "v"(_b), "v"(_a)); } \
        else { _Pragma("unroll") for (int k = 0; k < 2; ++k) acc[ai][bj][m][n] = __builtin_amdgcn_mfma_f32_16x16x32_bf16(Bt[n][k], At[m][k], acc[ai][bj][m][n], 0, 0, 0); } } \
        __builtin_amdgcn_s_setprio(0); } while (0)
#define PG8_WAIT_V(n) asm volatile("s_waitcnt vmcnt(" #n ")" ::: "memory")
#define PG8_WAIT_L(n) asm volatile("s_waitcnt lgkmcnt(" #n ")" ::: "memory")
#define PG8_BAR __builtin_amdgcn_s_barrier()
#define PG8_SCHED __builtin_amdgcn_sched_barrier(0)
    Unit cur, nxt; int ui = 0;
    if (!S.next(0, cur)) return;
    f32x4 acc[2][2][4][2];
#pragma unroll
    for (int a = 0; a < 2; ++a)
#pragma unroll
        for (int b = 0; b < 2; ++b)
#pragma unroll
            for (int m = 0; m < 4; ++m)
#pragma unroll
                for (int n = 0; n < 2; ++n) acc[a][b][m][n] = (f32x4){0.f, 0.f, 0.f, 0.f};
    bf16x8 At[4][2], B0[2][2], B1[2][2];
    const char* cA = (const char*)g.A + (size_t)cur.pm * tstepA; const char* cB = (const char*)g.Bt + (size_t)cur.pn * tstepB;
    S.a_ready(cur);
    if constexpr (SP2) {
        PG8_STAGE(PG8_SB(0, 0), cB, voffB); PG8_STAGE(PG8_SB(0, 1), cB + hstepB, voffB); PG8_STAGE(PG8_SA(0, 0), cA, voffA); PG8_STAGE(PG8_SA(0, 1), cA + hstepA, voffA);
        if (wr == 1) PG8_BAR;
        PG8_WAIT_V(2); PG8_BAR;
        PG8_STAGE(PG8_SB(1, 0), cB + kstep, voffB); PG8_STAGE(PG8_SA(1, 0), cA + kstep, voffA); PG8_STAGE(PG8_SB(1, 1), cB + hstepB + kstep, voffB);
        PG8_WAIT_V(6); PG8_BAR;
    } else {
        PG8_STAGE(PG8_SB(0, 0), cB, voffB); PG8_STAGE(PG8_SA(0, 0), cA, voffA); PG8_STAGE(PG8_SB(0, 1), cB + hstepB, voffB); PG8_STAGE(PG8_SA(0, 1), cA + hstepA, voffA);
        if (wr == 1) PG8_BAR;
        PG8_WAIT_V(4); PG8_BAR;
        PG8_STAGE(PG8_SB(1, 0), cB + kstep, voffB); PG8_STAGE(PG8_SA(1, 0), cA + kstep, voffA); PG8_STAGE(PG8_SB(1, 1), cB + hstepB + kstep, voffB);
        PG8_WAIT_V(6); PG8_BAR;
    }
    for (;;) {
        const bool has_next = S.next(ui + 1, nxt);
        const char* nA = has_next ? (const char*)g.A + (size_t)nxt.pm * tstepA : cA; const char* nB = has_next ? (const char*)g.Bt + (size_t)nxt.pn * tstepB : cB;
        for (int t = 0; t < nt; t += 2) {
            if constexpr (Epi::MIDK) { if (t == nt / 2) { if constexpr (F8) asm volatile("s_nop 15\n\ts_nop 15" ::: "memory"); E.mid(acc, cur, wr, wc, fr, fq); } }
            const bool last = (t == nt - 2);
            const char* a1 = cA + (size_t)(t + 1) * kstep;
            const char* a2 = last ? nA : cA + (size_t)(t + 2) * kstep; const char* b2 = last ? nB : cB + (size_t)(t + 2) * kstep;
            const char* a3 = a2 + kstep; const char* b3 = b2 + kstep;
            if (last && has_next) S.a_ready(nxt);
            if constexpr (SP2) {
            PG8_LDB(B0, 0, 0); PG8_LDB(B1, 0, 1); PG8_SCHED; PG8_LDA(At, 0, 0); PG8_STAGE(PG8_SA(1, 1), a1 + hstepA, voffA);
            PG8_WAIT_V(8); PG8_WAIT_L(0); PG8_BAR; PG8_MMA(0, 0, At, B0); PG8_MMA(0, 1, At, B1); PG8_BAR; PG8_SCHED;
            PG8_LDA(At, 0, 1); PG8_STAGE(PG8_SB(0, 0), b2, voffB); PG8_STAGE(PG8_SB(0, 1), b2 + hstepB, voffB); PG8_STAGE(PG8_SA(0, 0), a2, voffA);
            PG8_WAIT_V(8); PG8_WAIT_L(0); PG8_BAR; PG8_MMA(1, 0, At, B0); PG8_MMA(1, 1, At, B1); PG8_BAR; PG8_SCHED;
            PG8_LDB(B0, 1, 0); PG8_LDB(B1, 1, 1); PG8_SCHED; PG8_LDA(At, 1, 0); PG8_STAGE(PG8_SA(0, 1), a2 + hstepA, voffA);
            PG8_WAIT_V(8); PG8_WAIT_L(0); PG8_BAR; PG8_MMA(0, 0, At, B0); PG8_MMA(0, 1, At, B1); PG8_BAR; PG8_SCHED;
            PG8_LDA(At, 1, 1); PG8_STAGE(PG8_SB(1, 0), b3, voffB); PG8_STAGE(PG8_SB(1, 1), b3 + hstepB, voffB); PG8_STAGE(PG8_SA(1, 0), a3, voffA);
            PG8_WAIT_V(8); PG8_WAIT_L(0); PG8_BAR; PG8_MMA(1, 0, At, B0); PG8_MMA(1, 1, At, B1); PG8_BAR; PG8_SCHED;
            } else {
            PG8_LDB(B0, 0, 0); PG8_SCHED; PG8_LDA(At, 0, 0); PG8_STAGE(PG8_SA(1, 1), a1 + hstepA, voffA);
            PG8_WAIT_L(8); PG8_BAR; PG8_WAIT_L(0); PG8_MMA(0, 0, At, B0); PG8_BAR; PG8_SCHED;
            PG8_LDB(B1, 0, 1); PG8_STAGE(PG8_SB(0, 0), b2, voffB);
            PG8_BAR; PG8_WAIT_L(0); PG8_MMA(0, 1, At, B1); PG8_BAR;
            PG8_LDA(At, 0, 1); PG8_STAGE(PG8_SA(0, 0), a2, voffA);
            PG8_BAR; PG8_WAIT_L(0); PG8_MMA(1, 0, At, B0); PG8_BAR; PG8_SCHED;
            PG8_STAGE(PG8_SB(0, 1), b2 + hstepB, voffB);
            PG8_WAIT_V(6); PG8_BAR; PG8_MMA(1, 1, At, B1); PG8_BAR;
            PG8_LDB(B0, 1, 0); PG8_SCHED; PG8_LDA(At, 1, 0); PG8_STAGE(PG8_SA(0, 1), a2 + hstepA, voffA);
            PG8_WAIT_L(8); PG8_BAR; PG8_WAIT_L(0); PG8_MMA(0, 0, At, B0); PG8_BAR; PG8_SCHED;
            PG8_LDB(B1, 1, 1); PG8_STAGE(PG8_SB(1, 0), b3, voffB);
            PG8_BAR; PG8_WAIT_L(0); PG8_MMA(0, 1, At, B1); PG8_BAR;
            PG8_LDA(At, 1, 1); PG8_STAGE(PG8_SA(1, 0), a3, voffA);
            PG8_BAR; PG8_WAIT_L(0); PG8_MMA(1, 0, At, B0); PG8_BAR; PG8_SCHED;
            PG8_STAGE(PG8_SB(1, 1), b3 + hstepB, voffB);
            PG8_WAIT_V(6); PG8_BAR; PG8_MMA(1, 1, At, B1); PG8_BAR;
            }
        }
        if constexpr (F8) asm volatile("s_nop 15\n\ts_nop 15" ::: "memory");
        if constexpr (ALIGN_EPI) { if (wr == 0) PG8_BAR; }
        if constexpr (!Epi::AFTER_DRAIN) { E(acc, cur, wr, wc, fr, fq); S.done(cur); }
        if (!has_next) break;
#pragma unroll
        for (int a = 0; a < 2; ++a)
#pragma unroll
            for (int b = 0; b < 2; ++b)
#pragma unroll
                for (int m = 0; m < 4; ++m)
#pragma unroll
                    for (int n = 0; n < 2; ++n) acc[a][b][m][n] = (f32x4){0.f, 0.f, 0.f, 0.f};
        cur = nxt; cA = nA; cB = nB; ++ui;
        if constexpr (ALIGN_EPI) { if (wr == 1) PG8_BAR; }
    }
    PG8_WAIT_V(0);
    if constexpr (!ALIGN_EPI) { if (wr == 0) PG8_BAR; }
    PG8_BAR;
    if constexpr (Epi::AFTER_DRAIN) { E.fused(acc, cur, wr, wc, fr, fq, lds, wid, lane); S.done(cur); }
#undef PG8_SA
#undef PG8_SB
#undef PG8_STAGE
#undef PG8_LDA
#undef PG8_LDB
#undef PG8_MMA
#undef PG8_WAIT_V
#undef PG8_WAIT_L
#undef PG8_BAR
#undef PG8_SCHED
}
}


#define LAS __attribute__((address_space(3)))
#define XB_TMO      128
#define XB_XCNT(j)  (256  + 64 * (j))
#define XB_XSUB(j)  (1280 + 64 * (j))
#define XB_XGEN(j)  (2304 + 64 * (j))
#define XB_TOP      3328
#define XB_TOPGEN   3392
#define XCD_BAR_WORDS 3456
#define XB_SPIN_CAP (1u << 20)

__device__ __forceinline__ unsigned xb_ld(unsigned* p)              { return __hip_atomic_load(p, __ATOMIC_RELAXED, __HIP_MEMORY_SCOPE_AGENT); }
__device__ __forceinline__ unsigned xb_add(unsigned* p, unsigned v) { return __hip_atomic_fetch_add(p, v, __ATOMIC_RELAXED, __HIP_MEMORY_SCOPE_AGENT); }
__device__ __forceinline__ unsigned xb_xcc_id() { return (unsigned)__builtin_amdgcn_s_getreg((3 << 11) | 20) & 0xFu; }
#define XB_SPIN(cond, bar) do { unsigned _sp = 0; while (cond) { __builtin_amdgcn_s_sleep(1); \
    if ((++_sp & 255u) == 0u) { if (xb_ld(&(bar)[XB_TMO])) break; if (_sp > XB_SPIN_CAP) { atomicAdd(&(bar)[XB_TMO], 1u); break; } } } } while (0)

struct XcdBarrier {
    unsigned* bar; unsigned x; int wv;
    volatile LAS unsigned* st;
};

__device__ __forceinline__ XcdBarrier xcd_barrier_post(unsigned* bar, volatile LAS unsigned* st, int wv) {
    XcdBarrier b; b.bar = bar; b.x = xb_xcc_id(); b.st = st; b.wv = wv;
    if (threadIdx.x == 0) (void)xb_add(&bar[XB_XCNT(b.x)], 1u);
    return b;
}
__device__ __forceinline__ void xcd_barrier_complete(unsigned* bar, unsigned x, unsigned& nloc, unsigned& nx) {
    const unsigned G = gridDim.x * gridDim.y * gridDim.z;
    unsigned sum, cnt, mine, sp = 0u;
    for (;;) {
        sum = 0u; cnt = 0u; mine = 0u;
#pragma unroll
        for (unsigned j = 0; j < 16; ++j) { const unsigned c = xb_ld(&bar[XB_XCNT(j)]); sum += c; cnt += (c > 0u) ? 1u : 0u; mine = (j == x) ? c : mine; }
        if (sum == G) break;
        __builtin_amdgcn_s_sleep(1);
        if ((++sp & 255u) == 0u) { if (xb_ld(&bar[XB_TMO])) break; if (sp > XB_SPIN_CAP) { atomicAdd(&bar[XB_TMO], 1u); break; } }
    }
    nloc = mine > 0u ? mine : 1u; nx = cnt > 0u ? cnt : 1u;
}

__device__ __forceinline__ void xcd_barrier(const XcdBarrier& b) {
    asm volatile("s_waitcnt vmcnt(0)" ::: "memory");
    __syncthreads();
    unsigned xb_z = 0u; asm volatile("" : "+v"(xb_z));
    if (b.wv == 0 && __builtin_amdgcn_mbcnt_hi(~0u, __builtin_amdgcn_mbcnt_lo(~0u, xb_z)) == 0u) {
        unsigned* bar = b.bar;
        __builtin_amdgcn_s_waitcnt(0);
        unsigned nloc = b.st[0], nx = b.st[1];
        if (nloc == 0u) { xcd_barrier_complete(bar, b.x, nloc, nx); b.st[0] = nloc; b.st[1] = nx; }
        const unsigned old = xb_add(&bar[XB_XSUB(b.x)], 1u);
        const unsigned gen = old / nloc;
        if (old + 1u == (gen + 1u) * nloc) {
            __builtin_amdgcn_fence(__ATOMIC_RELEASE, "agent");
            asm volatile("s_waitcnt vmcnt(0)" ::: "memory");
            const unsigned og = xb_add(&bar[XB_TOP], 1u);
            const unsigned tg = og / nx;
            if (og + 1u == (tg + 1u) * nx) xb_add(&bar[XB_TOPGEN], 1u);
            else XB_SPIN(xb_ld(&bar[XB_TOPGEN]) == tg, bar);
            __builtin_amdgcn_fence(__ATOMIC_ACQUIRE, "agent");
            xb_add(&bar[XB_XGEN(b.x)], 1u);
            asm volatile("s_waitcnt vmcnt(0)" ::: "memory");
        } else {
            XB_SPIN(xb_ld(&bar[XB_XGEN(b.x)]) == gen, bar);
            __builtin_amdgcn_fence(__ATOMIC_ACQUIRE, "agent");
            asm volatile("s_waitcnt vmcnt(0)" ::: "memory");
        }
    }
    __syncthreads();
}

constexpr int D = 2048, NBATCH = 8, SEQ = 2048, CTXL = 256, DEPTH = 2;
constexpr int NLAT = NBATCH * SEQ, NCTX = NBATCH * CTXL, NTOK = NLAT + NCTX;
constexpr int INW = 12288, MODW = 6 * D, DC = 1024, NH = 8, DK = 128, NEXP = 16384;
constexpr int C_CB = 0, C_CC = 1024, C_CV = 2048, C_Q = 3072, C_ZF = 4096, C_ZB = 5120, C_VI = 6144, C_OG = 7168, C_GA = 8192, C_GB = 10240;
constexpr int C_YA = 3072, C_YB = 4096;
constexpr float ALPHA = 1.41421356237309515f, LN_EPS = 1e-6f, F_MIN = 1e-30f, QSCALE = 0.08838834764831845f;
constexpr int NWAVES = 8, NTHREADS = 512;
enum { I_X = 0, I_C, I_CTX, I_CCTX, I_WMOD, I_BMOD, I_WIN, I_CONVW, I_CONVB, I_LBRAW, I_HGG, I_WPA, I_WPB, I_WO, I_LN1G, I_LN1B, I_WQ, I_KEYS, I_PU, I_PV, I_LN2G, I_LN2B, N_IN };

constexpr size_t MiB = 1u << 20;
constexpr size_t WS_CTL = 0, CTL_ZERO_BYTES = 64 * 1024;
constexpr size_t WS_MOD = 1 * MiB;
constexpr size_t WS_WIN = 2 * MiB;
constexpr size_t WS_WPA = 50 * MiB, WS_WPB = 54 * MiB;
constexpr size_t WS_WO = 58 * MiB, WS_WQ = 66 * MiB;
constexpr size_t WS_KEYS = 74 * MiB;
constexpr size_t WS_U = 76 * MiB, WS_V = 140 * MiB;
constexpr size_t WS_X = 204 * MiB;
constexpr size_t WS_H = 348 * MiB;
constexpr size_t WS_Y = 420 * MiB;
constexpr size_t WS_PROJ = 492 * MiB;
constexpr size_t WS_OSC = 924 * MiB;
constexpr size_t WS_END = 1068 * MiB;
static_assert(WS_PROJ + (size_t)NTOK * INW * 2 <= WS_OSC && WS_OSC + (size_t)2 * NTOK * DC * 4 <= WS_END, "ws map");
constexpr size_t WS_ESCALE = 75 * MiB;
constexpr size_t WS_LBT = 75 * MiB + 131072;
constexpr int EROW = 1536;
constexpr int EREC = 3072;
typedef _Float16 v32h __attribute__((ext_vector_type(32)));
typedef float v32f __attribute__((ext_vector_type(32)));
typedef int v6i __attribute__((ext_vector_type(6)));
constexpr float SW8 = 2048.0f, SA8_M = 8.0f, SA8_H = 16.0f, SA8_Y = 8.0f;
constexpr size_t WS_H8 = 1086 * MiB;
constexpr size_t WS_WIN8 = WS_WIN + 8 * MiB;
constexpr int CW_BAR = 4096;

constexpr int RING_BYTES = 131072, LDSCTL_OFF = 135168, MISC_OFF = LDSCTL_OFF + 320, LDS_BYTES = 147456;

#define DI __device__ __forceinline__
typedef unsigned short bf16;
typedef unsigned u32x4 __attribute__((ext_vector_type(4)));
typedef unsigned u32x2 __attribute__((ext_vector_type(2)));
typedef float f32x4 __attribute__((ext_vector_type(4)));
constexpr int ESEG = 192;
constexpr size_t ESLICE = (size_t)16384 * ESEG;
__device__ __forceinline__ void eseg_store(unsigned char* tbl, int e, int lane, const v6i p) {
    unsigned char* d = tbl + (size_t)(lane >> 3) * ESLICE + (size_t)e * ESEG + (lane & 7) * 24;
    *(u32x2*)d = (u32x2){(unsigned)p[0], (unsigned)p[1]}; *(u32x2*)(d + 8) = (u32x2){(unsigned)p[2], (unsigned)p[3]}; *(u32x2*)(d + 16) = (u32x2){(unsigned)p[4], (unsigned)p[5]};
}

DI float bf_lo(unsigned w) { return __uint_as_float(w << 16); }
DI float bf_hi(unsigned w) { return __uint_as_float(w & 0xffff0000u); }
DI unsigned pk2(float lo, float hi) { unsigned r; asm("v_cvt_pk_bf16_f32 %0, %1, %2" : "=v"(r) : "v"(lo), "v"(hi)); return r; }
DI float clamp448(float x) { return fminf(fmaxf(x, -448.0f), 448.0f); }
DI unsigned pk4_fp8(float a, float b, float c, float d) { int w = 0; w = __builtin_amdgcn_cvt_pk_fp8_f32(clamp448(a), clamp448(b), w, false); w = __builtin_amdgcn_cvt_pk_fp8_f32(clamp448(c), clamp448(d), w, true); return (unsigned)w; }
DI void unpack8(const u32x4 w, float (&f)[8]) { f[0] = bf_lo(w.x); f[1] = bf_hi(w.x); f[2] = bf_lo(w.y); f[3] = bf_hi(w.y); f[4] = bf_lo(w.z); f[5] = bf_hi(w.z); f[6] = bf_lo(w.w); f[7] = bf_hi(w.w); }
DI u32x4 pack8(const float (&f)[8]) { u32x4 w; w.x = pk2(f[0], f[1]); w.y = pk2(f[2], f[3]); w.z = pk2(f[4], f[5]); w.w = pk2(f[6], f[7]); return w; }
DI float wave_sum(float v) {
#pragma unroll
    for (int o = 1; o < 64; o <<= 1) v += __shfl_xor(v, o);
    return v;
}
DI float frcp(float x) { return __builtin_amdgcn_rcpf(x); }
DI float sigm(float x) { return frcp(1.0f + __expf(-x)); }
DI float silu(float x) { return x * frcp(1.0f + __expf(-x)); }
DI float gelu_erf(float x) { return 0.5f * x * (1.0f + erff(x * 0.70710678118654752f)); }

extern __shared__ __attribute__((aligned(16))) unsigned char lds_raw[];
constexpr int PTR_OFF = MISC_OFF + 256;
DI unsigned long long ld_ptr(int i) {
    const unsigned long long v = ((volatile LAS unsigned long long*)((LAS unsigned char*)lds_raw + PTR_OFF))[i];
    const unsigned lo = __builtin_amdgcn_readfirstlane((unsigned)v), hi = __builtin_amdgcn_readfirstlane((unsigned)(v >> 32));
    return ((unsigned long long)hi << 32) | lo;
}
template <class T> DI T* as_global(unsigned long long v) {
    return (T*)(__attribute__((address_space(1))) T*)v; }
DI const float* inp(int i) { return as_global<const float>(ld_ptr(i)); }
struct Frame {
    LAS unsigned char* lds;
    int tid, lane, wave, G;
    float* out; unsigned char* ws;
    float* mod; bf16 *Win, *Wpa, *Wpb, *Wo, *Wq, *Keys, *U, *V; float* X; bf16 *H, *Y, *PROJ; float* OSC;
};
DI int lane_id() { unsigned z = 0u; asm volatile("" : "+v"(z)); return (int)__builtin_amdgcn_mbcnt_hi(~0u, __builtin_amdgcn_mbcnt_lo(~0u, z)); }
DI Frame mkframe(int wv) {
    Frame F; int ln = lane_id(); asm volatile("" : "+v"(ln)); asm volatile("" : "+s"(wv));
    F.lds = (LAS unsigned char*)lds_raw; F.tid = wv * 64 + ln; F.lane = ln; F.wave = wv; F.G = gridDim.x;
    F.out = as_global<float>(ld_ptr(N_IN)); unsigned char* ws = as_global<unsigned char>(ld_ptr(N_IN + 1)); F.ws = ws;
    F.mod = (float*)(ws + WS_MOD); F.Win = (bf16*)(ws + WS_WIN); F.Wpa = (bf16*)(ws + WS_WPA); F.Wpb = (bf16*)(ws + WS_WPB); F.Wo = (bf16*)(ws + WS_WO); F.Wq = (bf16*)(ws + WS_WQ);
    F.Keys = (bf16*)(ws + WS_KEYS); F.U = (bf16*)(ws + WS_U); F.V = (bf16*)(ws + WS_V); F.X = (float*)(ws + WS_X); F.H = (bf16*)(ws + WS_H); F.Y = (bf16*)(ws + WS_Y);
    F.PROJ = (bf16*)(ws + WS_PROJ); F.OSC = (float*)(ws + WS_OSC);
    return F;
}
DI const float* xrow(const float* xin, const float* cin, const float* X, int l, int r) {
    if (l == 0) return r < NLAT ? xin + (size_t)r * D : cin + (size_t)(r - NLAT) * D;
    return X + (size_t)r * D;
}
DI int modrow(int r) { return r < NLAT ? r / SEQ : 8; }
DI float lower_bound(const float* lbraw, int l, int d, int c) {
    if (l == 0) return 0.0f;
    const float a0 = lbraw[d * DC + c], a1 = lbraw[2 * DC + d * DC + c];
    return 1.0f / (1.0f + __expf(a0 - a1));
}

DI void transpose_item(const float* W, int K, int N, bf16* WT, LAS float* scr, int item, int lane, int ldw = 0, int koff = 0, bool f8 = false, int win_split = 0) {
    if (ldw == 0) ldw = K;
    const int nblk = N / 64, kb = item / nblk, nb = item % nblk, k0 = 64 * kb, n0 = 64 * nb;
    int drow = n0;
    if (win_split) { if (n0 >= C_ZF && n0 < C_VI) { drow = n0 - C_ZF; } else { f8 = true; drow = n0 < C_ZF ? n0 : n0 - (C_VI - C_ZF); WT = (bf16*)((unsigned char*)WT + (WS_WIN8 - WS_WIN)); } }
    const int n4 = (lane & 15) * 4;
#pragma unroll 8
    for (int i = 0; i < 16; ++i) { const int kk = 4 * i + (lane >> 4); const f32x4 v = __builtin_nontemporal_load((const f32x4*)(W + (size_t)(k0 + kk) * N + n0 + n4));
        LAS float* d = scr + kk * 65 + n4; d[0] = v.x; d[1] = v.y; d[2] = v.z; d[3] = v.w; }
    __builtin_amdgcn_fence(__ATOMIC_RELEASE, "wavefront"); asm volatile("s_waitcnt lgkmcnt(0)" ::: "memory");
    const int c = lane & 7;
#pragma unroll
    for (int j = 0; j < 8; ++j) { const int n = (lane >> 3) + 8 * j; const LAS float* s = scr + (8 * c) * 65 + n;
        if (f8) { u32x2 o; o.x = pk4_fp8(s[0 * 65] * SW8, s[1 * 65] * SW8, s[2 * 65] * SW8, s[3 * 65] * SW8); o.y = pk4_fp8(s[4 * 65] * SW8, s[5 * 65] * SW8, s[6 * 65] * SW8, s[7 * 65] * SW8);
            *(u32x2*)((unsigned char*)WT + (size_t)(drow + n) * ldw + koff + k0 + 8 * c) = o; }
        else { u32x4 o; o.x = pk2(s[0 * 65], s[1 * 65]); o.y = pk2(s[2 * 65], s[3 * 65]); o.z = pk2(s[4 * 65], s[5 * 65]); o.w = pk2(s[6 * 65], s[7 * 65]);
            *(u32x4*)(WT + (size_t)(drow + n) * ldw + koff + k0 + 8 * c) = o; } }
    asm volatile("s_waitcnt lgkmcnt(0)" ::: "memory");
}
DI void cvt_copy(const Frame& F, const float* src, bf16* dst, size_t n) {
    const size_t nthreads = (size_t)F.G * NTHREADS;
    for (size_t i = (size_t)blockIdx.x * NTHREADS + F.tid; i < n / 8; i += nthreads) {
        const f32x4 a = *(const f32x4*)(src + i * 8), b = *(const f32x4*)(src + i * 8 + 4);
        u32x4 o; o.x = pk2(a.x, a.y); o.y = pk2(a.z, a.w); o.z = pk2(b.x, b.y); o.w = pk2(b.z, b.w);
        *(u32x4*)(dst + i * 8) = o;
    }
}
DI void phase_convert(int l, int wv, bool tables) {
    const Frame F = mkframe(wv);
    LAS float* scr = (LAS float*)(F.lds + F.wave * 16640);
    const int gw = blockIdx.x * NWAVES + F.wave, NGW = F.G * NWAVES;
    constexpr int IT_IN = (D / 64) * (INW / 64), IT_PA = (DC / 64) * (D / 64), IT_O = (D / 64) * (D / 64);
    constexpr int NITEMS = IT_IN + 2 * IT_PA + 2 * IT_O;
    for (int it = gw; it < NITEMS; it += NGW) {
        int r = it;
        if (r < IT_IN) { transpose_item(inp(I_WIN) + (size_t)l * D * INW, D, INW, F.Win, scr, r, F.lane, D, 0, false, 1); continue; } r -= IT_IN;
        if (r < IT_PA) { transpose_item(inp(I_WPA) + (size_t)l * DC * D, DC, D, F.Wpa, scr, r, F.lane, D, 0, true); continue; } r -= IT_PA;
        if (r < IT_PA) { transpose_item(inp(I_WPB) + (size_t)l * DC * D, DC, D, F.Wpa, scr, r, F.lane, D, DC, true); continue; } r -= IT_PA;
        if (r < IT_O)  { transpose_item(inp(I_WO) + (size_t)l * D * D, D, D, F.Wo, scr, r, F.lane, D, 0, true); continue; } r -= IT_O;
        transpose_item(inp(I_WQ) + (size_t)l * D * D, D, D, F.Wq, scr, r, F.lane);
    }
    cvt_copy(F, inp(I_KEYS) + (size_t)l * NH * 2 * 128 * 128, F.Keys, (size_t)NH * 2 * 128 * 128);
    if (blockIdx.x == 0) { const float* lbraw = inp(I_LBRAW); float* lbt = (float*)(F.ws + WS_LBT);
        for (int i = F.tid; i < 2 * DC; i += NTHREADS) lbt[i] = lower_bound(lbraw, l, i / DC, i % DC); }
    { const float* pu = inp(I_PU) + (size_t)l * NEXP * D; const float* pv = inp(I_PV) + (size_t)l * NEXP * D;
      unsigned char* U6 = (unsigned char*)F.U; unsigned char* V6 = (unsigned char*)F.V; float* SU = (float*)(F.ws + WS_ESCALE); float* SV = SU + NEXP;
      if (tables) for (int it = gw; it < 2 * NEXP; it += NGW) {
          const int e = it >> 1; const float* src = ((it & 1) ? pv : pu) + (size_t)e * D; unsigned char* dst = (it & 1) ? V6 : U6;
          f32x4 x[8]; float am = 0.f;
#pragma unroll
          for (int c = 0; c < 8; ++c) { x[c] = __builtin_nontemporal_load((const f32x4*)(src + c * 256 + F.lane * 4));
              am = fmaxf(am, fmaxf(fmaxf(fabsf(x[c].x), fabsf(x[c].y)), fmaxf(fabsf(x[c].z), fabsf(x[c].w)))); }
#pragma unroll
          for (int o = 1; o < 64; o <<= 1) am = fmaxf(am, __shfl_xor(am, o));
          const float inv = am > 0.f ? 7.0f / am : 0.f, sc = am > 0.f ? am * (1.0f / 7.0f) : 0.f;
          v32h hx;
#pragma unroll
          for (int c = 0; c < 8; ++c) { hx[c * 4 + 0] = (_Float16)(x[c].x * inv); hx[c * 4 + 1] = (_Float16)(x[c].y * inv); hx[c * 4 + 2] = (_Float16)(x[c].z * inv); hx[c * 4 + 3] = (_Float16)(x[c].w * inv); }
          const v6i p = __builtin_amdgcn_cvt_scalef32_pk32_fp6_f16(hx, 1.0f);
          eseg_store(dst, e, F.lane, p);
          if (F.lane == 0) ((it & 1) ? SV : SU)[e] = sc;
      } }
}
DI void phase_mod(int wv) {
    const Frame F = mkframe(wv);
    LAS float* sv = (LAS float*)F.lds;
    LAS float* red = (LAS float*)(F.lds + 73728);
    constexpr int NITEM = 2 * (MODW / 64);
    if ((int)blockIdx.x >= NITEM) return;
    __syncthreads();
    const float* cvec = inp(I_C); const float* cctx = inp(I_CCTX); const float* wmod = inp(I_WMOD); const float* bmod = inp(I_BMOD);
    for (int i = F.tid; i < 9 * D; i += NTHREADS) { const int r = i / D, k = i % D; const float c = r < 8 ? cvec[r * D + k] : cctx[k]; sv[i] = silu(c); }
    __syncthreads();
    for (int item = blockIdx.x; item < NITEM; item += F.G) {
        const int l = item / (MODW / 64), nb = item % (MODW / 64);
        const float* W = wmod + (size_t)l * D * MODW + nb * 64 + F.lane;
        float acc[9];
#pragma unroll
        for (int r = 0; r < 9; ++r) acc[r] = 0.f;
#pragma unroll 8
        for (int kk = 0; kk < 256; ++kk) { const int k = F.wave * 256 + kk; const float w = __builtin_nontemporal_load(W + (size_t)k * MODW);
#pragma unroll
            for (int r = 0; r < 9; ++r) acc[r] += sv[r * D + k] * w; }
#pragma unroll
        for (int r = 0; r < 9; ++r) red[(F.wave * 9 + r) * 64 + F.lane] = acc[r];
        __syncthreads();
        for (int idx = F.tid; idx < 9 * 64; idx += NTHREADS) { const int r = idx / 64, nn = idx % 64; float s = bmod[l * MODW + nb * 64 + nn];
#pragma unroll
            for (int w = 0; w < 8; ++w) s += red[(w * 9 + r) * 64 + nn];
            F.mod[((size_t)l * 9 + r) * MODW + nb * 64 + nn] = s; }
        __syncthreads();
    }
}

DI void load_row_f32(const float* src, int lane, float (&v)[32]) {
#pragma unroll
    for (int c = 0; c < 4; ++c) { const f32x4 a = *(const f32x4*)(src + c * 512 + lane * 8), b = *(const f32x4*)(src + c * 512 + lane * 8 + 4);
        v[c * 8 + 0] = a.x; v[c * 8 + 1] = a.y; v[c * 8 + 2] = a.z; v[c * 8 + 3] = a.w; v[c * 8 + 4] = b.x; v[c * 8 + 5] = b.y; v[c * 8 + 6] = b.z; v[c * 8 + 7] = b.w; }
}
DI void store_row_f32(float* dst, int lane, const float (&v)[32]) {
#pragma unroll
    for (int c = 0; c < 4; ++c) { *(f32x4*)(dst + c * 512 + lane * 8) = (f32x4){v[c * 8 + 0], v[c * 8 + 1], v[c * 8 + 2], v[c * 8 + 3]};
        *(f32x4*)(dst + c * 512 + lane * 8 + 4) = (f32x4){v[c * 8 + 4], v[c * 8 + 5], v[c * 8 + 6], v[c * 8 + 7]}; }
}
DI void load_row_bf16(const bf16* src, int lane, float (&v)[32]) {
#pragma unroll
    for (int c = 0; c < 4; ++c) { const u32x4 w = *(const u32x4*)(src + c * 512 + lane * 8);
        v[c * 8 + 0] = bf_lo(w.x); v[c * 8 + 1] = bf_hi(w.x); v[c * 8 + 2] = bf_lo(w.y); v[c * 8 + 3] = bf_hi(w.y); v[c * 8 + 4] = bf_lo(w.z); v[c * 8 + 5] = bf_hi(w.z); v[c * 8 + 6] = bf_lo(w.w); v[c * 8 + 7] = bf_hi(w.w); }
}
DI void store_row_bf16(bf16* dst, int lane, const float (&v)[32]) {
#pragma unroll
    for (int c = 0; c < 4; ++c) { u32x4 w; w.x = pk2(v[c * 8 + 0], v[c * 8 + 1]); w.y = pk2(v[c * 8 + 2], v[c * 8 + 3]); w.z = pk2(v[c * 8 + 4], v[c * 8 + 5]); w.w = pk2(v[c * 8 + 6], v[c * 8 + 7]);
        *(u32x4*)(dst + c * 512 + lane * 8) = w; }
}
DI void row_normalize(float (&v)[32]) {
    float s = 0.f;
#pragma unroll
    for (int i = 0; i < 32; ++i) s += v[i];
    const float mean = wave_sum(s) * (1.0f / D);
    float q = 0.f;
#pragma unroll
    for (int i = 0; i < 32; ++i) { v[i] -= mean; q += v[i] * v[i]; }
    const float rstd = rsqrtf(wave_sum(q) * (1.0f / D) + LN_EPS);
#pragma unroll
    for (int i = 0; i < 32; ++i) v[i] *= rstd;
}

DI void phase_modulate1(int l, int wv) {
    const Frame F = mkframe(wv);
    const float* xin = inp(I_X); const float* cin = inp(I_CTX);
    const int gw = blockIdx.x * NWAVES + F.wave, NGW = F.G * NWAVES;
    for (int r = gw; r < NTOK; r += NGW) {
        const float* md = F.mod + ((size_t)l * 9 + modrow(r)) * MODW;
        float v[32], sh[32], sc[32];
        load_row_f32(xrow(xin, cin, F.X, l, r), F.lane, v);
        load_row_f32(md + 0 * D, F.lane, sh); load_row_f32(md + 1 * D, F.lane, sc);
        row_normalize(v);
#pragma unroll
        for (int i = 0; i < 32; ++i) v[i] = v[i] * (1.0f + sc[i]) + sh[i];
        store_row_bf16(F.H + (size_t)r * D, F.lane, v);
        unsigned char* h8 = F.ws + WS_H8 + (size_t)r * D;
#pragma unroll
        for (int c = 0; c < 4; ++c) *(u32x2*)(h8 + c * 512 + F.lane * 8) = (u32x2){pk4_fp8(v[c * 8 + 0] * SA8_H, v[c * 8 + 1] * SA8_H, v[c * 8 + 2] * SA8_H, v[c * 8 + 3] * SA8_H), pk4_fp8(v[c * 8 + 4] * SA8_H, v[c * 8 + 5] * SA8_H, v[c * 8 + 6] * SA8_H, v[c * 8 + 7] * SA8_H)};
    }
}

struct EpiStore {
    static constexpr bool PERM = true, AFTER_DRAIN = false, MIDK = false;
    bf16* O; int ldc; float scale; int split_pn, shift;
    DI void operator()(const pg8::f32x4 (&acc)[2][2][4][2], const pg8::Unit& u, int wr, int wc, int fr, int fq) const {
        const int row0 = u.pm * 256 + wr * 64 + fr, col0 = u.pn * 256 + (u.pn >= split_pn ? shift : 0) + wc * 64 + 8 * fq;
#pragma unroll
        for (int ai = 0; ai < 2; ++ai)
#pragma unroll
            for (int m = 0; m < 4; ++m) { bf16* rowp = O + (size_t)(row0 + ai * 128 + m * 16) * ldc + col0;
#pragma unroll
                for (int bj = 0; bj < 2; ++bj) { const pg8::f32x4 v0 = acc[ai][bj][m][0] * scale, v1 = acc[ai][bj][m][1] * scale;
                    u32x4 w; w.x = pk2(v0[0], v0[1]); w.y = pk2(v0[2], v0[3]); w.z = pk2(v1[0], v1[1]); w.w = pk2(v1[2], v1[3]);
                    *(u32x4*)(rowp + bj * 32) = w; } }
    }
};
struct EpiMerge {
    static constexpr bool PERM = true, AFTER_DRAIN = false, MIDK = true;
    const bf16* Ga; const bf16* Gb; int ldg; bf16* O; int ldc;
    DI void mid(pg8::f32x4 (&acc)[2][2][4][2], const pg8::Unit& u, int wr, int wc, int fr, int fq) const {
        asm volatile("" : "+v"(fr), "+v"(fq));
        const int row0 = u.pm * 256 + wr * 64 + fr, col0 = u.pn * 256 + wc * 64 + 8 * fq;
#pragma unroll
        for (int ai = 0; ai < 2; ++ai)
#pragma unroll
            for (int m = 0; m < 4; ++m) { const size_t rr = (size_t)(row0 + ai * 128 + m * 16);
#pragma unroll
                for (int bj = 0; bj < 2; ++bj) { float ga[8], gb[8];
                    unpack8(*(const u32x4*)(Ga + rr * ldg + col0 + bj * 32), ga); unpack8(*(const u32x4*)(Gb + rr * ldg + col0 + bj * 32), gb);
#pragma unroll
                    for (int j = 0; j < 8; ++j) { const float ratio = (1.0f + __expf(-gb[j])) * frcp(1.0f + __expf(-ga[j])); acc[ai][bj][m][j >> 2][j & 3] *= ratio; } }
                asm volatile("" ::: "memory"); }
    }
    DI void operator()(const pg8::f32x4 (&acc)[2][2][4][2], const pg8::Unit& u, int wr, int wc, int fr, int fq) const {
        const int row0 = u.pm * 256 + wr * 64 + fr, col0 = u.pn * 256 + wc * 64 + 8 * fq;
#pragma unroll
        for (int ai = 0; ai < 2; ++ai)
#pragma unroll
            for (int m = 0; m < 4; ++m) { const size_t rr = (size_t)(row0 + ai * 128 + m * 16);
#pragma unroll
                for (int bj = 0; bj < 2; ++bj) { const pg8::f32x4 v0 = acc[ai][bj][m][0], v1 = acc[ai][bj][m][1];
                    const float a[8] = {v0[0], v0[1], v0[2], v0[3], v1[0], v1[1], v1[2], v1[3]}; float g[8], o[8];
                    unpack8(*(const u32x4*)(Gb + rr * ldg + col0 + bj * 32), g);
#pragma unroll
                    for (int j = 0; j < 8; ++j) o[j] = sigm(g[j]) * a[j] * (SA8_M / (SW8 * SA8_Y));
                    *(u32x2*)((unsigned char*)O + rr * ldc + col0 + bj * 32) = (u32x2){pk4_fp8(o[0], o[1], o[2], o[3]), pk4_fp8(o[4], o[5], o[6], o[7])}; } }
    }
};

typedef short bf16x8v __attribute__((ext_vector_type(8)));
typedef short s16x4v __attribute__((ext_vector_type(4)));
typedef float f32x16 __attribute__((ext_vector_type(16)));
DI unsigned short f2bf1(float x) { return (unsigned short)(pk2(x, 0.f) & 0xffffu); }
constexpr int C_QTF = C_CB, C_KTF = C_Q, C_QTB = C_ZF, C_KTB = C_ZB;
constexpr size_t WS_EV = 1068 * MiB;
DI float* ev_ptr(unsigned char* ws, int chunk, int h, int dir) { return (float*)(ws + WS_EV) + ((size_t)(chunk * NH + h) * 2 + dir) * 384; }
DI void phase_prep(int l, int wv, bool dry = false) {
    const Frame F = mkframe(wv);
    const float* lbt = (const float*)(F.ws + WS_LBT);
    const float* cw = inp(I_CONVW) + (size_t)l * 3 * DC; const float* cbias = inp(I_CONVB) + (size_t)l * DC;
    constexpr int O_TOTF = 0, O_TOTB = 2048, O_PRE = 4096;
    LAS unsigned char* L = F.lds;
    const int lane = F.lane, w = F.wave, pl = lane >> 3, cg = lane & 7, pp = w * 8 + pl;
    struct PrepIn { u32x4 cb, cc, cv, ccp, cvp, ccn, cvn, zf, zb, q; };
    constexpr int NITEM = (NTOK / 64) * NH * 2;
    auto item_load = [&](int item, PrepIn& P) {
        const int chunk = item >> 4, h = (item >> 1) & 7, hc = (item & 1) * 64 + cg * 8, row = chunk * 64 + pp, c0 = h * DK + hc;
        const bf16* prow = F.PROJ + (size_t)row * INW;
        bool hasp, hasn;
        if (row < NLAT) { hasp = pp != 0; hasn = pp != 63; } else { const int t = (row - NLAT) & (CTXL - 1); hasp = t != 0; hasn = t != CTXL - 1; }
        const bf16* pprev = hasp ? prow - INW : prow; const bf16* pnext = hasn ? prow + INW : prow;
        P.cb = *(const u32x4*)(prow + C_CB + c0); P.cc = *(const u32x4*)(prow + C_CC + c0); P.cv = *(const u32x4*)(prow + C_CV + c0);
        P.ccp = *(const u32x4*)(pprev + C_CC + c0); P.cvp = *(const u32x4*)(pprev + C_CV + c0); P.ccn = *(const u32x4*)(pnext + C_CC + c0); P.cvn = *(const u32x4*)(pnext + C_CV + c0);
        P.zf = *(const u32x4*)(prow + C_ZF + c0); P.zb = *(const u32x4*)(prow + C_ZB + c0); P.q = *(const u32x4*)(prow + C_Q + c0); };
    auto item_compute = [&](int item, const PrepIn& P) {
        const int chunk = item >> 4, h = (item >> 1) & 7, hc = (item & 1) * 64 + cg * 8, row = chunk * 64 + pp, c0 = h * DK + hc;
        bf16* prow = F.PROJ + (size_t)row * INW;
        bool hasp, hasn;
        if (row < NLAT) { hasp = pp != 0; hasn = pp != 63; } else { const int t = (row - NLAT) & (CTXL - 1); hasp = t != 0; hasn = t != CTXL - 1; }
        {   float cb[8], cc[8], cv[8], up[8], un[8], t0[8], t1[8], ya[8];
            unpack8(P.cb, cb); unpack8(P.cc, cc); unpack8(P.cv, cv);
            if (hasp) { unpack8(P.ccp, t0); unpack8(P.cvp, t1);
#pragma unroll
                for (int j = 0; j < 8; ++j) up[j] = t0[j] * t1[j]; }
            else {
#pragma unroll
                for (int j = 0; j < 8; ++j) up[j] = 0.f; }
            if (hasn) { unpack8(P.ccn, t0); unpack8(P.cvn, t1);
#pragma unroll
                for (int j = 0; j < 8; ++j) un[j] = t0[j] * t1[j]; }
            else {
#pragma unroll
                for (int j = 0; j < 8; ++j) un[j] = 0.f; }
            const f32x4 w0a = *(const f32x4*)(cw + c0), w0b = *(const f32x4*)(cw + c0 + 4), w1a = *(const f32x4*)(cw + DC + c0), w1b = *(const f32x4*)(cw + DC + c0 + 4);
            const f32x4 w2a = *(const f32x4*)(cw + 2 * DC + c0), w2b = *(const f32x4*)(cw + 2 * DC + c0 + 4), bia = *(const f32x4*)(cbias + c0), bib = *(const f32x4*)(cbias + c0 + 4);
#pragma unroll
            for (int j = 0; j < 8; ++j) { const float w0 = j < 4 ? w0a[j & 3] : w0b[j & 3], w1 = j < 4 ? w1a[j & 3] : w1b[j & 3], w2 = j < 4 ? w2a[j & 3] : w2b[j & 3], bi = j < 4 ? bia[j & 3] : bib[j & 3];
                ya[j] = cb[j] * (w0 * up[j] + w1 * (cc[j] * cv[j]) + w2 * un[j] + bi); }
            if (!dry) *(u32x2*)((unsigned char*)F.H + (size_t)row * D + c0) = (u32x2){pk4_fp8(ya[0] * SA8_Y, ya[1] * SA8_Y, ya[2] * SA8_Y, ya[3] * SA8_Y), pk4_fp8(ya[4] * SA8_Y, ya[5] * SA8_Y, ya[6] * SA8_Y, ya[7] * SA8_Y)};
        }
        float lff[8], lfb[8], kf[8], kb[8], qs[8];
        {   float zf[8], zb[8], q[8];
            unpack8(P.zf, zf); unpack8(P.zb, zb); unpack8(P.q, q);
            const f32x4 lfa = *(const f32x4*)(lbt + c0), lfc = *(const f32x4*)(lbt + c0 + 4), lba = *(const f32x4*)(lbt + DC + c0), lbc = *(const f32x4*)(lbt + DC + c0 + 4);
#pragma unroll
            for (int i = 0; i < 8; ++i) { const float lbf = i < 4 ? lfa[i & 3] : lfc[i & 3], lbb = i < 4 ? lba[i & 3] : lbc[i & 3];
                const float ef = __expf(fminf(fmaxf(-zf[i], -80.f), 80.f)), eb = __expf(fminf(fmaxf(-zb[i], -80.f), 80.f)), sf = frcp(1.0f + ef), sb = frcp(1.0f + eb);
                lff[i] = __logf(fmaxf(lbf + (1.0f - lbf) * sf, F_MIN)); kf[i] = (1.0f - lbf) * (ef * sf);
                lfb[i] = __logf(fmaxf(lbb + (1.0f - lbb) * sb, F_MIN)); kb[i] = (1.0f - lbb) * (eb * sb);
                qs[i] = q[i] * frcp(1.0f + __expf(-q[i])) * QSCALE; }
        }
#pragma unroll
        for (int d = 1; d < 8; d <<= 1) {
#pragma unroll
            for (int i = 0; i < 8; ++i) { const float o = __shfl_up(lff[i], 8 * d); if (pl >= d) lff[i] += o; const float o2 = __shfl_down(lfb[i], 8 * d); if (pl + d < 8) lfb[i] += o2; } }
        __syncthreads();
        if (pl == 7) { *(LAS f32x4*)(L + O_TOTF + (w * 64 + cg * 8) * 4) = (f32x4){lff[0], lff[1], lff[2], lff[3]}; *(LAS f32x4*)(L + O_TOTF + (w * 64 + cg * 8 + 4) * 4) = (f32x4){lff[4], lff[5], lff[6], lff[7]}; }
        if (pl == 0) { *(LAS f32x4*)(L + O_TOTB + (w * 64 + cg * 8) * 4) = (f32x4){lfb[0], lfb[1], lfb[2], lfb[3]}; *(LAS f32x4*)(L + O_TOTB + (w * 64 + cg * 8 + 4) * 4) = (f32x4){lfb[4], lfb[5], lfb[6], lfb[7]}; }
        __syncthreads();
        if (F.tid < 128) { const int dd = F.tid >> 6, cch = F.tid & 63; const LAS float* tp = (const LAS float*)(L + (dd ? O_TOTB : O_TOTF)) + cch; LAS float* pp_ = (LAS float*)(L + O_PRE) + dd * 640 + cch;
            float t[8];
#pragma unroll
            for (int ww = 0; ww < 8; ++ww) t[ww] = tp[ww * 64];
            float run = 0.f;
            if (dd == 0) {
#pragma unroll
                for (int ww = 0; ww < 8; ++ww) { pp_[ww * 64] = run; run += t[ww]; }
                pp_[512] = (t[0] + t[1]) + (t[2] + t[3]); }
            else {
#pragma unroll
                for (int ww = 7; ww >= 0; --ww) { pp_[ww * 64] = run; run += t[ww]; }
                pp_[512] = (t[4] + t[5]) + (t[6] + t[7]); }
            pp_[576] = run; }
        __syncthreads();
        {   float pf[8], rf[8], bf_[8], pb[8], rb[8], bb[8];
            const LAS float* PF = (const LAS float*)(L + O_PRE) + cg * 8; const LAS float* PB = PF + 640;
#pragma unroll
            for (int q4 = 0; q4 < 2; ++q4) { const f32x4 a0 = *(const LAS f32x4*)(PF + w * 64 + q4 * 4), a1 = *(const LAS f32x4*)(PF + 512 + q4 * 4), a2 = *(const LAS f32x4*)(PF + 576 + q4 * 4);
                const f32x4 b0 = *(const LAS f32x4*)(PB + w * 64 + q4 * 4), b1 = *(const LAS f32x4*)(PB + 512 + q4 * 4), b2 = *(const LAS f32x4*)(PB + 576 + q4 * 4);
#pragma unroll
                for (int e = 0; e < 4; ++e) { const int i = q4 * 4 + e; pf[i] = a0[e]; rf[i] = a1[e]; bf_[i] = a2[e]; pb[i] = b0[e]; rb[i] = b1[e]; bb[i] = b2[e]; } }
            float o0[8], o1[8], o2[8], o3[8];
#pragma unroll
            for (int i = 0; i < 8; ++i) { const float bcf = pf[i] + lff[i], bcb = pb[i] + lfb[i];
                o0[i] = qs[i] * __expf(fminf(bcf - rf[i], 80.f)); o1[i] = kf[i] * __expf(fminf(rf[i] - bcf, 80.f));
                o2[i] = qs[i] * __expf(fminf(bcb - rb[i], 80.f)); o3[i] = kb[i] * __expf(fminf(rb[i] - bcb, 80.f)); }
            if (!dry) { *(u32x4*)(prow + C_QTF + c0) = pack8(o0); *(u32x4*)(prow + C_KTF + c0) = pack8(o1);
            *(u32x4*)(prow + C_QTB + c0) = pack8(o2); *(u32x4*)(prow + C_KTB + c0) = pack8(o3); }
            if (pp == 0 && !dry) {
                float* evf = ev_ptr(F.ws, chunk, h, 0) + hc; float* evb = ev_ptr(F.ws, chunk, h, 1) + hc;
#pragma unroll
                for (int q4 = 0; q4 < 2; ++q4) {
                    *(f32x4*)(evf + q4 * 4) = (f32x4){__expf(rf[q4 * 4]), __expf(rf[q4 * 4 + 1]), __expf(rf[q4 * 4 + 2]), __expf(rf[q4 * 4 + 3])};
                    *(f32x4*)(evf + 128 + q4 * 4) = (f32x4){__expf(bf_[q4 * 4] - rf[q4 * 4]), __expf(bf_[q4 * 4 + 1] - rf[q4 * 4 + 1]), __expf(bf_[q4 * 4 + 2] - rf[q4 * 4 + 2]), __expf(bf_[q4 * 4 + 3] - rf[q4 * 4 + 3])};
                    *(f32x4*)(evf + 256 + q4 * 4) = (f32x4){__expf(bf_[q4 * 4]), __expf(bf_[q4 * 4 + 1]), __expf(bf_[q4 * 4 + 2]), __expf(bf_[q4 * 4 + 3])};
                    *(f32x4*)(evb + q4 * 4) = (f32x4){__expf(rb[q4 * 4]), __expf(rb[q4 * 4 + 1]), __expf(rb[q4 * 4 + 2]), __expf(rb[q4 * 4 + 3])};
                    *(f32x4*)(evb + 128 + q4 * 4) = (f32x4){__expf(bb[q4 * 4] - rb[q4 * 4]), __expf(bb[q4 * 4 + 1] - rb[q4 * 4 + 1]), __expf(bb[q4 * 4 + 2] - rb[q4 * 4 + 2]), __expf(bb[q4 * 4 + 3] - rb[q4 * 4 + 3])};
                    *(f32x4*)(evb + 256 + q4 * 4) = (f32x4){__expf(bb[q4 * 4]), __expf(bb[q4 * 4 + 1]), __expf(bb[q4 * 4 + 2]), __expf(bb[q4 * 4 + 3])}; }
            }
        }
    };
    PrepIn PA, PB;
    int item = blockIdx.x;
    if (item < NITEM) item_load(item, PA);
    while (item < NITEM) {
        const int n1 = item + F.G, n2 = item + 2 * F.G;
        if (n1 < NITEM) item_load(n1, PB);
        item_compute(item, PA);
        if (n1 >= NITEM) break;
        if (n2 < NITEM) item_load(n2, PA);
        item_compute(n1, PB);
        item = n2;
    }
}
DI bf16x8v tr_frag(const LAS unsigned char* tile, int stride, int s0, int cbase, int lane) {
    const int i16 = lane & 15, g16 = (lane >> 4) & 1;
    const LAS unsigned char* p = tile + (s0 + (i16 >> 2)) * stride + (cbase + 16 * g16 + 4 * (i16 & 3)) * 2;
    const s16x4v lo = __builtin_amdgcn_ds_read_tr16_b64_v4i16((LAS s16x4v*)p), hi = __builtin_amdgcn_ds_read_tr16_b64_v4i16((LAS s16x4v*)(p + 4 * stride));
    return __builtin_shufflevector(lo, hi, 0, 1, 2, 3, 4, 5, 6, 7);
}
DI void phase_scan(int l, int wv, bool fill) {
    const Frame F = mkframe(wv);
    const float* pu = inp(I_PU) + (size_t)l * NEXP * D; const float* pv = inp(I_PV) + (size_t)l * NEXP * D;
    constexpr int RS = 272, RS64 = 144;
    constexpr int O_QT = 0, O_KT = 17408, O_ST = 34816, O_V = 52224, O_PM = 61440, O_EV = 70656;
    LAS unsigned char* L = F.lds;
    const int tid = F.tid, lane = F.lane, w = F.wave, r32 = lane & 31, hh = lane >> 5;
    const int srow = tid >> 3, sc16 = (tid & 7) * 16, svc = (tid & 7) * 8;
    for (int task = blockIdx.x; task < NBATCH * NH * 4; task += F.G) {
        const int b = task >> 5, h = (task >> 2) & 7, dir = (task >> 1) & 1, vh = task & 1;
        const int cq = (dir ? C_QTB : C_QTF) + h * DK + sc16, ck = (dir ? C_KTB : C_KTF) + h * DK + sc16, cvv = C_VI + h * DK + vh * 64 + svc;
        f32x16 S;
#pragma unroll
        for (int i = 0; i < 16; ++i) S[i] = 0.f;
        auto chunk_row0 = [&](int c) { return c < 4 ? NLAT + b * CTXL + (dir ? 3 - c : c) * 64 : b * SEQ + (dir ? 35 - c : c - 4) * 64; };
        u32x4 q0, q1, k0, k1, vr; f32x4 evr = (f32x4){0.f, 0.f, 0.f, 0.f};
        f32x4 fx[8]; const int fidx = (int)blockIdx.x * 4 + w; const bool filler = fill && w < 4;
        auto fill_load = [&](int it) { const float* src = ((it & 1) ? pv : pu) + (size_t)(it >> 1) * D; const float* src2 = src + 1024;
            unsigned lo = (unsigned)lane * 4u; asm volatile("" : "+v"(lo));
#pragma unroll
            for (int c8 = 0; c8 < 4; ++c8) { fx[c8] = __builtin_nontemporal_load((const f32x4*)(src + lo + c8 * 256)); fx[4 + c8] = __builtin_nontemporal_load((const f32x4*)(src2 + lo + c8 * 256)); } };
        if (filler) fill_load(fidx);
        {   const int row0 = chunk_row0(0); const bf16* pr = F.PROJ + (size_t)(row0 + srow) * INW;
            q0 = *(const u32x4*)(pr + cq); q1 = *(const u32x4*)(pr + cq + 8); k0 = *(const u32x4*)(pr + ck); k1 = *(const u32x4*)(pr + ck + 8); vr = *(const u32x4*)(pr + cvv);
            if (tid < 96) evr = *(const f32x4*)(ev_ptr(F.ws, row0 >> 6, h, dir) + tid * 4); }
        for (int c = 0; c < 36; ++c) {
            const int row0 = chunk_row0(c);
            __syncthreads();
            *(LAS u32x4*)(L + O_QT + srow * RS + sc16 * 2) = q0; *(LAS u32x4*)(L + O_QT + srow * RS + sc16 * 2 + 16) = q1;
            *(LAS u32x4*)(L + O_KT + srow * RS + sc16 * 2) = k0; *(LAS u32x4*)(L + O_KT + srow * RS + sc16 * 2 + 16) = k1;
            *(LAS u32x4*)(L + O_V + srow * RS64 + svc * 2) = vr;
            if (tid < 96) *(LAS f32x4*)(L + O_EV + tid * 16) = evr;
            if (c + 1 < 36) { const int rown = chunk_row0(c + 1); const bf16* pr = F.PROJ + (size_t)(rown + srow) * INW;
                q0 = *(const u32x4*)(pr + cq); q1 = *(const u32x4*)(pr + cq + 8); k0 = *(const u32x4*)(pr + ck); k1 = *(const u32x4*)(pr + ck + 8); vr = *(const u32x4*)(pr + cvv);
                if (tid < 96) evr = *(const f32x4*)(ev_ptr(F.ws, rown >> 6, h, dir) + tid * 4); }
            __syncthreads();
            {   const int kb = w >> 1, vb = w & 1;
                const LAS float* er = (const LAS float*)(L + O_EV) + kb * 32 + 4 * hh; const LAS float* ebr = er + 128; const LAS float* eb = er + 256;
#pragma unroll
                for (int g = 0; g < 4; ++g) { const f32x4 e4 = *(const LAS f32x4*)(er + 8 * g);
                    u32x2 pk; pk.x = pk2(S[4 * g] * e4.x, S[4 * g + 1] * e4.y); pk.y = pk2(S[4 * g + 2] * e4.z, S[4 * g + 3] * e4.w);
                    *(LAS u32x2*)(L + O_ST + (vb * 32 + r32) * RS + (kb * 32 + 8 * g + 4 * hh) * 2) = pk; }
                f32x16 U;
#pragma unroll
                for (int i = 0; i < 16; ++i) U[i] = 0.f;
#pragma unroll
                for (int ks = 0; ks < 4; ++ks) { const bf16x8v a = tr_frag(L + O_KT, RS, ks * 16 + 8 * hh, kb * 32, lane), bv = tr_frag(L + O_V, RS64, ks * 16 + 8 * hh, vb * 32, lane);
                    U = __builtin_amdgcn_mfma_f32_32x32x16_bf16(a, bv, U, 0, 0, 0); }
#pragma unroll
                for (int g = 0; g < 4; ++g) { const f32x4 b4 = *(const LAS f32x4*)(eb + 8 * g), c4 = *(const LAS f32x4*)(ebr + 8 * g);
                    S[4 * g] = b4.x * S[4 * g] + c4.x * U[4 * g]; S[4 * g + 1] = b4.y * S[4 * g + 1] + c4.y * U[4 * g + 1]; S[4 * g + 2] = b4.z * S[4 * g + 2] + c4.z * U[4 * g + 2]; S[4 * g + 3] = b4.w * S[4 * g + 3] + c4.w * U[4 * g + 3]; }
            }
            if (w < 4) {
                const int tb = w >> 1, sb = w & 1;
                f32x16 acc;
#pragma unroll
                for (int i = 0; i < 16; ++i) acc[i] = 0.f;
#pragma unroll 4
                for (int ks = 0; ks < 8; ++ks) { const bf16x8v a = *(const LAS bf16x8v*)(L + O_QT + (tb * 32 + r32) * RS + (ks * 16 + 8 * hh) * 2), bq = *(const LAS bf16x8v*)(L + O_KT + (sb * 32 + r32) * RS + (ks * 16 + 8 * hh) * 2);
                    acc = __builtin_amdgcn_mfma_f32_32x32x16_bf16(a, bq, acc, 0, 0, 0); }
#pragma unroll
                for (int i = 0; i < 16; ++i) { const int t = tb * 32 + (i & 3) + 8 * (i >> 2) + 4 * hh, sp = sb * 32 + r32; const bool keep = dir ? (sp >= t) : (sp <= t);
                    *(LAS unsigned short*)(L + O_PM + t * RS64 + sp * 2) = f2bf1(keep ? acc[i] : 0.f); }
            }
            __syncthreads();
            if (filler && c < 32) {
                const int it = fidx + 1024 * c, e = it >> 1; unsigned char* dst = (it & 1) ? (unsigned char*)F.V : (unsigned char*)F.U;
                float am = 0.f;
#pragma unroll
                for (int c8 = 0; c8 < 8; ++c8) am = fmaxf(am, fmaxf(fmaxf(fabsf(fx[c8].x), fabsf(fx[c8].y)), fmaxf(fabsf(fx[c8].z), fabsf(fx[c8].w))));
#pragma unroll
                for (int o = 1; o < 64; o <<= 1) am = fmaxf(am, __shfl_xor(am, o));
                const float inv = am > 0.f ? 7.0f / am : 0.f, sc = am > 0.f ? am * (1.0f / 7.0f) : 0.f;
                v32h hx;
#pragma unroll
                for (int c8 = 0; c8 < 8; ++c8) { hx[c8 * 4 + 0] = (_Float16)(fx[c8].x * inv); hx[c8 * 4 + 1] = (_Float16)(fx[c8].y * inv); hx[c8 * 4 + 2] = (_Float16)(fx[c8].z * inv); hx[c8 * 4 + 3] = (_Float16)(fx[c8].w * inv); }
                const v6i p = __builtin_amdgcn_cvt_scalef32_pk32_fp6_f16(hx, 1.0f);
                eseg_store(dst, e, lane, p);
                if (lane == 0) ((float*)(F.ws + WS_ESCALE) + ((it & 1) ? NEXP : 0))[e] = sc;
                if (c + 1 < 32) fill_load(it + 1024);
            }
            if (w >= 4) {
                const int tb = (w - 4) >> 1, vb = (w - 4) & 1;
                f32x16 acc;
#pragma unroll
                for (int i = 0; i < 16; ++i) acc[i] = 0.f;
#pragma unroll
                for (int ks = 0; ks < 4; ++ks) { const bf16x8v a = *(const LAS bf16x8v*)(L + O_PM + (tb * 32 + r32) * RS64 + (ks * 16 + 8 * hh) * 2), bv = tr_frag(L + O_V, RS64, ks * 16 + 8 * hh, vb * 32, lane);
                    acc = __builtin_amdgcn_mfma_f32_32x32x16_bf16(a, bv, acc, 0, 0, 0); }
#pragma unroll 4
                for (int ks = 0; ks < 8; ++ks) { const bf16x8v a = *(const LAS bf16x8v*)(L + O_QT + (tb * 32 + r32) * RS + (ks * 16 + 8 * hh) * 2), bs = *(const LAS bf16x8v*)(L + O_ST + (vb * 32 + r32) * RS + (ks * 16 + 8 * hh) * 2);
                    acc = __builtin_amdgcn_mfma_f32_32x32x16_bf16(a, bs, acc, 0, 0, 0); }
                bf16* ob = (bf16*)F.OSC + ((size_t)dir * NTOK + row0) * DC + h * DK + vh * 64 + vb * 32 + r32;
#pragma unroll
                for (int i = 0; i < 16; ++i) { const int t = tb * 32 + (i & 3) + 8 * (i >> 2) + 4 * hh; ob[(size_t)t * DC] = f2bf1(acc[i]); }
            }
        }
    }
}

DI void phase_readout(int l, int nrows, int wv) {
    const Frame F = mkframe(wv);
    const int gw = blockIdx.x * NWAVES + F.wave, NGW = F.G * NWAVES;
    const float* ng = inp(I_HGG) + (size_t)l * DK;
    struct RowIn { u32x4 a[2], b[2]; u32x4 og[2]; };
    auto row_load = [&](int r, RowIn& R) { const bf16* prow = F.PROJ + (size_t)r * INW; const bf16* osc = (const bf16*)F.OSC;
#pragma unroll
        for (int c = 0; c < 2; ++c) { const int e0 = c * 512 + F.lane * 8;
            R.a[c] = *(const u32x4*)(osc + (size_t)r * DC + e0); R.b[c] = *(const u32x4*)(osc + ((size_t)NTOK + r) * DC + e0);
            R.og[c] = *(const u32x4*)(prow + C_OG + e0); } };
    auto row_compute = [&](int r, const RowIn& R) {
#pragma unroll
        for (int c = 0; c < 2; ++c) {
            const int e0 = c * 512 + F.lane * 8;
            float o[8], og[8], yb[8]; float ss = 0.f;
            { float fa[8], fb[8]; unpack8(R.a[c], fa); unpack8(R.b[c], fb);
#pragma unroll
              for (int j = 0; j < 8; ++j) o[j] = fa[j] + fb[j]; }
#pragma unroll
            for (int j = 0; j < 8; ++j) ss += o[j] * o[j];
            ss += __shfl_xor(ss, 1); ss += __shfl_xor(ss, 2); ss += __shfl_xor(ss, 4); ss += __shfl_xor(ss, 8);
            const float rs = rsqrtf(ss * (1.0f / DK) + LN_EPS);
            unpack8(R.og[c], og);
#pragma unroll
            for (int j = 0; j < 8; ++j) yb[j] = o[j] * rs * ng[(e0 + j) & (DK - 1)] * silu(og[j]);
            *(u32x2*)((unsigned char*)F.H + (size_t)r * D + DC + e0) = (u32x2){pk4_fp8(yb[0] * SA8_Y, yb[1] * SA8_Y, yb[2] * SA8_Y, yb[3] * SA8_Y), pk4_fp8(yb[4] * SA8_Y, yb[5] * SA8_Y, yb[6] * SA8_Y, yb[7] * SA8_Y)};
        } };
    RowIn RA, RB;
    int r = gw;
    if (r < nrows) row_load(r, RA);
    while (r < nrows) {
        const int n1 = r + NGW, n2 = r + 2 * NGW;
        if (n1 < nrows) row_load(n1, RB);
        row_compute(r, RA);
        if (n1 >= nrows) break;
        if (n2 < nrows) row_load(n2, RA);
        row_compute(n1, RB);
        r = n2;
    }
}

DI void phase_ln1(int l, int nrows, int wv) {
    const Frame F = mkframe(wv);
    const float* xin = inp(I_X); const float* cin = inp(I_CTX);
    const int gw = blockIdx.x * NWAVES + F.wave, NGW = F.G * NWAVES;
    const float* lg = inp(I_LN1G) + (size_t)l * D; const float* lbias = inp(I_LN1B) + (size_t)l * D;
    for (int r = gw; r < nrows; r += NGW) {
        const float* md = F.mod + ((size_t)l * 9 + modrow(r)) * MODW;
        float v[32], t[32];
        load_row_f32(xrow(xin, cin, F.X, l, r), F.lane, v);
        load_row_bf16(F.H + (size_t)r * D, F.lane, t);
        { float g1[32]; load_row_f32(md + 2 * D, F.lane, g1);
#pragma unroll
          for (int i = 0; i < 32; ++i) v[i] = ALPHA * v[i] + g1[i] * t[i]; }
        row_normalize(v);
        { float a[32], bb[32]; load_row_f32(lg, F.lane, a); load_row_f32(lbias, F.lane, bb);
#pragma unroll
          for (int i = 0; i < 32; ++i) v[i] = v[i] * a[i] + bb[i]; }
        store_row_f32(F.X + (size_t)r * D, F.lane, v);
        row_normalize(v);
        { float sh[32], sc[32]; load_row_f32(md + 3 * D, F.lane, sh); load_row_f32(md + 4 * D, F.lane, sc);
#pragma unroll
          for (int i = 0; i < 32; ++i) v[i] = v[i] * (1.0f + sc[i]) + sh[i]; }
        store_row_bf16(F.H + (size_t)r * D, F.lane, v);
    }
}

typedef __bf16 bf16x2v __attribute__((ext_vector_type(2)));
DI int crow32(int reg, int h) { return (reg & 3) + 8 * (reg >> 2) + 4 * h; }
#define CE_DESC(a, b) do { const float _x = (a), _y = (b); (a) = fmaxf(_x, _y); (b) = fminf(_x, _y); } while (0)
#define CE_ASC(a, b) do { const float _x = (a), _y = (b); (a) = fminf(_x, _y); (b) = fmaxf(_x, _y); } while (0)
DI void sort16_desc(float (&x)[16]) {
#pragma unroll
    for (int k = 2; k <= 16; k <<= 1)
#pragma unroll
        for (int j = k >> 1; j > 0; j >>= 1)
#pragma unroll
            for (int i = 0; i < 16; ++i) { const int l = i ^ j; if (l > i) { if ((i & k) == 0) CE_DESC(x[i], x[l]); else CE_ASC(x[i], x[l]); } }
}
DI void merge_top16(float (&a)[16], const float (&b)[16]) {
#pragma unroll
    for (int i = 0; i < 16; ++i) a[i] = fmaxf(a[i], b[15 - i]);
#pragma unroll
    for (int j = 8; j > 0; j >>= 1)
#pragma unroll
        for (int i = 0; i < 16; ++i) { const int l = i ^ j; if (l > i) CE_DESC(a[i], a[l]); }
}
DI void top16_of64(float (&x)[64], float (&t)[16]) {
    float g[4][16];
#pragma unroll
    for (int q = 0; q < 4; ++q) {
#pragma unroll
        for (int i = 0; i < 16; ++i) g[q][i] = x[q * 16 + i];
        sort16_desc(g[q]); }
    merge_top16(g[0], g[1]); merge_top16(g[2], g[3]); merge_top16(g[0], g[2]);
#pragma unroll
    for (int i = 0; i < 16; ++i) t[i] = g[0][i];
}
constexpr int cand_off(int i) { int o = 0; for (int a = 0; a < i; ++a) o += 16 / (a + 1); return o; }
static_assert(cand_off(16) == 50, "candidate count");
constexpr size_t WS_RIDX = 1068 * MiB, WS_RG = 1077 * MiB;
DI void route_block(const Frame& F, int t0, int t1) {
    const int lane = F.lane, r32 = lane & 31, hh = lane >> 5;
    unsigned short* RI = (unsigned short*)(F.ws + WS_RIDX) + (size_t)t0 * 128; float* RGl = (float*)(F.ws + WS_RG) + (size_t)t0 * 128;
    LAS unsigned* kl = (LAS unsigned*)(F.lds + 98304 + F.wave * 2048);
    const float NEG = -3.0e38f;
    const int ntile = (t1 - t0 + 31) / 32;
    for (int item = F.wave; item < ntile * NH; item += NWAVES) {
        const int tile = item >> 3, h = item & 7;
        const int tl = tile * 32 + r32; const bool valid = t0 + tl < t1;
        const int tok = valid ? t0 + tl : t1 - 1;
        float tv[2][16];
#pragma unroll
        for (int p = 0; p < 2; ++p) {
            f32x16 acc[4];
#pragma unroll
            for (int kb = 0; kb < 4; ++kb)
#pragma unroll
                for (int i = 0; i < 16; ++i) acc[kb][i] = 0.f;
            const bf16* qp = F.Y + (size_t)tok * D + (h * 2 + p) * 128 + 8 * hh;
            const bf16* kp = F.Keys + ((size_t)((h * 2 + p) * 128) + r32) * 128 + 8 * hh;
#pragma unroll 4
            for (int ks = 0; ks < 8; ++ks) {
                const bf16x8v bq = *(const bf16x8v*)(qp + ks * 16);
#pragma unroll
                for (int kb = 0; kb < 4; ++kb) { const bf16x8v ak = *(const bf16x8v*)(kp + (size_t)kb * 32 * 128 + ks * 16);
                    acc[kb] = __builtin_amdgcn_mfma_f32_32x32x16_bf16(ak, bq, acc[kb], 0, 0, 0); }
            }
            float x[64];
#pragma unroll
            for (int kb = 0; kb < 4; ++kb)
#pragma unroll
                for (int i = 0; i < 16; ++i) { const unsigned key = (unsigned)(kb * 32 + (i & 3) + 8 * (i >> 2)) + 4u * (unsigned)hh;
                    x[kb * 16 + i] = __uint_as_float((__float_as_uint(acc[kb][i]) & ~127u) | key); }
            float t[16], pb[16];
            top16_of64(x, t);
#pragma unroll
            for (int i = 0; i < 16; ++i) pb[i] = __shfl_xor(t[i], 32);
            merge_top16(t, pb);
#pragma unroll
            for (int i = 0; i < 16; ++i) tv[p][i] = t[i];
        }
#pragma unroll
        for (int w = 0; w < 8; ++w) { unsigned pk = 0;
#pragma unroll
            for (int b = 0; b < 4; ++b) { const int i = w * 4 + b; pk |= (__float_as_uint(i < 16 ? tv[0][i] : tv[1][i - 16]) & 127u) << (8 * b); }
            kl[w * 64 + lane] = pk; }
        float x[64];
#pragma unroll
        for (int i = 0; i < 64; ++i) x[i] = NEG;
#pragma unroll
        for (int i = 0; i < 16; ++i)
#pragma unroll
            for (int j = 0; j < 16; ++j) if ((i + 1) * (j + 1) <= 16) {
                const float sa = __uint_as_float(__float_as_uint(tv[0][i]) & ~127u), sb = __uint_as_float(__float_as_uint(tv[1][j]) & ~127u);
                x[cand_off(i) + j] = __uint_as_float((__float_as_uint(sa + sb) & ~255u) | (unsigned)(i * 16 + j)); }
        float c[16];
        top16_of64(x, c);
        asm volatile("s_waitcnt lgkmcnt(0)" ::: "memory");
        int eidx[16]; float ev[16]; float den = 0.f;
        const float mx = __uint_as_float(__float_as_uint(c[0]) & ~255u);
#pragma unroll
        for (int i = 0; i < 16; ++i) {
            const unsigned bits = __float_as_uint(c[i]); const int pos = bits & 255u, ia = pos >> 4, ib = 16 + (pos & 15);
            const unsigned wa = kl[(ia >> 2) * 64 + lane], wb = kl[(ib >> 2) * 64 + lane];
            const int ka = (wa >> (8 * (ia & 3))) & 127, kb2 = (wb >> (8 * (ib & 3))) & 127;
            eidx[i] = ka * 128 + kb2;
            ev[i] = __expf(__uint_as_float(bits & ~255u) - mx); den += ev[i]; }
        const float inv = 1.0f / den;
        if (valid) {
            if (hh == 0) {
#pragma unroll
                for (int q = 0; q < 2; ++q) *(u32x4*)(RI + tl * 128 + h * 16 + q * 8) = (u32x4){(unsigned)eidx[q * 8] | ((unsigned)eidx[q * 8 + 1] << 16), (unsigned)eidx[q * 8 + 2] | ((unsigned)eidx[q * 8 + 3] << 16), (unsigned)eidx[q * 8 + 4] | ((unsigned)eidx[q * 8 + 5] << 16), (unsigned)eidx[q * 8 + 6] | ((unsigned)eidx[q * 8 + 7] << 16)};
            } else {
#pragma unroll
                for (int q = 0; q < 4; ++q) *(f32x4*)(RGl + tl * 128 + h * 16 + q * 4) = (f32x4){ev[q * 4] * inv, ev[q * 4 + 1] * inv, ev[q * 4 + 2] * inv, ev[q * 4 + 3] * inv};
            }
        }
    }
}

DI float gelu_fast(float v) {
    const float av = fabsf(v), t = __builtin_amdgcn_rcpf(1.0f + 0.2316419f * av);
    float q = t * 0.5307027145f - 0.7265760135f; q = q * t + 0.7107068705f; q = q * t - 0.142248368f; q = q * t + 0.127414796f; q = q * t;
    const float m = v * (q * __builtin_amdgcn_exp2f(v * v * -0.72134752044f));
    return v < 0.f ? m : v - m;
}
constexpr size_t WS_PP = WS_OSC;
constexpr size_t WS_PW = WS_OSC + 72 * MiB;
static_assert(WS_PW + (size_t)NTOK * 128 * 4 <= WS_END, "ws map");
typedef float f32x2 __attribute__((ext_vector_type(2)));
template <int CTRL> DI float dpp_add(float x) { return x + __uint_as_float(__builtin_amdgcn_update_dpp(0u, __float_as_uint(x), CTRL, 0xf, 0xf, true)); }
struct ESeg { u32x4 a; u32x2 b; };
DI void eseg_load(ESeg& r, __amdgpu_buffer_rsrc_t rs, int voff) { r.a = __builtin_amdgcn_raw_buffer_load_b128(rs, voff, 0, 0); r.b = __builtin_amdgcn_raw_buffer_load_b64(rs, voff + 16, 0, 0); }
DI v32f eseg_unpack(const ESeg& r) { return __builtin_amdgcn_cvt_scalef32_pk32_f32_fp6((v6i){(int)r.a.x, (int)r.a.y, (int)r.a.z, (int)r.a.w, (int)r.b.x, (int)r.b.y}, 1.0f); }
DI unsigned char* uniform_ptr(unsigned char* p) {
    const unsigned long long v = (unsigned long long)p; const unsigned lo = __builtin_amdgcn_readfirstlane((unsigned)v), hi = __builtin_amdgcn_readfirstlane((unsigned)(v >> 32));
    return as_global<unsigned char>(((unsigned long long)hi << 32) | lo); }
DI void xcd_split(const Frame& F, int& x, int& wx, int& nwx) {
    if ((F.G & 7) == 0) { x = blockIdx.x & 7; wx = (blockIdx.x >> 3) * NWAVES + F.wave; nwx = (F.G >> 3) * NWAVES; }
    else { const int gw = blockIdx.x * NWAVES + F.wave, NW = F.G * NWAVES; x = gw & 7; wx = gw >> 3; nwx = (NW - x + 7) >> 3; }
}
DI void phase_peer_route(int nrows, int wv) {
    const Frame R = mkframe(wv);
    const int per0 = (nrows + R.G - 1) / R.G, s0 = blockIdx.x * per0, s1 = min(s0 + per0, nrows);
    __syncthreads();
    if (s0 < s1) route_block(R, s0, s1);
}
DI void ids_load(u32x4 (&d)[2], const unsigned short* RI16, int t, int g) { const u32x4* p = (const u32x4*)(RI16 + (size_t)t * 128 + g * 16); d[0] = p[0]; d[1] = p[1]; }
#ifndef ID_MASK
#define ID_MASK 0xffffu
#endif
DI int id_of(const u32x4 (&d)[2], int r, unsigned mask = 0xffffu) { const unsigned w = d[r >> 3][(r >> 1) & 3]; return (r & 1) ? (int)((w >> 16) & mask) : (int)(w & mask); }
template <int MODE = 0> DI void phase_peer_u(int nrows, int wv, unsigned mask = 0xffffu) {
    const Frame F = mkframe(wv);
    int x, wx, nwx; xcd_split(F, x, wx, nwx);
    const int lane = F.lane, s = lane & 7, g = lane >> 3, s24 = s * 24;
    const __amdgpu_buffer_rsrc_t US = __builtin_amdgcn_make_buffer_rsrc((void*)uniform_ptr((unsigned char*)F.U + (size_t)x * ESLICE), 0, (int)ESLICE, 0x00020000);
    const unsigned short* RI16 = (const unsigned short*)(F.ws + WS_RIDX);
    float* P = (float*)(F.ws + WS_PP) + (size_t)x * NTOK * 128;
    const bf16* Hs = F.H + (8 * x + s) * 4;
    int t = wx; if (t >= nrows) return;
    ESeg rw[16]; u32x4 idn[2], idnn[2]; u32x2 hp[8];
    { u32x4 idc[2]; ids_load(idc, RI16, t, g);
#pragma unroll
      for (int r = 0; r < 16; ++r) eseg_load(rw[r], US, id_of(idc, r, mask) * ESEG + s24); }
#pragma unroll
    for (int c = 0; c < 8; ++c) hp[c] = *(const u32x2*)(Hs + (size_t)t * D + c * 256);
    ids_load(idn, RI16, t + nwx < nrows ? t + nwx : t, g);
    __builtin_amdgcn_s_waitcnt(0);
    for (;;) {
        const int tn = t + nwx, tnn = tn + nwx, tn_c = tn < nrows ? tn : t, tnn_c = tnn < nrows ? tnn : t;
        ids_load(idnn, RI16, tnn_c, g);
        u32x2 hq[8];
#pragma unroll
        for (int c = 0; c < 8; ++c) hq[c] = hp[c];
        __builtin_amdgcn_sched_barrier(0);
#pragma unroll
        for (int c = 0; c < 8; ++c) hp[c] = *(const u32x2*)(Hs + (size_t)tn_c * D + c * 256);
        __builtin_amdgcn_sched_barrier(0);
        float o0 = 0.f, o1 = 0.f;
#pragma unroll
        for (int r = 0; r < 16; ++r) {
            if (MODE == 2) { o0 += __uint_as_float(rw[r].a.x ^ rw[r].a.w ^ rw[r].b.y); eseg_load(rw[r], US, id_of(idn, r, mask) * ESEG + s24); if (r & 1) __builtin_amdgcn_sched_barrier(0); continue; }
            typedef __bf16 bfx2 __attribute__((ext_vector_type(2))); typedef __bf16 bfx32 __attribute__((ext_vector_type(32)));
            const bfx32 rr = __builtin_amdgcn_cvt_scalef32_pk32_bf16_fp6((v6i){(int)rw[r].a.x, (int)rw[r].a.y, (int)rw[r].a.z, (int)rw[r].a.w, (int)rw[r].b.x, (int)rw[r].b.y}, 1.0f);
            float dA = 0.f, dB = 0.f;
#define DOT2(k, acc) acc = __builtin_amdgcn_fdot2_f32_bf16(__builtin_shufflevector(rr, rr, 2 * (k), 2 * (k) + 1), __builtin_bit_cast(bfx2, ((k) & 1) ? hq[(k) >> 1].y : hq[(k) >> 1].x), acc, false)
            DOT2(0, dA); DOT2(1, dB); DOT2(2, dA); DOT2(3, dB); DOT2(4, dA); DOT2(5, dB); DOT2(6, dA); DOT2(7, dB); DOT2(8, dA); DOT2(9, dB); DOT2(10, dA); DOT2(11, dB); DOT2(12, dA); DOT2(13, dB); DOT2(14, dA); DOT2(15, dB);
#undef DOT2
            float d = dA + dB;
            d = dpp_add<0xB1>(d); d = dpp_add<0x4E>(d); d = dpp_add<0x141>(d);
            if ((r >> 1) == s) { if (r & 1) o1 = d; else o0 = d; }
            if (MODE != 1) eseg_load(rw[r], US, id_of(idn, r, mask) * ESEG + s24);
            else asm volatile("" : "+v"(rw[r].a.x), "+v"(rw[r].a.y), "+v"(rw[r].a.z), "+v"(rw[r].a.w), "+v"(rw[r].b.x), "+v"(rw[r].b.y));
            if (r & 1) __builtin_amdgcn_sched_barrier(0);
        }
        *(f32x2*)(P + (size_t)t * 128 + g * 16 + 2 * s) = (f32x2){o0, o1};
        if (tn >= nrows) break;
        t = tn; idn[0] = idnn[0]; idn[1] = idnn[1];
    }
}
DI void phase_peer_w(int nrows, int wv) {
    const Frame F = mkframe(wv);
    const unsigned short* RI = (const unsigned short*)(F.ws + WS_RIDX); const float* RG = (const float*)(F.ws + WS_RG); const float* P = (const float*)(F.ws + WS_PP); float* W = (float*)(F.ws + WS_PW);
    const float* SU = (const float*)(F.ws + WS_ESCALE); const float* SV = SU + NEXP;
    const int n4 = nrows * 32;
    for (int i = blockIdx.x * NTHREADS + F.tid; i < n4; i += F.G * NTHREADS) {
        const u32x2 ep = *(const u32x2*)(RI + (size_t)i * 4); const u32x4 e = {ep.x & 0xffffu, ep.x >> 16, ep.y & 0xffffu, ep.y >> 16}; const f32x4 gt = *(const f32x4*)(RG + (size_t)i * 4);
        f32x4 sum = *(const f32x4*)(P + (size_t)i * 4);
#pragma unroll
        for (int xx = 1; xx < 8; ++xx) sum += *(const f32x4*)(P + (size_t)xx * NTOK * 128 + (size_t)i * 4);
        f32x4 w;
        w.x = gt.x * SV[e.x] * gelu_fast(SU[e.x] * sum.x); w.y = gt.y * SV[e.y] * gelu_fast(SU[e.y] * sum.y); w.z = gt.z * SV[e.z] * gelu_fast(SU[e.z] * sum.z); w.w = gt.w * SV[e.w] * gelu_fast(SU[e.w] * sum.w);
        *(f32x4*)(W + (size_t)i * 4) = w;
    }
}
DI void phase_peer_v(int l, int nrows, int wv, bool dry = false, unsigned mask = 0xffffu) {
    const Frame F = mkframe(wv);
    int x, wx, nwx; xcd_split(F, x, wx, nwx);
    const int lane = F.lane, s = lane & 7, g = lane >> 3, s24 = s * 24;
    const __amdgpu_buffer_rsrc_t VS = __builtin_amdgcn_make_buffer_rsrc((void*)uniform_ptr((unsigned char*)F.V + (size_t)x * ESLICE), 0, (int)ESLICE, 0x00020000);
    const unsigned short* RI16 = (const unsigned short*)(F.ws + WS_RIDX); const float* Wg = (const float*)(F.ws + WS_PW) + g * 16;
    const bool b3 = (lane >> 3) & 1; const int col = (((lane >> 5) * 2 + ((lane >> 4) & 1)) * 2 + (b3 ? 1 : 0)) * 256 + (8 * x + s) * 4;
    int t = wx; if (t >= nrows) return;
    ESeg rw[16]; u32x4 idn[2], idnn[2]; f32x4 wq[4];
    { u32x4 idc[2]; ids_load(idc, RI16, t, g);
#pragma unroll
      for (int r = 0; r < 16; ++r) eseg_load(rw[r], VS, id_of(idc, r, mask) * ESEG + s24); }
#pragma unroll
    for (int q = 0; q < 4; ++q) wq[q] = *(const f32x4*)(Wg + (size_t)t * 128 + q * 4);
    ids_load(idn, RI16, t + nwx < nrows ? t + nwx : t, g);
    __builtin_amdgcn_s_waitcnt(0);
    for (;;) {
        const int tn = t + nwx, tnn = tn + nwx, tn_c = tn < nrows ? tn : t, tnn_c = tnn < nrows ? tnn : t;
        ids_load(idnn, RI16, tnn_c, g);
        float wt[16];
#pragma unroll
        for (int q = 0; q < 4; ++q) { wt[q * 4] = wq[q].x; wt[q * 4 + 1] = wq[q].y; wt[q * 4 + 2] = wq[q].z; wt[q * 4 + 3] = wq[q].w; }
#pragma unroll
        for (int q = 0; q < 16; ++q) asm volatile("" : "+v"(wt[q]));
        __builtin_amdgcn_sched_barrier(0);
#pragma unroll
        for (int q = 0; q < 4; ++q) wq[q] = *(const f32x4*)(Wg + (size_t)tn_c * 128 + q * 4);
        float* xp = F.X + (size_t)t * D + col;
        const f32x4 x1 = *(const f32x4*)xp, g2 = *(const f32x4*)(F.mod + ((size_t)l * 9 + modrow(t)) * MODW + 5 * D + col);
        __builtin_amdgcn_sched_barrier(0);
        f32x2 fa[16];
#pragma unroll
        for (int j = 0; j < 16; ++j) fa[j] = (f32x2){0.f, 0.f};
#pragma unroll
        for (int r = 0; r < 16; ++r) {
            const v32f rr = eseg_unpack(rw[r]); const f32x2 w2 = {wt[r], wt[r]};
#pragma unroll
            for (int j = 0; j < 16; ++j) fa[j] = __builtin_elementwise_fma((f32x2){rr[2 * j], rr[2 * j + 1]}, w2, fa[j]);
            eseg_load(rw[r], VS, id_of(idn, r, mask) * ESEG + s24);
            if (r & 1) __builtin_amdgcn_sched_barrier(0);
        }
        float f16[16], f8[8];
#pragma unroll
        for (int j = 0; j < 16; ++j) { const float lo = (j & 1) ? fa[j >> 1].y : fa[j >> 1].x, hi = (j & 1) ? fa[8 + (j >> 1)].y : fa[8 + (j >> 1)].x;
            const auto a = __builtin_amdgcn_permlane32_swap(__float_as_uint(lo), __float_as_uint(hi), false, false); f16[j] = __uint_as_float(a[0]) + __uint_as_float(a[1]); }
#pragma unroll
        for (int j = 0; j < 8; ++j) { const auto a = __builtin_amdgcn_permlane16_swap(__float_as_uint(f16[j]), __float_as_uint(f16[j + 8]), false, false); f8[j] = __uint_as_float(a[0]) + __uint_as_float(a[1]); }
#pragma unroll
        for (int j = 0; j < 8; ++j) f8[j] = dpp_add<0x128>(f8[j]);
        f32x4 z;
        z.x = ALPHA * x1.x + g2.x * (b3 ? f8[4] : f8[0]); z.y = ALPHA * x1.y + g2.y * (b3 ? f8[5] : f8[1]); z.z = ALPHA * x1.z + g2.z * (b3 ? f8[6] : f8[2]); z.w = ALPHA * x1.w + g2.w * (b3 ? f8[7] : f8[3]);
        if (!dry) *(f32x4*)xp = z;
        if (tn >= nrows) break;
        t = tn; idn[0] = idnn[0]; idn[1] = idnn[1];
    }
}
DI void load16_f32(const float* src, int lane, float (&v)[32]) {
#pragma unroll
    for (int c = 0; c < 8; ++c) { const f32x4 a = *(const f32x4*)(src + c * 256 + lane * 4); v[c * 4 + 0] = a.x; v[c * 4 + 1] = a.y; v[c * 4 + 2] = a.z; v[c * 4 + 3] = a.w; }
}
DI void store16_f32(float* dst, int lane, const float (&v)[32]) {
#pragma unroll
    for (int c = 0; c < 8; ++c) *(f32x4*)(dst + c * 256 + lane * 4) = (f32x4){v[c * 4 + 0], v[c * 4 + 1], v[c * 4 + 2], v[c * 4 + 3]};
}
DI void phase_peer_ln2(int l, int nrows, bool last, int wv) {
    const Frame T = mkframe(wv);
    const int lane = T.lane;
    const float* lg2 = inp(I_LN2G) + (size_t)l * D; const float* lb2 = inp(I_LN2B) + (size_t)l * D;
#define CBAR() asm volatile("" ::: "memory")
    for (int r = blockIdx.x * NWAVES + T.wave; r < nrows; r += T.G * NWAVES) {
        float v[32];
        load16_f32(T.X + (size_t)r * D, lane, v);
        row_normalize(v);
        { float t[32]; load16_f32(lg2, lane, t);
#pragma unroll
          for (int i = 0; i < 32; ++i) v[i] *= t[i]; }
        CBAR();
        { float t[32]; load16_f32(lb2, lane, t);
#pragma unroll
          for (int i = 0; i < 32; ++i) v[i] += t[i]; }
        CBAR();
        store16_f32(last ? T.out + (size_t)r * D : T.X + (size_t)r * D, lane, v);
        if (!last) {
            const float* mdn = T.mod + ((size_t)(l + 1) * 9 + modrow(r)) * MODW;
            row_normalize(v);
            CBAR();
            { float t[32]; load16_f32(mdn + 1 * D, lane, t);
#pragma unroll
              for (int i = 0; i < 32; ++i) v[i] *= (1.0f + t[i]); }
            CBAR();
            { float t[32]; load16_f32(mdn + 0 * D, lane, t);
#pragma unroll
              for (int i = 0; i < 32; ++i) v[i] += t[i]; }
#pragma unroll
            for (int c = 0; c < 8; ++c) { u32x2 wv2; wv2.x = pk2(v[c * 4 + 0], v[c * 4 + 1]); wv2.y = pk2(v[c * 4 + 2], v[c * 4 + 3]);
                *(u32x2*)(T.H + (size_t)r * D + c * 256 + lane * 4) = wv2;
                *(unsigned*)(T.ws + WS_H8 + (size_t)r * D + c * 256 + lane * 4) = pk4_fp8(v[c * 4 + 0] * SA8_H, v[c * 4 + 1] * SA8_H, v[c * 4 + 2] * SA8_H, v[c * 4 + 3] * SA8_H); }
        }
        CBAR();
    }
#undef CBAR
}

#ifndef MK_N_LAUNCHES
#define MK_N_LAUNCHES 1
#endif
constexpr int PH_PER_LAYER = 15, N_PHASES = DEPTH * PH_PER_LAYER;
struct Args { const float* in[N_IN]; float* out; unsigned char* ws; int ph_lo, ph_hi; };
static_assert(sizeof(Args) == N_IN * 8 + 8 + 8 + 8, "Args has no padding");

struct OrderW8 : pg8::StaticOrder {
    int base, c_lo, nctx;
    __device__ void init3(int M_, int N_, int G_, int c_, int base_, int c_lo_, int nctx_) { init(M_, N_, G_, c_); base = base_; c_lo = c_lo_; nctx = nctx_; }
    __device__ bool unit_of(long L, pg8::Unit& u) const {
        if (L < nwg) { pg8::StaticOrder t = *this; t.c = (int)(L % G); return t.pg8::StaticOrder::next((int)(L / G), u); }
        const int r = (int)(L - nwg); if (r >= nctx) return false;
        u.pm = NLAT / 256 + (r & 7); u.pn = C_ZF / 256 + (r >> 3); return true;
    }
    __device__ bool next(int i, pg8::Unit& u) const {
        if (i < base) return unit_of((long)i * G + c, u);
        if (c < c_lo) return false;
        return unit_of((long)base * G + (long)(i - base) * (G - c_lo) + (c - c_lo), u);
    }
};
__global__ void __launch_bounds__(NTHREADS, 2) mk_fwd(Args args) {
    LAS unsigned char* ldsl = (LAS unsigned char*)lds_raw;
    for (int u = threadIdx.x; u < (LDS_BYTES - LDSCTL_OFF) / 4; u += NTHREADS) ((LAS unsigned*)(ldsl + LDSCTL_OFF))[u] = 0u;
    __syncthreads();
    if (threadIdx.x < N_IN + 2) { const int i = threadIdx.x; const unsigned long long v = i < N_IN ? (unsigned long long)args.in[i] : (i == N_IN ? (unsigned long long)args.out : (unsigned long long)args.ws);
        ((volatile LAS unsigned long long*)(ldsl + PTR_OFF))[i] = v; }
    __syncthreads();
    unsigned char* ws = as_global<unsigned char>(ld_ptr(N_IN + 1));
    const int wv = __builtin_amdgcn_readfirstlane(threadIdx.x >> 6);
    const int lo = args.ph_lo, hi = args.ph_hi;
    const bool multi = (hi - lo) > 1;
    XcdBarrier bar; bar.bar = (unsigned*)(ws + WS_CTL) + CW_BAR; bar.x = 0; bar.st = nullptr; bar.wv = wv;
    if (multi) bar = xcd_barrier_post((unsigned*)(ws + WS_CTL) + CW_BAR, (volatile LAS unsigned*)(ldsl + MISC_OFF) + 8, wv);
#ifndef PH_MASK
#define PH_MASK 0x7fff
#endif
#define IN(k) (((PH_MASK >> ((k) % PH_PER_LAYER)) & 1) && lo <= (k) && (k) < hi)
#define WSO() ({ unsigned long long _w = (unsigned long long)ws; asm volatile("" : "+s"(_w)); as_global<unsigned char>(_w); })
#define SEAM(k) do { if (IN(k) && IN((k) + 1)) xcd_barrier(bar); } while (0)

    for (int l = 0; l < DEPTH; ++l) {
        const int pb = l * PH_PER_LAYER;
        const bool last = (l == DEPTH - 1);
        const int nrows = last ? NLAT : NTOK;
        if (IN(pb + 0)) { phase_convert(l, wv, gridDim.x != 256); if (l == 0) phase_mod(wv);
#ifdef DUP_P0
            if (l == 0) { __syncthreads(); phase_convert(l, wv, gridDim.x != 256); phase_mod(wv); }
#endif
        }
        SEAM(pb + 0);
        if (IN(pb + 1) && l == 0) { phase_modulate1(l, wv);
#ifdef DUP_P1
            if (l == 0) { phase_modulate1(l, wv); phase_modulate1(l, wv); phase_modulate1(l, wv); phase_modulate1(l, wv); }
#endif
        }
        if (l == 0) SEAM(pb + 1);
        if (IN(pb + 2)) { unsigned char* wsl = WSO();
            {
                pg8::Gemm g{(bf16*)(wsl + WS_H), (bf16*)(wsl + WS_WIN), NTOK, 2 * DC, D, D}; pg8::StaticOrder S; S.init(NTOK, 2 * DC, (int)gridDim.x, (int)blockIdx.x);
                EpiStore E{(bf16*)(wsl + WS_PROJ) + C_ZF, INW, 1.0f, 1 << 30, 0};
                pg8::gemm_phase<EpiStore, pg8::StaticOrder, true, true>(ldsl, g, S, E, wv); }
            {
                const int mrows = last ? NLAT : NTOK;
                pg8::Gemm g{(bf16*)(wsl + WS_H8), (bf16*)(wsl + WS_WIN8), mrows, 10 * DC, D / 2, D / 2}; OrderW8 S;
                if (gridDim.x == 256) S.init3(mrows, 10 * DC, 256, (int)blockIdx.x, 9, 64, last ? 32 : 0);
                else S.init3(mrows, 10 * DC, (int)gridDim.x, (int)blockIdx.x, 1 << 20, 0, last ? 32 : 0);
                EpiStore E{(bf16*)(wsl + WS_PROJ), INW, 1.0f / (SW8 * SA8_H), C_ZF / 256, C_VI - C_ZF};
                pg8::gemm_phase<EpiStore, OrderW8, true, true, true>(ldsl, g, S, E, wv); }
        }
        SEAM(pb + 2);
        if (IN(pb + 3)) {
#ifdef DUP_PREP
            if (l == 0) phase_prep(l, wv, gridDim.x != 1);
#endif
            phase_prep(l, wv); }
        SEAM(pb + 3);
        if (IN(pb + 4)) { phase_scan(l, wv, gridDim.x == 256);
#ifdef DUP_P3
            if (l == 0) phase_scan(l, wv, gridDim.x == 256);
#endif
        }
        SEAM(pb + 4);
        if (IN(pb + 5)) phase_readout(l, nrows, wv);
        SEAM(pb + 5);
        if (IN(pb + 6)) { unsigned char* wsl = WSO(); pg8::Gemm g{(bf16*)(wsl + WS_H), (bf16*)(wsl + WS_WPA), nrows, D, D / 2, D / 2}; pg8::StaticOrder S; S.init(nrows, D, (int)gridDim.x, (int)blockIdx.x);
            EpiMerge E{(bf16*)(wsl + WS_PROJ) + C_GA, (bf16*)(wsl + WS_PROJ) + C_GB, INW, (bf16*)(wsl + WS_Y), D};
            pg8::gemm_phase<EpiMerge, pg8::StaticOrder, true, true, true>(ldsl, g, S, E, wv); }
        SEAM(pb + 6);
        if (IN(pb + 7)) { unsigned char* wsl = WSO(); pg8::Gemm g{(bf16*)(wsl + WS_Y), (bf16*)(wsl + WS_WO), nrows, D, D / 2, D / 2}; pg8::StaticOrder S; S.init(nrows, D, (int)gridDim.x, (int)blockIdx.x); EpiStore E{(bf16*)(wsl + WS_H), D, 1.0f / (SW8 * SA8_M), 1 << 30, 0};
            pg8::gemm_phase<EpiStore, pg8::StaticOrder, true, true, true>(ldsl, g, S, E, wv); }
        SEAM(pb + 7);
        if (IN(pb + 8)) phase_ln1(l, nrows, wv);
        SEAM(pb + 8);
        if (IN(pb + 9)) { unsigned char* wsl = WSO(); pg8::Gemm g{(bf16*)(wsl + WS_H), (bf16*)(wsl + WS_WQ), nrows, D, D, D}; pg8::StaticOrder S; S.init(nrows, D, (int)gridDim.x, (int)blockIdx.x); EpiStore E{(bf16*)(wsl + WS_Y), D, 1.0f, 1 << 30, 0};
            pg8::gemm_phase<EpiStore, pg8::StaticOrder, true, true>(ldsl, g, S, E, wv); }
        SEAM(pb + 9);

        if (IN(pb + 10)) { phase_peer_route(nrows, wv);
#ifdef DUP_RT
            if (last) phase_peer_route(nrows, wv);
#endif
        }
        SEAM(pb + 10);
        if (IN(pb + 11)) {
#ifdef DUP_PU
            if (last) phase_peer_u(nrows, wv, DUP_PU);
#endif
            phase_peer_u(nrows, wv); }
        SEAM(pb + 11);
        if (IN(pb + 12)) phase_peer_w(nrows, wv);
        SEAM(pb + 12);
        if (IN(pb + 13)) {
#ifdef DUP_PV
            if (last) phase_peer_v(l, nrows, wv, gridDim.x != 1, DUP_PV);
#endif
            phase_peer_v(l, nrows, wv); }
        SEAM(pb + 13);
        if (IN(pb + 14)) { phase_peer_ln2(l, nrows, last, wv);
#ifdef DUP_LN2
            if (last) { phase_peer_ln2(l, nrows, last, wv); phase_peer_ln2(l, nrows, last, wv); }
#endif
        }
        SEAM(pb + 14);
    }
#undef IN
#undef SEAM
}

extern "C" void kernel_launch(void* const* d_in, const int* in_sizes, int n_in, void* d_out, int out_size, void* d_ws, size_t ws_size, hipStream_t stream) {
    static int grid = 0;
    if (grid == 0) {
        if (n_in != N_IN || in_sizes[I_X] != NLAT * D || out_size != NLAT * D || ws_size < WS_H8 + 36 * MiB) { fprintf(stderr, "kernel_launch: unexpected shapes (n_in %d, ws %zu); nothing launched\n", n_in, ws_size); grid = -1; return; }
        int dev = 0, cus = 0, per_cu = 0;
        if (hipGetDevice(&dev) != hipSuccess || hipDeviceGetAttribute(&cus, hipDeviceAttributeMultiprocessorCount, dev) != hipSuccess) { grid = -1; return; }
        if (hipFuncSetAttribute((const void*)mk_fwd, hipFuncAttributeMaxDynamicSharedMemorySize, LDS_BYTES) != hipSuccess) { fprintf(stderr, "kernel_launch: hipFuncSetAttribute failed\n"); grid = -1; return; }
        if (hipOccupancyMaxActiveBlocksPerMultiprocessor(&per_cu, (const void*)mk_fwd, NTHREADS, LDS_BYTES) != hipSuccess || per_cu < 1) { fprintf(stderr, "kernel_launch: occupancy query says %d\n", per_cu); per_cu = 1; }
        (void)hipGetLastError();
        grid = cus;
        if ((NTOK + grid - 1) / grid > 96) { fprintf(stderr, "kernel_launch: %d CUs: the PEER phase holds at most 96 tokens per workgroup in LDS; nothing launched\n", cus); grid = -1; return; }
    }
    if (grid < 0) return;
    if (hipMemsetAsync((char*)d_ws + WS_CTL, 0, CTL_ZERO_BYTES, stream) != hipSuccess) return;
    Args a{};
    for (int i = 0; i < N_IN; ++i) a.in[i] = (const float*)d_in[i];
    a.out = (float*)d_out; a.ws = (unsigned char*)d_ws;
#if MK_N_LAUNCHES == 1
    a.ph_lo = 0; a.ph_hi = N_PHASES;
    hipLaunchKernelGGL(mk_fwd, dim3(grid), dim3(NTHREADS), LDS_BYTES, stream, a);
#else
    for (int p = 0; p < N_PHASES; ++p) { a.ph_lo = p; a.ph_hi = p + 1; hipLaunchKernelGGL(mk_fwd, dim3(grid), dim3(NTHREADS), LDS_BYTES, stream, a); }
#endif
}
```

```cpp
#include <hip/hip_runtime.h>
#include <stdint.h>
#include <stdio.h>

#define MK_N_LAUNCHES 1
namespace pg8 {
#define PG8_LAS __attribute__((address_space(3)))
typedef unsigned short bf16_t;
typedef short bf16x8 __attribute__((ext_vector_type(8)));
typedef float f32x4 __attribute__((ext_vector_type(4)));
typedef unsigned u32x4 __attribute__((ext_vector_type(4)));
constexpr int BM = 256, BK = 64, HALF = 128, HTB = HALF * BK * 2  , STAGE_BYTES = 8 * HTB, NXCD = 8, WGM = 8;

__host__ __device__ __forceinline__ int lds_byte(int r, int c) { const int st = (r >> 4) * 2 + (c >> 5), rr = r & 15, cc = c & 31, ob = rr * 64 + cc * 2; return st * 1024 + (ob ^ (((ob >> 9) & 1) << 5)); }
__host__ __device__ __forceinline__ void stage_rc(int b, int& R, int& C) { const int st = b / 1024, sb = b % 1024, swz = sb ^ (((sb >> 9) & 1) << 5); R = (st >> 1) * 16 + swz / 64; C = (st & 1) * 32 + (swz % 64) / 2; }
__host__ __device__ __forceinline__ int perm32(int rho) { const int n = rho >> 4, i = rho & 15; return 8 * (i >> 2) + 4 * n + (i & 3); }

struct Unit { int pm, pn; };
struct Gemm { const bf16_t* A; const bf16_t* Bt; int M, N, K, lda; };

struct StaticOrder {
    int nM, nN, nwg, G, c;
    __host__ __device__ void init(int M, int N, int G_, int c_) { nM = M / BM; nN = N / BM; nwg = nM * nN; G = G_; c = c_; }
    __host__ __device__ bool next(int i, Unit& u) const {
        const long L = (long)i * G + c; if (L >= nwg) return false;
        int wgid = (int)L; { const int q = nwg / NXCD, r = nwg % NXCD, xcd = wgid % NXCD, off = wgid / NXCD; wgid = (xcd < r ? xcd * (q + 1) : r * (q + 1) + (xcd - r) * q) + off; }
        const int nig = WGM * nN, gid = wgid / nig, fm = gid * WGM, gsz = (nM - fm) < WGM ? (nM - fm) : WGM;
        u.pm = fm + ((wgid % nig) % gsz); u.pn = (wgid % nig) / gsz; return true;
    }
    __device__ __forceinline__ void a_ready(const Unit&) const {}
    __device__ __forceinline__ void done(const Unit&) const {}
};

__device__ __forceinline__ unsigned cvt_pk_bf16(float lo, float hi) { unsigned r; asm volatile("v_cvt_pk_bf16_f32 %0, %1, %2" : "=v"(r) : "v"(lo), "v"(hi)); return r; }
typedef float f32x2 __attribute__((ext_vector_type(2)));
typedef int i32x4 __attribute__((ext_vector_type(4)));
typedef int i32x8 __attribute__((ext_vector_type(8)));
__device__ __forceinline__ i32x8 cat8(bf16x8 lo, bf16x8 hi) { const i32x4 a = __builtin_bit_cast(i32x4, lo), b = __builtin_bit_cast(i32x4, hi); return __builtin_shufflevector(a, b, 0, 1, 2, 3, 4, 5, 6, 7); }
template <class Epi, class Sched, bool ALIGN_EPI = false, bool SP2 = false, bool F8 = false>
__device__ __forceinline__ void gemm_phase(PG8_LAS unsigned char* lds, const Gemm g, const Sched& S, const Epi& E, int wv) {
    int tid_ = wv * 64 + (int)__builtin_amdgcn_mbcnt_hi(~0u, __builtin_amdgcn_mbcnt_lo(~0u, 0u)); asm volatile("" : "+v"(tid_));
    const int tid = tid_, wid = __builtin_amdgcn_readfirstlane(tid >> 6), lane = tid & 63, wr = wid >> 2, wc = wid & 3, fr = lane & 15, fq = lane >> 4;
    const int K = g.K, nt = K / BK;
    unsigned voffA[2], voffB[2];
#pragma unroll
    for (int i = 0; i < 2; ++i) { int R, C; stage_rc(tid * 16 + i * 8192, R, C); const int Rb = Epi::PERM ? ((R & ~31) + perm32(R & 31)) : R;
        voffA[i] = (unsigned)(R * g.lda + C) * 2u; voffB[i] = (unsigned)(Rb * K + C) * 2u; }
    const size_t kstep = (size_t)(BK * 2);
    const size_t hstepA = (size_t)HALF * g.lda * 2, hstepB = (size_t)HALF * K * 2;
    const size_t tstepA = 2 * hstepA, tstepB = 2 * hstepB;
    const unsigned ldsw = (unsigned)wid * 1024u;
    const int aoff = lds_byte(wr * 64 + fr, fq * 8), boff = SP2 ? lds_byte((wc & 1) * 64 + fr, fq * 8) : lds_byte(wc * 32 + fr, fq * 8); const int hw = wc >> 1;
#define PG8_SA(b, h) (((b) * 2 + (h)) * HTB)
#define PG8_SB(b, h) ((4 + (b) * 2 + (h)) * HTB)
#define PG8_STAGE(bufoff, gbase, voff) do { _Pragma("unroll") for (int _i = 0; _i < 2; ++_i) \
        __builtin_amdgcn_global_load_lds((const unsigned*)((const char*)(gbase) + (voff)[_i]), (PG8_LAS unsigned*)(lds + (bufoff) + ldsw + _i * 8192), 16, 0, 0); } while (0)
#define PG8_LDA(dst, b, h) do { _Pragma("unroll") for (int m = 0; m < 4; ++m) _Pragma("unroll") for (int k = 0; k < 2; ++k) dst[m][k] = *(const PG8_LAS bf16x8*)(lds + PG8_SA(b, h) + aoff + m * 2048 + k * 1024); } while (0)
#define PG8_LDB(dst, b, h) do { _Pragma("unroll") for (int n = 0; n < 2; ++n) _Pragma("unroll") for (int k = 0; k < 2; ++k) dst[n][k] = *(const PG8_LAS bf16x8*)(lds + (SP2 ? PG8_SB(b, hw) + (h) * 4096 : PG8_SB(b, h)) + boff + n * 2048 + k * 1024); } while (0)
#define PG8_MMA(ai, bj, At, Bt) do { __builtin_amdgcn_s_setprio(1); _Pragma("unroll") for (int m = 0; m < 4; ++m) _Pragma("unroll") for (int n = 0; n < 2; ++n) { \
        if constexpr (F8) { const i32x8 _b = cat8(Bt[n][0], Bt[n][1]), _a = cat8(At[m][0], At[m][1]); asm volatile("v_mfma_f32_16x16x128_f8f6f4 %0, %1, %2, %0" : "+v"(acc[ai][bj][m][n]) : "v"(_b), "v"(_a)); } \
        else { _Pragma("unroll") for (int k = 0; k < 2; ++k) acc[ai][bj][m][n] = __builtin_amdgcn_mfma_f32_16x16x32_bf16(Bt[n][k], At[m][k], acc[ai][bj][m][n], 0, 0, 0); } } \
        __builtin_amdgcn_s_setprio(0); } while (0)
#define PG8_WAIT_V(n) asm volatile("s_waitcnt vmcnt(" #n ")" ::: "memory")
#define PG8_WAIT_L(n) asm volatile("s_waitcnt lgkmcnt(" #n ")" ::: "memory")
#define PG8_BAR __builtin_amdgcn_s_barrier()
#define PG8_SCHED __builtin_amdgcn_sched_barrier(0)
    Unit cur, nxt; int ui = 0;
    if (!S.next(0, cur)) return;
    f32x4 acc[2][2][4][2];
#pragma unroll
    for (int a = 0; a < 2; ++a)
#pragma unroll
        for (int b = 0; b < 2; ++b)
#pragma unroll
            for (int m = 0; m < 4; ++m)
#pragma unroll
                for (int n = 0; n < 2; ++n) acc[a][b][m][n] = (f32x4){0.f, 0.f, 0.f, 0.f};
    bf16x8 At[4][2], B0[2][2], B1[2][2];
    const char* cA = (const char*)g.A + (size_t)cur.pm * tstepA; const char* cB = (const char*)g.Bt + (size_t)cur.pn * tstepB;
    S.a_ready(cur);
    if constexpr (SP2) {
        PG8_STAGE(PG8_SB(0, 0), cB, voffB); PG8_STAGE(PG8_SB(0, 1), cB + hstepB, voffB); PG8_STAGE(PG8_SA(0, 0), cA, voffA); PG8_STAGE(PG8_SA(0, 1), cA + hstepA, voffA);
        if (wr == 1) PG8_BAR;
        PG8_WAIT_V(2); PG8_BAR;
        PG8_STAGE(PG8_SB(1, 0), cB + kstep, voffB); PG8_STAGE(PG8_SA(1, 0), cA + kstep, voffA); PG8_STAGE(PG8_SB(1, 1), cB + hstepB + kstep, voffB);
        PG8_WAIT_V(6); PG8_BAR;
    } else {
        PG8_STAGE(PG8_SB(0, 0), cB, voffB); PG8_STAGE(PG8_SA(0, 0), cA, voffA); PG8_STAGE(PG8_SB(0, 1), cB + hstepB, voffB); PG8_STAGE(PG8_SA(0, 1), cA + hstepA, voffA);
        if (wr == 1) PG8_BAR;
        PG8_WAIT_V(4); PG8_BAR;
        PG8_STAGE(PG8_SB(1, 0), cB + kstep, voffB); PG8_STAGE(PG8_SA(1, 0), cA + kstep, voffA); PG8_STAGE(PG8_SB(1, 1), cB + hstepB + kstep, voffB);
        PG8_WAIT_V(6); PG8_BAR;
    }
    for (;;) {
        const bool has_next = S.next(ui + 1, nxt);
        const char* nA = has_next ? (const char*)g.A + (size_t)nxt.pm * tstepA : cA; const char* nB = has_next ? (const char*)g.Bt + (size_t)nxt.pn * tstepB : cB;
        for (int t = 0; t < nt; t += 2) {
            if constexpr (Epi::MIDK) { if (t == nt / 2) { if constexpr (F8) asm volatile("s_nop 15\n\ts_nop 15" ::: "memory"); E.mid(acc, cur, wr, wc, fr, fq); } }
            const bool last = (t == nt - 2);
            const char* a1 = cA + (size_t)(t + 1) * kstep;
            const char* a2 = last ? nA : cA + (size_t)(t + 2) * kstep; const char* b2 = last ? nB : cB + (size_t)(t + 2) * kstep;
            const char* a3 = a2 + kstep; const char* b3 = b2 + kstep;
            if (last && has_next) S.a_ready(nxt);
            if constexpr (SP2) {
            PG8_LDB(B0, 0, 0); PG8_LDB(B1, 0, 1); PG8_SCHED; PG8_LDA(At, 0, 0); PG8_STAGE(PG8_SA(1, 1), a1 + hstepA, voffA);
            PG8_WAIT_V(8); PG8_WAIT_L(0); PG8_BAR; PG8_MMA(0, 0, At, B0); PG8_MMA(0, 1, At, B1); PG8_BAR; PG8_SCHED;
            PG8_LDA(At, 0, 1); PG8_STAGE(PG8_SB(0, 0), b2, voffB); PG8_STAGE(PG8_SB(0, 1), b2 + hstepB, voffB); PG8_STAGE(PG8_SA(0, 0), a2, voffA);
            PG8_WAIT_V(8); PG8_WAIT_L(0); PG8_BAR; PG8_MMA(1, 0, At, B0); PG8_MMA(1, 1, At, B1); PG8_BAR; PG8_SCHED;
            PG8_LDB(B0, 1, 0); PG8_LDB(B1, 1, 1); PG8_SCHED; PG8_LDA(At, 1, 0); PG8_STAGE(PG8_SA(0, 1), a2 + hstepA, voffA);
            PG8_WAIT_V(8); PG8_WAIT_L(0); PG8_BAR; PG8_MMA(0, 0, At, B0); PG8_MMA(0, 1, At, B1); PG8_BAR; PG8_SCHED;
            PG8_LDA(At, 1, 1); PG8_STAGE(PG8_SB(1, 0), b3, voffB); PG8_STAGE(PG8_SB(1, 1), b3 + hstepB, voffB); PG8_STAGE(PG8_SA(1, 0), a3, voffA);
            PG8_WAIT_V(8); PG8_WAIT_L(0); PG8_BAR; PG8_MMA(1, 0, At, B0); PG8_MMA(1, 1, At, B1); PG8_BAR; PG8_SCHED;
            } else {
            PG8_LDB(B0, 0, 0); PG8_SCHED; PG8_LDA(At, 0, 0); PG8_STAGE(PG8_SA(1, 1), a1 + hstepA, voffA);
            PG8_WAIT_L(8); PG8_BAR; PG8_WAIT_L(0); PG8_MMA(0, 0, At, B0); PG8_BAR; PG8_SCHED;
            PG8_LDB(B1, 0, 1); PG8_STAGE(PG8_SB(0, 0), b2, voffB);
            PG8_BAR; PG8_WAIT_L(0); PG8_MMA(0, 1, At, B1); PG8_BAR;
            PG8_LDA(At, 0, 1); PG8_STAGE(PG8_SA(0, 0), a2, voffA);
            PG8_BAR; PG8_WAIT_L(0); PG8_MMA(1, 0, At, B0); PG8_BAR; PG8_SCHED;
            PG8_STAGE(PG8_SB(0, 1), b2 + hstepB, voffB);
            PG8_WAIT_V(6); PG8_BAR; PG8_MMA(1, 1, At, B1); PG8_BAR;
            PG8_LDB(B0, 1, 0); PG8_SCHED; PG8_LDA(At, 1, 0); PG8_STAGE(PG8_SA(0, 1), a2 + hstepA, voffA);
            PG8_WAIT_L(8); PG8_BAR; PG8_WAIT_L(0); PG8_MMA(0, 0, At, B0); PG8_BAR; PG8_SCHED;
            PG8_LDB(B1, 1, 1); PG8_STAGE(PG8_SB(1, 0), b3, voffB);
            PG8_BAR; PG8_WAIT_L(0); PG8_MMA(0, 1, At, B1); PG8_BAR;
            PG8_LDA(At, 1, 1); PG8_STAGE(PG8_SA(1, 0), a3, voffA);
            PG8_BAR; PG8_WAIT_L(0); PG8_MMA(1, 0, At, B0); PG8_BAR; PG8_SCHED;
            PG8_STAGE(PG8_SB(1, 1), b3 + hstepB, voffB);
            PG8_WAIT_V(6); PG8_BAR; PG8_MMA(1, 1, At, B1); PG8_BAR;
            }
        }
        if constexpr (F8) asm volatile("s_nop 15\n\ts_nop 15" ::: "memory");
        if constexpr (ALIGN_EPI) { if (wr == 0) PG8_BAR; }
        if constexpr (!Epi::AFTER_DRAIN) { E(acc, cur, wr, wc, fr, fq); S.done(cur); }
        if (!has_next) break;
#pragma unroll
        for (int a = 0; a < 2; ++a)
#pragma unroll
            for (int b = 0; b < 2; ++b)
#pragma unroll
                for (int m = 0; m < 4; ++m)
#pragma unroll
                    for (int n = 0; n < 2; ++n) acc[a][b][m][n] = (f32x4){0.f, 0.f, 0.f, 0.f};
        cur = nxt; cA = nA; cB = nB; ++ui;
        if constexpr (ALIGN_EPI) { if (wr == 1) PG8_BAR; }
    }
    PG8_WAIT_V(0);
    if constexpr (!ALIGN_EPI) { if (wr == 0) PG8_BAR; }
    PG8_BAR;
    if constexpr (Epi::AFTER_DRAIN) { E.fused(acc, cur, wr, wc, fr, fq, lds, wid, lane); S.done(cur); }
#undef PG8_SA
#undef PG8_SB
#undef PG8_STAGE
#undef PG8_LDA
#undef PG8_LDB
#undef PG8_MMA
#undef PG8_WAIT_V
#undef PG8_WAIT_L
#undef PG8_BAR
#undef PG8_SCHED
}
}


#define LAS __attribute__((address_space(3)))
#define XB_TMO      128
#define XB_XCNT(j)  (256  + 64 * (j))
#define XB_XSUB(j)  (1280 + 64 * (j))
#define XB_XGEN(j)  (2304 + 64 * (j))
#define XB_TOP      3328
#define XB_TOPGEN   3392
#define XCD_BAR_WORDS 3456
#define XB_SPIN_CAP (1u << 20)

__device__ __forceinline__ unsigned xb_ld(unsigned* p)              { return __hip_atomic_load(p, __ATOMIC_RELAXED, __HIP_MEMORY_SCOPE_AGENT); }
__device__ __forceinline__ unsigned xb_add(unsigned* p, unsigned v) { return __hip_atomic_fetch_add(p, v, __ATOMIC_RELAXED, __HIP_MEMORY_SCOPE_AGENT); }
__device__ __forceinline__ unsigned xb_xcc_id() { return (unsigned)__builtin_amdgcn_s_getreg((3 << 11) | 20) & 0xFu; }
#define XB_SPIN(cond, bar) do { unsigned _sp = 0; while (cond) { __builtin_amdgcn_s_sleep(1); \
    if ((++_sp & 255u) == 0u) { if (xb_ld(&(bar)[XB_TMO])) break; if (_sp > XB_SPIN_CAP) { atomicAdd(&(bar)[XB_TMO], 1u); break; } } } } while (0)

struct XcdBarrier {
    unsigned* bar; unsigned x; int wv;
    volatile LAS unsigned* st;
};

__device__ __forceinline__ XcdBarrier xcd_barrier_post(unsigned* bar, volatile LAS unsigned* st, int wv) {
    XcdBarrier b; b.bar = bar; b.x = xb_xcc_id(); b.st = st; b.wv = wv;
    if (threadIdx.x == 0) (void)xb_add(&bar[XB_XCNT(b.x)], 1u);
    return b;
}
__device__ __forceinline__ void xcd_barrier_complete(unsigned* bar, unsigned x, unsigned& nloc, unsigned& nx) {
    const unsigned G = gridDim.x * gridDim.y * gridDim.z;
    unsigned sum, cnt, mine, sp = 0u;
    for (;;) {
        sum = 0u; cnt = 0u; mine = 0u;
#pragma unroll
        for (unsigned j = 0; j < 16; ++j) { const unsigned c = xb_ld(&bar[XB_XCNT(j)]); sum += c; cnt += (c > 0u) ? 1u : 0u; mine = (j == x) ? c : mine; }
        if (sum == G) break;
        __builtin_amdgcn_s_sleep(1);
        if ((++sp & 255u) == 0u) { if (xb_ld(&bar[XB_TMO])) break; if (sp > XB_SPIN_CAP) { atomicAdd(&bar[XB_TMO], 1u); break; } }
    }
    nloc = mine > 0u ? mine : 1u; nx = cnt > 0u ? cnt : 1u;
}

__device__ __forceinline__ void xcd_barrier(const XcdBarrier& b) {
    asm volatile("s_waitcnt vmcnt(0)" ::: "memory");
    __syncthreads();
    unsigned xb_z = 0u; asm volatile("" : "+v"(xb_z));
    if (b.wv == 0 && __builtin_amdgcn_mbcnt_hi(~0u, __builtin_amdgcn_mbcnt_lo(~0u, xb_z)) == 0u) {
        unsigned* bar = b.bar;
        __builtin_amdgcn_s_waitcnt(0);
        unsigned nloc = b.st[0], nx = b.st[1];
        if (nloc == 0u) { xcd_barrier_complete(bar, b.x, nloc, nx); b.st[0] = nloc; b.st[1] = nx; }
        const unsigned old = xb_add(&bar[XB_XSUB(b.x)], 1u);
        const unsigned gen = old / nloc;
        if (old + 1u == (gen + 1u) * nloc) {
            __builtin_amdgcn_fence(__ATOMIC_RELEASE, "agent");
            asm volatile("s_waitcnt vmcnt(0)" ::: "memory");
            const unsigned og = xb_add(&bar[XB_TOP], 1u);
            const unsigned tg = og / nx;
            if (og + 1u == (tg + 1u) * nx) xb_add(&bar[XB_TOPGEN], 1u);
            else XB_SPIN(xb_ld(&bar[XB_TOPGEN]) == tg, bar);
            __builtin_amdgcn_fence(__ATOMIC_ACQUIRE, "agent");
            xb_add(&bar[XB_XGEN(b.x)], 1u);
            asm volatile("s_waitcnt vmcnt(0)" ::: "memory");
        } else {
            XB_SPIN(xb_ld(&bar[XB_XGEN(b.x)]) == gen, bar);
            __builtin_amdgcn_fence(__ATOMIC_ACQUIRE, "agent");
            asm volatile("s_waitcnt vmcnt(0)" ::: "memory");
        }
    }
    __syncthreads();
}

constexpr int D = 2048, NBATCH = 8, SEQ = 2048, CTXL = 256, DEPTH = 2;
constexpr int NLAT = NBATCH * SEQ, NCTX = NBATCH * CTXL, NTOK = NLAT + NCTX;
constexpr int INW = 12288, MODW = 6 * D, DC = 1024, NH = 8, DK = 128, NEXP = 16384;
constexpr int C_CB = 0, C_CC = 1024, C_CV = 2048, C_Q = 3072, C_ZF = 4096, C_ZB = 5120, C_VI = 6144, C_OG = 7168, C_GA = 8192, C_GB = 10240;
constexpr int C_YA = 3072, C_YB = 4096;
constexpr float ALPHA = 1.41421356237309515f, LN_EPS = 1e-6f, F_MIN = 1e-30f, QSCALE = 0.08838834764831845f;
constexpr int NWAVES = 8, NTHREADS = 512;
enum { I_X = 0, I_C, I_CTX, I_CCTX, I_WMOD, I_BMOD, I_WIN, I_CONVW, I_CONVB, I_LBRAW, I_HGG, I_WPA, I_WPB, I_WO, I_LN1G, I_LN1B, I_WQ, I_KEYS, I_PU, I_PV, I_LN2G, I_LN2B, N_IN };

constexpr size_t MiB = 1u << 20;
constexpr size_t WS_CTL = 0, CTL_ZERO_BYTES = 1 * MiB;
constexpr size_t WS_MOD = 1 * MiB;
constexpr size_t WS_WIN = 2 * MiB;
constexpr size_t WS_WPA = 50 * MiB, WS_WPB = 54 * MiB;
constexpr size_t WS_WO = 58 * MiB, WS_WQ = 66 * MiB;
constexpr size_t WS_KEYS = 74 * MiB;
constexpr size_t WS_U = 76 * MiB, WS_V = 140 * MiB;
constexpr size_t WS_X = 204 * MiB;
constexpr size_t WS_H = 348 * MiB;
constexpr size_t WS_Y = 420 * MiB;
constexpr size_t WS_PROJ = 492 * MiB;
constexpr size_t WS_OSC = 924 * MiB;
constexpr size_t WS_END = 1068 * MiB;
static_assert(WS_PROJ + (size_t)NTOK * INW * 2 <= WS_OSC && WS_OSC + (size_t)2 * NTOK * DC * 4 <= WS_END, "ws map");
constexpr size_t WS_ESCALE = 75 * MiB;
constexpr size_t WS_LBT = 75 * MiB + 131072;
constexpr int EROW = 1536;
constexpr int EREC = 3072;
typedef _Float16 v32h __attribute__((ext_vector_type(32)));
typedef float v32f __attribute__((ext_vector_type(32)));
typedef int v6i __attribute__((ext_vector_type(6)));
constexpr float SW8 = 2048.0f, SA8_M = 8.0f, SA8_H = 16.0f, SA8_Y = 8.0f;
constexpr size_t WS_H8 = 1086 * MiB;
constexpr size_t WS_WIN8 = WS_WIN + 8 * MiB;
constexpr int CW_BAR = 4096;

constexpr int RING_BYTES = 131072, LDSCTL_OFF = 135168, MISC_OFF = LDSCTL_OFF + 320, LDS_BYTES = 147456;

#define DI __device__ __forceinline__
typedef unsigned short bf16;
typedef unsigned u32x4 __attribute__((ext_vector_type(4)));
typedef unsigned u32x2 __attribute__((ext_vector_type(2)));
typedef float f32x4 __attribute__((ext_vector_type(4)));
constexpr int ESEG = 192;
constexpr size_t ESLICE = (size_t)16384 * ESEG;
__device__ __forceinline__ void eseg_store(unsigned char* tbl, int e, int lane, const v6i p) {
    unsigned char* d = tbl + (size_t)(lane >> 3) * ESLICE + (size_t)e * ESEG + (lane & 7) * 24;
    *(u32x2*)d = (u32x2){(unsigned)p[0], (unsigned)p[1]}; *(u32x2*)(d + 8) = (u32x2){(unsigned)p[2], (unsigned)p[3]}; *(u32x2*)(d + 16) = (u32x2){(unsigned)p[4], (unsigned)p[5]};
}

DI float bf_lo(unsigned w) { return __uint_as_float(w << 16); }
DI float bf_hi(unsigned w) { return __uint_as_float(w & 0xffff0000u); }
DI unsigned pk2(float lo, float hi) { unsigned r; asm("v_cvt_pk_bf16_f32 %0, %1, %2" : "=v"(r) : "v"(lo), "v"(hi)); return r; }
DI float clamp448(float x) { return fminf(fmaxf(x, -448.0f), 448.0f); }
DI unsigned pk4_fp8(float a, float b, float c, float d) { int w = 0; w = __builtin_amdgcn_cvt_pk_fp8_f32(clamp448(a), clamp448(b), w, false); w = __builtin_amdgcn_cvt_pk_fp8_f32(clamp448(c), clamp448(d), w, true); return (unsigned)w; }
DI void unpack8(const u32x4 w, float (&f)[8]) { f[0] = bf_lo(w.x); f[1] = bf_hi(w.x); f[2] = bf_lo(w.y); f[3] = bf_hi(w.y); f[4] = bf_lo(w.z); f[5] = bf_hi(w.z); f[6] = bf_lo(w.w); f[7] = bf_hi(w.w); }
DI u32x4 pack8(const float (&f)[8]) { u32x4 w; w.x = pk2(f[0], f[1]); w.y = pk2(f[2], f[3]); w.z = pk2(f[4], f[5]); w.w = pk2(f[6], f[7]); return w; }
DI float wave_sum(float v) {
#pragma unroll
    for (int o = 1; o < 64; o <<= 1) v += __shfl_xor(v, o);
    return v;
}
DI float frcp(float x) { return __builtin_amdgcn_rcpf(x); }
DI float sigm(float x) { return frcp(1.0f + __expf(-x)); }
DI float silu(float x) { return x * frcp(1.0f + __expf(-x)); }
DI float gelu_erf(float x) { return 0.5f * x * (1.0f + erff(x * 0.70710678118654752f)); }

extern __shared__ __attribute__((aligned(16))) unsigned char lds_raw[];
constexpr int PTR_OFF = MISC_OFF + 256;
DI unsigned long long ld_ptr(int i) {
    const unsigned long long v = ((volatile LAS unsigned long long*)((LAS unsigned char*)lds_raw + PTR_OFF))[i];
    const unsigned lo = __builtin_amdgcn_readfirstlane((unsigned)v), hi = __builtin_amdgcn_readfirstlane((unsigned)(v >> 32));
    return ((unsigned long long)hi << 32) | lo;
}
template <class T> DI T* as_global(unsigned long long v) {
    return (T*)(__attribute__((address_space(1))) T*)v; }
DI const float* inp(int i) { return as_global<const float>(ld_ptr(i)); }
struct Frame {
    LAS unsigned char* lds;
    int tid, lane, wave, G;
    float* out; unsigned char* ws;
    float* mod; bf16 *Win, *Wpa, *Wpb, *Wo, *Wq, *Keys, *U, *V; float* X; bf16 *H, *Y, *PROJ; float* OSC;
};
DI int lane_id() { unsigned z = 0u; asm volatile("" : "+v"(z)); return (int)__builtin_amdgcn_mbcnt_hi(~0u, __builtin_amdgcn_mbcnt_lo(~0u, z)); }
DI Frame mkframe(int wv) {
    Frame F; int ln = lane_id(); asm volatile("" : "+v"(ln)); asm volatile("" : "+s"(wv));
    F.lds = (LAS unsigned char*)lds_raw; F.tid = wv * 64 + ln; F.lane = ln; F.wave = wv; F.G = gridDim.x;
    F.out = as_global<float>(ld_ptr(N_IN)); unsigned char* ws = as_global<unsigned char>(ld_ptr(N_IN + 1)); F.ws = ws;
    F.mod = (float*)(ws + WS_MOD); F.Win = (bf16*)(ws + WS_WIN); F.Wpa = (bf16*)(ws + WS_WPA); F.Wpb = (bf16*)(ws + WS_WPB); F.Wo = (bf16*)(ws + WS_WO); F.Wq = (bf16*)(ws + WS_WQ);
    F.Keys = (bf16*)(ws + WS_KEYS); F.U = (bf16*)(ws + WS_U); F.V = (bf16*)(ws + WS_V); F.X = (float*)(ws + WS_X); F.H = (bf16*)(ws + WS_H); F.Y = (bf16*)(ws + WS_Y);
    F.PROJ = (bf16*)(ws + WS_PROJ); F.OSC = (float*)(ws + WS_OSC);
    return F;
}
DI const float* xrow(const float* xin, const float* cin, const float* X, int l, int r) {
    if (l == 0) return r < NLAT ? xin + (size_t)r * D : cin + (size_t)(r - NLAT) * D;
    return X + (size_t)r * D;
}
DI int modrow(int r) { return r < NLAT ? r / SEQ : 8; }
DI float lower_bound(const float* lbraw, int l, int d, int c) {
    if (l == 0) return 0.0f;
    const float a0 = lbraw[d * DC + c], a1 = lbraw[2 * DC + d * DC + c];
    return 1.0f / (1.0f + __expf(a0 - a1));
}

DI void transpose_item(const float* W, int K, int N, bf16* WT, LAS float* scr, int item, int lane, int ldw = 0, int koff = 0, bool f8 = false, int win_split = 0) {
    if (ldw == 0) ldw = K;
    const int nblk = N / 64, kb = item / nblk, nb = item % nblk, k0 = 64 * kb, n0 = 64 * nb;
    int drow = n0;
    if (win_split) { if (n0 >= C_ZF && n0 < C_VI) { drow = n0 - C_ZF; } else { f8 = true; drow = n0 < C_ZF ? n0 : n0 - (C_VI - C_ZF); WT = (bf16*)((unsigned char*)WT + (WS_WIN8 - WS_WIN)); } }
    const int n4 = (lane & 15) * 4;
#pragma unroll 8
    for (int i = 0; i < 16; ++i) { const int kk = 4 * i + (lane >> 4); const f32x4 v = __builtin_nontemporal_load((const f32x4*)(W + (size_t)(k0 + kk) * N + n0 + n4));
        LAS float* d = scr + kk * 65 + n4; d[0] = v.x; d[1] = v.y; d[2] = v.z; d[3] = v.w; }
    __builtin_amdgcn_fence(__ATOMIC_RELEASE, "wavefront"); asm volatile("s_waitcnt lgkmcnt(0)" ::: "memory");
    const int c = lane & 7;
#pragma unroll
    for (int j = 0; j < 8; ++j) { const int n = (lane >> 3) + 8 * j; const LAS float* s = scr + (8 * c) * 65 + n;
        if (f8) { u32x2 o; o.x = pk4_fp8(s[0 * 65] * SW8, s[1 * 65] * SW8, s[2 * 65] * SW8, s[3 * 65] * SW8); o.y = pk4_fp8(s[4 * 65] * SW8, s[5 * 65] * SW8, s[6 * 65] * SW8, s[7 * 65] * SW8);
            *(u32x2*)((unsigned char*)WT + (size_t)(drow + n) * ldw + koff + k0 + 8 * c) = o; }
        else { u32x4 o; o.x = pk2(s[0 * 65], s[1 * 65]); o.y = pk2(s[2 * 65], s[3 * 65]); o.z = pk2(s[4 * 65], s[5 * 65]); o.w = pk2(s[6 * 65], s[7 * 65]);
            *(u32x4*)(WT + (size_t)(drow + n) * ldw + koff + k0 + 8 * c) = o; } }
    asm volatile("s_waitcnt lgkmcnt(0)" ::: "memory");
}
DI void cvt_copy(const Frame& F, const float* src, bf16* dst, size_t n) {
    const size_t nthreads = (size_t)F.G * NTHREADS;
    for (size_t i = (size_t)blockIdx.x * NTHREADS + F.tid; i < n / 8; i += nthreads) {
        const f32x4 a = *(const f32x4*)(src + i * 8), b = *(const f32x4*)(src + i * 8 + 4);
        u32x4 o; o.x = pk2(a.x, a.y); o.y = pk2(a.z, a.w); o.z = pk2(b.x, b.y); o.w = pk2(b.z, b.w);
        *(u32x4*)(dst + i * 8) = o;
    }
}
DI void phase_convert(int l, int wv, bool tables) {
    const Frame F = mkframe(wv);
    LAS float* scr = (LAS float*)(F.lds + F.wave * 16640);
    const int gw = blockIdx.x * NWAVES + F.wave, NGW = F.G * NWAVES;
    constexpr int IT_IN = (D / 64) * (INW / 64), IT_PA = (DC / 64) * (D / 64), IT_O = (D / 64) * (D / 64);
    constexpr int NITEMS = IT_IN + 2 * IT_PA + 2 * IT_O;
    for (int it = gw; it < NITEMS; it += NGW) {
        int r = it;
        if (r < IT_IN) { transpose_item(inp(I_WIN) + (size_t)l * D * INW, D, INW, F.Win, scr, r, F.lane, D, 0, false, 1); continue; } r -= IT_IN;
        if (r < IT_PA) { transpose_item(inp(I_WPA) + (size_t)l * DC * D, DC, D, F.Wpa, scr, r, F.lane, D, 0, true); continue; } r -= IT_PA;
        if (r < IT_PA) { transpose_item(inp(I_WPB) + (size_t)l * DC * D, DC, D, F.Wpa, scr, r, F.lane, D, DC, true); continue; } r -= IT_PA;
        if (r < IT_O)  { transpose_item(inp(I_WO) + (size_t)l * D * D, D, D, F.Wo, scr, r, F.lane, D, 0, true); continue; } r -= IT_O;
        transpose_item(inp(I_WQ) + (size_t)l * D * D, D, D, F.Wq, scr, r, F.lane);
    }
    cvt_copy(F, inp(I_KEYS) + (size_t)l * NH * 2 * 128 * 128, F.Keys, (size_t)NH * 2 * 128 * 128);
    if (blockIdx.x == 0) { const float* lbraw = inp(I_LBRAW); float* lbt = (float*)(F.ws + WS_LBT);
        for (int i = F.tid; i < 2 * DC; i += NTHREADS) lbt[i] = lower_bound(lbraw, l, i / DC, i % DC); }
    { const float* pu = inp(I_PU) + (size_t)l * NEXP * D; const float* pv = inp(I_PV) + (size_t)l * NEXP * D;
      unsigned char* U6 = (unsigned char*)F.U; unsigned char* V6 = (unsigned char*)F.V; float* SU = (float*)(F.ws + WS_ESCALE); float* SV = SU + NEXP;
      if (tables) for (int it = gw; it < 2 * NEXP; it += NGW) {
          const int e = it >> 1; const float* src = ((it & 1) ? pv : pu) + (size_t)e * D; unsigned char* dst = (it & 1) ? V6 : U6;
          f32x4 x[8]; float am = 0.f;
#pragma unroll
          for (int c = 0; c < 8; ++c) { x[c] = __builtin_nontemporal_load((const f32x4*)(src + c * 256 + F.lane * 4));
              am = fmaxf(am, fmaxf(fmaxf(fabsf(x[c].x), fabsf(x[c].y)), fmaxf(fabsf(x[c].z), fabsf(x[c].w)))); }
#pragma unroll
          for (int o = 1; o < 64; o <<= 1) am = fmaxf(am, __shfl_xor(am, o));
          const float inv = am > 0.f ? 7.0f / am : 0.f, sc = am > 0.f ? am * (1.0f / 7.0f) : 0.f;
          v32h hx;
#pragma unroll
          for (int c = 0; c < 8; ++c) { hx[c * 4 + 0] = (_Float16)(x[c].x * inv); hx[c * 4 + 1] = (_Float16)(x[c].y * inv); hx[c * 4 + 2] = (_Float16)(x[c].z * inv); hx[c * 4 + 3] = (_Float16)(x[c].w * inv); }
          const v6i p = __builtin_amdgcn_cvt_scalef32_pk32_fp6_f16(hx, 1.0f);
          eseg_store(dst, e, F.lane, p);
          if (F.lane == 0) ((it & 1) ? SV : SU)[e] = sc;
      } }
}
DI void phase_mod(int wv) {
    const Frame F = mkframe(wv);
    LAS float* sv = (LAS float*)F.lds;
    LAS float* red = (LAS float*)(F.lds + 73728);
    constexpr int NITEM = 2 * (MODW / 64);
    if ((int)blockIdx.x >= NITEM) return;
    __syncthreads();
    const float* cvec = inp(I_C); const float* cctx = inp(I_CCTX); const float* wmod = inp(I_WMOD); const float* bmod = inp(I_BMOD);
    for (int i = F.tid; i < 9 * D; i += NTHREADS) { const int r = i / D, k = i % D; const float c = r < 8 ? cvec[r * D + k] : cctx[k]; sv[i] = silu(c); }
    __syncthreads();
    for (int item = blockIdx.x; item < NITEM; item += F.G) {
        const int l = item / (MODW / 64), nb = item % (MODW / 64);
        const float* W = wmod + (size_t)l * D * MODW + nb * 64 + F.lane;
        float acc[9];
#pragma unroll
        for (int r = 0; r < 9; ++r) acc[r] = 0.f;
#pragma unroll 8
        for (int kk = 0; kk < 256; ++kk) { const int k = F.wave * 256 + kk; const float w = __builtin_nontemporal_load(W + (size_t)k * MODW);
#pragma unroll
            for (int r = 0; r < 9; ++r) acc[r] += sv[r * D + k] * w; }
#pragma unroll
        for (int r = 0; r < 9; ++r) red[(F.wave * 9 + r) * 64 + F.lane] = acc[r];
        __syncthreads();
        for (int idx = F.tid; idx < 9 * 64; idx += NTHREADS) { const int r = idx / 64, nn = idx % 64; float s = bmod[l * MODW + nb * 64 + nn];
#pragma unroll
            for (int w = 0; w < 8; ++w) s += red[(w * 9 + r) * 64 + nn];
            F.mod[((size_t)l * 9 + r) * MODW + nb * 64 + nn] = s; }
        __syncthreads();
    }
}

DI void load_row_f32(const float* src, int lane, float (&v)[32]) {
#pragma unroll
    for (int c = 0; c < 4; ++c) { const f32x4 a = *(const f32x4*)(src + c * 512 + lane * 8), b = *(const f32x4*)(src + c * 512 + lane * 8 + 4);
        v[c * 8 + 0] = a.x; v[c * 8 + 1] = a.y; v[c * 8 + 2] = a.z; v[c * 8 + 3] = a.w; v[c * 8 + 4] = b.x; v[c * 8 + 5] = b.y; v[c * 8 + 6] = b.z; v[c * 8 + 7] = b.w; }
}
DI void store_row_f32(float* dst, int lane, const float (&v)[32]) {
#pragma unroll
    for (int c = 0; c < 4; ++c) { *(f32x4*)(dst + c * 512 + lane * 8) = (f32x4){v[c * 8 + 0], v[c * 8 + 1], v[c * 8 + 2], v[c * 8 + 3]};
        *(f32x4*)(dst + c * 512 + lane * 8 + 4) = (f32x4){v[c * 8 + 4], v[c * 8 + 5], v[c * 8 + 6], v[c * 8 + 7]}; }
}
DI void load_row_bf16(const bf16* src, int lane, float (&v)[32]) {
#pragma unroll
    for (int c = 0; c < 4; ++c) { const u32x4 w = *(const u32x4*)(src + c * 512 + lane * 8);
        v[c * 8 + 0] = bf_lo(w.x); v[c * 8 + 1] = bf_hi(w.x); v[c * 8 + 2] = bf_lo(w.y); v[c * 8 + 3] = bf_hi(w.y); v[c * 8 + 4] = bf_lo(w.z); v[c * 8 + 5] = bf_hi(w.z); v[c * 8 + 6] = bf_lo(w.w); v[c * 8 + 7] = bf_hi(w.w); }
}
DI void store_row_bf16(bf16* dst, int lane, const float (&v)[32]) {
#pragma unroll
    for (int c = 0; c < 4; ++c) { u32x4 w; w.x = pk2(v[c * 8 + 0], v[c * 8 + 1]); w.y = pk2(v[c * 8 + 2], v[c * 8 + 3]); w.z = pk2(v[c * 8 + 4], v[c * 8 + 5]); w.w = pk2(v[c * 8 + 6], v[c * 8 + 7]);
        *(u32x4*)(dst + c * 512 + lane * 8) = w; }
}
DI void row_normalize(float (&v)[32]) {
    float s = 0.f;
#pragma unroll
    for (int i = 0; i < 32; ++i) s += v[i];
    const float mean = wave_sum(s) * (1.0f / D);
    float q = 0.f;
#pragma unroll
    for (int i = 0; i < 32; ++i) { v[i] -= mean; q += v[i] * v[i]; }
    const float rstd = rsqrtf(wave_sum(q) * (1.0f / D) + LN_EPS);
#pragma unroll
    for (int i = 0; i < 32; ++i) v[i] *= rstd;
}

DI void phase_modulate1(int l, int wv) {
    const Frame F = mkframe(wv);
    const float* xin = inp(I_X); const float* cin = inp(I_CTX);
    const int gw = blockIdx.x * NWAVES + F.wave, NGW = F.G * NWAVES;
    for (int r = gw; r < NTOK; r += NGW) {
        const float* md = F.mod + ((size_t)l * 9 + modrow(r)) * MODW;
        float v[32], sh[32], sc[32];
        load_row_f32(xrow(xin, cin, F.X, l, r), F.lane, v);
        load_row_f32(md + 0 * D, F.lane, sh); load_row_f32(md + 1 * D, F.lane, sc);
        row_normalize(v);
#pragma unroll
        for (int i = 0; i < 32; ++i) v[i] = v[i] * (1.0f + sc[i]) + sh[i];
        store_row_bf16(F.H + (size_t)r * D, F.lane, v);
        unsigned char* h8 = F.ws + WS_H8 + (size_t)r * D;
#pragma unroll
        for (int c = 0; c < 4; ++c) *(u32x2*)(h8 + c * 512 + F.lane * 8) = (u32x2){pk4_fp8(v[c * 8 + 0] * SA8_H, v[c * 8 + 1] * SA8_H, v[c * 8 + 2] * SA8_H, v[c * 8 + 3] * SA8_H), pk4_fp8(v[c * 8 + 4] * SA8_H, v[c * 8 + 5] * SA8_H, v[c * 8 + 6] * SA8_H, v[c * 8 + 7] * SA8_H)};
    }
}

struct EpiStore {
    static constexpr bool PERM = true, AFTER_DRAIN = false, MIDK = false;
    bf16* O; int ldc; float scale; int split_pn, shift;
    DI void operator()(const pg8::f32x4 (&acc)[2][2][4][2], const pg8::Unit& u, int wr, int wc, int fr, int fq) const {
        const int row0 = u.pm * 256 + wr * 64 + fr, col0 = u.pn * 256 + (u.pn >= split_pn ? shift : 0) + wc * 64 + 8 * fq;
#pragma unroll
        for (int ai = 0; ai < 2; ++ai)
#pragma unroll
            for (int m = 0; m < 4; ++m) { bf16* rowp = O + (size_t)(row0 + ai * 128 + m * 16) * ldc + col0;
#pragma unroll
                for (int bj = 0; bj < 2; ++bj) { const pg8::f32x4 v0 = acc[ai][bj][m][0] * scale, v1 = acc[ai][bj][m][1] * scale;
                    u32x4 w; w.x = pk2(v0[0], v0[1]); w.y = pk2(v0[2], v0[3]); w.z = pk2(v1[0], v1[1]); w.w = pk2(v1[2], v1[3]);
                    *(u32x4*)(rowp + bj * 32) = w; } }
    }
};
struct EpiMerge {
    static constexpr bool PERM = true, AFTER_DRAIN = false, MIDK = true;
    const bf16* Ga; const bf16* Gb; int ldg; bf16* O; int ldc;
    DI void mid(pg8::f32x4 (&acc)[2][2][4][2], const pg8::Unit& u, int wr, int wc, int fr, int fq) const {
        asm volatile("" : "+v"(fr), "+v"(fq));
        const int row0 = u.pm * 256 + wr * 64 + fr, col0 = u.pn * 256 + wc * 64 + 8 * fq;
#pragma unroll
        for (int ai = 0; ai < 2; ++ai)
#pragma unroll
            for (int m = 0; m < 4; ++m) { const size_t rr = (size_t)(row0 + ai * 128 + m * 16);
#pragma unroll
                for (int bj = 0; bj < 2; ++bj) { float ga[8], gb[8];
                    unpack8(*(const u32x4*)(Ga + rr * ldg + col0 + bj * 32), ga); unpack8(*(const u32x4*)(Gb + rr * ldg + col0 + bj * 32), gb);
#pragma unroll
                    for (int j = 0; j < 8; ++j) { const float ratio = (1.0f + __expf(-gb[j])) * frcp(1.0f + __expf(-ga[j])); acc[ai][bj][m][j >> 2][j & 3] *= ratio; } }
                asm volatile("" ::: "memory"); }
    }
    DI void operator()(const pg8::f32x4 (&acc)[2][2][4][2], const pg8::Unit& u, int wr, int wc, int fr, int fq) const {
        const int row0 = u.pm * 256 + wr * 64 + fr, col0 = u.pn * 256 + wc * 64 + 8 * fq;
#pragma unroll
        for (int ai = 0; ai < 2; ++ai)
#pragma unroll
            for (int m = 0; m < 4; ++m) { const size_t rr = (size_t)(row0 + ai * 128 + m * 16);
#pragma unroll
                for (int bj = 0; bj < 2; ++bj) { const pg8::f32x4 v0 = acc[ai][bj][m][0], v1 = acc[ai][bj][m][1];
                    const float a[8] = {v0[0], v0[1], v0[2], v0[3], v1[0], v1[1], v1[2], v1[3]}; float g[8], o[8];
                    unpack8(*(const u32x4*)(Gb + rr * ldg + col0 + bj * 32), g);
#pragma unroll
                    for (int j = 0; j < 8; ++j) o[j] = sigm(g[j]) * a[j] * (SA8_M / (SW8 * SA8_Y));
                    *(u32x2*)((unsigned char*)O + rr * ldc + col0 + bj * 32) = (u32x2){pk4_fp8(o[0], o[1], o[2], o[3]), pk4_fp8(o[4], o[5], o[6], o[7])}; } }
    }
};

typedef short bf16x8v __attribute__((ext_vector_type(8)));
typedef short s16x4v __attribute__((ext_vector_type(4)));
typedef float f32x16 __attribute__((ext_vector_type(16)));
DI unsigned short f2bf1(float x) { return (unsigned short)(pk2(x, 0.f) & 0xffffu); }
constexpr int C_QTF = C_CB, C_KTF = C_Q, C_QTB = C_ZF, C_KTB = C_ZB;
constexpr size_t WS_EV = 1068 * MiB;
DI float* ev_ptr(unsigned char* ws, int chunk, int h, int dir) { return (float*)(ws + WS_EV) + ((size_t)(chunk * NH + h) * 2 + dir) * 384; }
DI void phase_prep(int l, int wv, bool dry = false) {
    const Frame F = mkframe(wv);
    const float* lbt = (const float*)(F.ws + WS_LBT);
    const float* cw = inp(I_CONVW) + (size_t)l * 3 * DC; const float* cbias = inp(I_CONVB) + (size_t)l * DC;
    constexpr int O_TOTF = 0, O_TOTB = 2048, O_PRE = 4096;
    LAS unsigned char* L = F.lds;
    const int lane = F.lane, w = F.wave, pl = lane >> 3, cg = lane & 7, pp = w * 8 + pl;
    struct PrepIn { u32x4 cb, cc, cv, ccp, cvp, ccn, cvn, zf, zb, q; };
    constexpr int NITEM = (NTOK / 64) * NH * 2;
    auto item_load = [&](int item, PrepIn& P) {
        const int chunk = item >> 4, h = (item >> 1) & 7, hc = (item & 1) * 64 + cg * 8, row = chunk * 64 + pp, c0 = h * DK + hc;
        const bf16* prow = F.PROJ + (size_t)row * INW;
        bool hasp, hasn;
        if (row < NLAT) { hasp = pp != 0; hasn = pp != 63; } else { const int t = (row - NLAT) & (CTXL - 1); hasp = t != 0; hasn = t != CTXL - 1; }
        const bf16* pprev = hasp ? prow - INW : prow; const bf16* pnext = hasn ? prow + INW : prow;
        P.cb = *(const u32x4*)(prow + C_CB + c0); P.cc = *(const u32x4*)(prow + C_CC + c0); P.cv = *(const u32x4*)(prow + C_CV + c0);
        P.ccp = *(const u32x4*)(pprev + C_CC + c0); P.cvp = *(const u32x4*)(pprev + C_CV + c0); P.ccn = *(const u32x4*)(pnext + C_CC + c0); P.cvn = *(const u32x4*)(pnext + C_CV + c0);
        P.zf = *(const u32x4*)(prow + C_ZF + c0); P.zb = *(const u32x4*)(prow + C_ZB + c0); P.q = *(const u32x4*)(prow + C_Q + c0); };
    auto item_compute = [&](int item, const PrepIn& P) {
        const int chunk = item >> 4, h = (item >> 1) & 7, hc = (item & 1) * 64 + cg * 8, row = chunk * 64 + pp, c0 = h * DK + hc;
        bf16* prow = F.PROJ + (size_t)row * INW;
        bool hasp, hasn;
        if (row < NLAT) { hasp = pp != 0; hasn = pp != 63; } else { const int t = (row - NLAT) & (CTXL - 1); hasp = t != 0; hasn = t != CTXL - 1; }
        {   float cb[8], cc[8], cv[8], up[8], un[8], t0[8], t1[8], ya[8];
            unpack8(P.cb, cb); unpack8(P.cc, cc); unpack8(P.cv, cv);
            if (hasp) { unpack8(P.ccp, t0); unpack8(P.cvp, t1);
#pragma unroll
                for (int j = 0; j < 8; ++j) up[j] = t0[j] * t1[j]; }
            else {
#pragma unroll
                for (int j = 0; j < 8; ++j) up[j] = 0.f; }
            if (hasn) { unpack8(P.ccn, t0); unpack8(P.cvn, t1);
#pragma unroll
                for (int j = 0; j < 8; ++j) un[j] = t0[j] * t1[j]; }
            else {
#pragma unroll
                for (int j = 0; j < 8; ++j) un[j] = 0.f; }
            const f32x4 w0a = *(const f32x4*)(cw + c0), w0b = *(const f32x4*)(cw + c0 + 4), w1a = *(const f32x4*)(cw + DC + c0), w1b = *(const f32x4*)(cw + DC + c0 + 4);
            const f32x4 w2a = *(const f32x4*)(cw + 2 * DC + c0), w2b = *(const f32x4*)(cw + 2 * DC + c0 + 4), bia = *(const f32x4*)(cbias + c0), bib = *(const f32x4*)(cbias + c0 + 4);
#pragma unroll
            for (int j = 0; j < 8; ++j) { const float w0 = j < 4 ? w0a[j & 3] : w0b[j & 3], w1 = j < 4 ? w1a[j & 3] : w1b[j & 3], w2 = j < 4 ? w2a[j & 3] : w2b[j & 3], bi = j < 4 ? bia[j & 3] : bib[j & 3];
                ya[j] = cb[j] * (w0 * up[j] + w1 * (cc[j] * cv[j]) + w2 * un[j] + bi); }
            if (!dry) *(u32x2*)((unsigned char*)F.H + (size_t)row * D + c0) = (u32x2){pk4_fp8(ya[0] * SA8_Y, ya[1] * SA8_Y, ya[2] * SA8_Y, ya[3] * SA8_Y), pk4_fp8(ya[4] * SA8_Y, ya[5] * SA8_Y, ya[6] * SA8_Y, ya[7] * SA8_Y)};
        }
        float lff[8], lfb[8], kf[8], kb[8], qs[8];
        {   float zf[8], zb[8], q[8];
            unpack8(P.zf, zf); unpack8(P.zb, zb); unpack8(P.q, q);
            const f32x4 lfa = *(const f32x4*)(lbt + c0), lfc = *(const f32x4*)(lbt + c0 + 4), lba = *(const f32x4*)(lbt + DC + c0), lbc = *(const f32x4*)(lbt + DC + c0 + 4);
#pragma unroll
            for (int i = 0; i < 8; ++i) { const float lbf = i < 4 ? lfa[i & 3] : lfc[i & 3], lbb = i < 4 ? lba[i & 3] : lbc[i & 3];
                const float ef = __expf(fminf(fmaxf(-zf[i], -80.f), 80.f)), eb = __expf(fminf(fmaxf(-zb[i], -80.f), 80.f)), sf = frcp(1.0f + ef), sb = frcp(1.0f + eb);
                lff[i] = __logf(fmaxf(lbf + (1.0f - lbf) * sf, F_MIN)); kf[i] = (1.0f - lbf) * (ef * sf);
                lfb[i] = __logf(fmaxf(lbb + (1.0f - lbb) * sb, F_MIN)); kb[i] = (1.0f - lbb) * (eb * sb);
                qs[i] = q[i] * frcp(1.0f + __expf(-q[i])) * QSCALE; }
        }
#pragma unroll
        for (int d = 1; d < 8; d <<= 1) {
#pragma unroll
            for (int i = 0; i < 8; ++i) { const float o = __shfl_up(lff[i], 8 * d); if (pl >= d) lff[i] += o; const float o2 = __shfl_down(lfb[i], 8 * d); if (pl + d < 8) lfb[i] += o2; } }
        __syncthreads();
        if (pl == 7) { *(LAS f32x4*)(L + O_TOTF + (w * 64 + cg * 8) * 4) = (f32x4){lff[0], lff[1], lff[2], lff[3]}; *(LAS f32x4*)(L + O_TOTF + (w * 64 + cg * 8 + 4) * 4) = (f32x4){lff[4], lff[5], lff[6], lff[7]}; }
        if (pl == 0) { *(LAS f32x4*)(L + O_TOTB + (w * 64 + cg * 8) * 4) = (f32x4){lfb[0], lfb[1], lfb[2], lfb[3]}; *(LAS f32x4*)(L + O_TOTB + (w * 64 + cg * 8 + 4) * 4) = (f32x4){lfb[4], lfb[5], lfb[6], lfb[7]}; }
        __syncthreads();
        if (F.tid < 128) { const int dd = F.tid >> 6, cch = F.tid & 63; const LAS float* tp = (const LAS float*)(L + (dd ? O_TOTB : O_TOTF)) + cch; LAS float* pp_ = (LAS float*)(L + O_PRE) + dd * 640 + cch;
            float t[8];
#pragma unroll
            for (int ww = 0; ww < 8; ++ww) t[ww] = tp[ww * 64];
            float run = 0.f;
            if (dd == 0) {
#pragma unroll
                for (int ww = 0; ww < 8; ++ww) { pp_[ww * 64] = run; run += t[ww]; }
                pp_[512] = (t[0] + t[1]) + (t[2] + t[3]); }
            else {
#pragma unroll
                for (int ww = 7; ww >= 0; --ww) { pp_[ww * 64] = run; run += t[ww]; }
                pp_[512] = (t[4] + t[5]) + (t[6] + t[7]); }
            pp_[576] = run; }
        __syncthreads();
        {   float pf[8], rf[8], bf_[8], pb[8], rb[8], bb[8];
            const LAS float* PF = (const LAS float*)(L + O_PRE) + cg * 8; const LAS float* PB = PF + 640;
#pragma unroll
            for (int q4 = 0; q4 < 2; ++q4) { const f32x4 a0 = *(const LAS f32x4*)(PF + w * 64 + q4 * 4), a1 = *(const LAS f32x4*)(PF + 512 + q4 * 4), a2 = *(const LAS f32x4*)(PF + 576 + q4 * 4);
                const f32x4 b0 = *(const LAS f32x4*)(PB + w * 64 + q4 * 4), b1 = *(const LAS f32x4*)(PB + 512 + q4 * 4), b2 = *(const LAS f32x4*)(PB + 576 + q4 * 4);
#pragma unroll
                for (int e = 0; e < 4; ++e) { const int i = q4 * 4 + e; pf[i] = a0[e]; rf[i] = a1[e]; bf_[i] = a2[e]; pb[i] = b0[e]; rb[i] = b1[e]; bb[i] = b2[e]; } }
            float o0[8], o1[8], o2[8], o3[8];
#pragma unroll
            for (int i = 0; i < 8; ++i) { const float bcf = pf[i] + lff[i], bcb = pb[i] + lfb[i];
                o0[i] = qs[i] * __expf(fminf(bcf - rf[i], 80.f)); o1[i] = kf[i] * __expf(fminf(rf[i] - bcf, 80.f));
                o2[i] = qs[i] * __expf(fminf(bcb - rb[i], 80.f)); o3[i] = kb[i] * __expf(fminf(rb[i] - bcb, 80.f)); }
            if (!dry) { *(u32x4*)(prow + C_QTF + c0) = pack8(o0); *(u32x4*)(prow + C_KTF + c0) = pack8(o1);
            *(u32x4*)(prow + C_QTB + c0) = pack8(o2); *(u32x4*)(prow + C_KTB + c0) = pack8(o3); }
            if (pp == 0 && !dry) {
                float* evf = ev_ptr(F.ws, chunk, h, 0) + hc; float* evb = ev_ptr(F.ws, chunk, h, 1) + hc;
#pragma unroll
                for (int q4 = 0; q4 < 2; ++q4) {
                    *(f32x4*)(evf + q4 * 4) = (f32x4){__expf(rf[q4 * 4]), __expf(rf[q4 * 4 + 1]), __expf(rf[q4 * 4 + 2]), __expf(rf[q4 * 4 + 3])};
                    *(f32x4*)(evf + 128 + q4 * 4) = (f32x4){__expf(bf_[q4 * 4] - rf[q4 * 4]), __expf(bf_[q4 * 4 + 1] - rf[q4 * 4 + 1]), __expf(bf_[q4 * 4 + 2] - rf[q4 * 4 + 2]), __expf(bf_[q4 * 4 + 3] - rf[q4 * 4 + 3])};
                    *(f32x4*)(evf + 256 + q4 * 4) = (f32x4){__expf(bf_[q4 * 4]), __expf(bf_[q4 * 4 + 1]), __expf(bf_[q4 * 4 + 2]), __expf(bf_[q4 * 4 + 3])};
                    *(f32x4*)(evb + q4 * 4) = (f32x4){__expf(rb[q4 * 4]), __expf(rb[q4 * 4 + 1]), __expf(rb[q4 * 4 + 2]), __expf(rb[q4 * 4 + 3])};
                    *(f32x4*)(evb + 128 + q4 * 4) = (f32x4){__expf(bb[q4 * 4] - rb[q4 * 4]), __expf(bb[q4 * 4 + 1] - rb[q4 * 4 + 1]), __expf(bb[q4 * 4 + 2] - rb[q4 * 4 + 2]), __expf(bb[q4 * 4 + 3] - rb[q4 * 4 + 3])};
                    *(f32x4*)(evb + 256 + q4 * 4) = (f32x4){__expf(bb[q4 * 4]), __expf(bb[q4 * 4 + 1]), __expf(bb[q4 * 4 + 2]), __expf(bb[q4 * 4 + 3])}; }
            }
        }
    };
    PrepIn PA, PB;
    int item = blockIdx.x;
    if (item < NITEM) item_load(item, PA);
    while (item < NITEM) {
        const int n1 = item + F.G, n2 = item + 2 * F.G;
        if (n1 < NITEM) item_load(n1, PB);
        item_compute(item, PA);
        if (n1 >= NITEM) break;
        if (n2 < NITEM) item_load(n2, PA);
        item_compute(n1, PB);
        item = n2;
    }
}
DI bf16x8v tr_frag(const LAS unsigned char* tile, int stride, int s0, int cbase, int lane) {
    const int i16 = lane & 15, g16 = (lane >> 4) & 1;
    const LAS unsigned char* p = tile + (s0 + (i16 >> 2)) * stride + (cbase + 16 * g16 + 4 * (i16 & 3)) * 2;
    const s16x4v lo = __builtin_amdgcn_ds_read_tr16_b64_v4i16((LAS s16x4v*)p), hi = __builtin_amdgcn_ds_read_tr16_b64_v4i16((LAS s16x4v*)(p + 4 * stride));
    return __builtin_shufflevector(lo, hi, 0, 1, 2, 3, 4, 5, 6, 7);
}
DI void phase_scan(int l, int wv, bool fill, bool last) {
    const Frame F = mkframe(wv);
    const float* pu = inp(I_PU) + (size_t)l * NEXP * D; const float* pv = inp(I_PV) + (size_t)l * NEXP * D;
    constexpr int RS = 272, RS64 = 144;
    constexpr int O_QT = 0, O_KT = 17408, O_ST = 34816, O_V = 52224, O_PM = 61440, O_EV = 70656;
    LAS unsigned char* L = F.lds;
    const int tid = F.tid, lane = F.lane, w = F.wave, r32 = lane & 31, hh = lane >> 5;
    const int srow = tid >> 3, sc16 = (tid & 7) * 16, svc = (tid & 7) * 8;
    for (int task = blockIdx.x; task < NBATCH * NH * 4; task += F.G) {
        const int b = task >> 5, h = (task >> 2) & 7, dir = (task >> 1) & 1, vh = task & 1;
        const int cq = (dir ? C_QTB : C_QTF) + h * DK + sc16, ck = (dir ? C_KTB : C_KTF) + h * DK + sc16, cvv = C_VI + h * DK + vh * 64 + svc;
        f32x16 S;
#pragma unroll
        for (int i = 0; i < 16; ++i) S[i] = 0.f;
        auto chunk_row0 = [&](int c) { return c < 4 ? NLAT + b * CTXL + (dir ? 3 - c : c) * 64 : b * SEQ + (dir ? 35 - c : c - 4) * 64; };
        u32x4 q0, q1, k0, k1, vr; f32x4 evr = (f32x4){0.f, 0.f, 0.f, 0.f};
        f32x4 fx[8]; const int fidx = (int)blockIdx.x * 4 + w; const bool filler = fill && w < 4;
        auto fill_load = [&](int it) { const float* src = ((it & 1) ? pv : pu) + (size_t)(it >> 1) * D; const float* src2 = src + 1024;
            unsigned lo = (unsigned)lane * 4u; asm volatile("" : "+v"(lo));
#pragma unroll
            for (int c8 = 0; c8 < 4; ++c8) { fx[c8] = __builtin_nontemporal_load((const f32x4*)(src + lo + c8 * 256)); fx[4 + c8] = __builtin_nontemporal_load((const f32x4*)(src2 + lo + c8 * 256)); } };
        if (filler) fill_load(fidx);
        {   const int row0 = chunk_row0(0); const bf16* pr = F.PROJ + (size_t)(row0 + srow) * INW;
            q0 = *(const u32x4*)(pr + cq); q1 = *(const u32x4*)(pr + cq + 8); k0 = *(const u32x4*)(pr + ck); k1 = *(const u32x4*)(pr + ck + 8); vr = *(const u32x4*)(pr + cvv);
            if (tid < 96) evr = *(const f32x4*)(ev_ptr(F.ws, row0 >> 6, h, dir) + tid * 4); }
        for (int c = 0; c < 36; ++c) {
            const int row0 = chunk_row0(c);
            __syncthreads();
            *(LAS u32x4*)(L + O_QT + srow * RS + sc16 * 2) = q0; *(LAS u32x4*)(L + O_QT + srow * RS + sc16 * 2 + 16) = q1;
            *(LAS u32x4*)(L + O_KT + srow * RS + sc16 * 2) = k0; *(LAS u32x4*)(L + O_KT + srow * RS + sc16 * 2 + 16) = k1;
            *(LAS u32x4*)(L + O_V + srow * RS64 + svc * 2) = vr;
            if (tid < 96) *(LAS f32x4*)(L + O_EV + tid * 16) = evr;
            if (c + 1 < 36) { const int rown = chunk_row0(c + 1); const bf16* pr = F.PROJ + (size_t)(rown + srow) * INW;
                q0 = *(const u32x4*)(pr + cq); q1 = *(const u32x4*)(pr + cq + 8); k0 = *(const u32x4*)(pr + ck); k1 = *(const u32x4*)(pr + ck + 8); vr = *(const u32x4*)(pr + cvv);
                if (tid < 96) evr = *(const f32x4*)(ev_ptr(F.ws, rown >> 6, h, dir) + tid * 4); }
            __syncthreads();
            {   const int kb = w >> 1, vb = w & 1;
                const LAS float* er = (const LAS float*)(L + O_EV) + kb * 32 + 4 * hh; const LAS float* ebr = er + 128; const LAS float* eb = er + 256;
#pragma unroll
                for (int g = 0; g < 4; ++g) { const f32x4 e4 = *(const LAS f32x4*)(er + 8 * g);
                    u32x2 pk; pk.x = pk2(S[4 * g] * e4.x, S[4 * g + 1] * e4.y); pk.y = pk2(S[4 * g + 2] * e4.z, S[4 * g + 3] * e4.w);
                    *(LAS u32x2*)(L + O_ST + (vb * 32 + r32) * RS + (kb * 32 + 8 * g + 4 * hh) * 2) = pk; }
                f32x16 U;
#pragma unroll
                for (int i = 0; i < 16; ++i) U[i] = 0.f;
#pragma unroll
                for (int ks = 0; ks < 4; ++ks) { const bf16x8v a = tr_frag(L + O_KT, RS, ks * 16 + 8 * hh, kb * 32, lane), bv = tr_frag(L + O_V, RS64, ks * 16 + 8 * hh, vb * 32, lane);
                    U = __builtin_amdgcn_mfma_f32_32x32x16_bf16(a, bv, U, 0, 0, 0); }
#pragma unroll
                for (int g = 0; g < 4; ++g) { const f32x4 b4 = *(const LAS f32x4*)(eb + 8 * g), c4 = *(const LAS f32x4*)(ebr + 8 * g);
                    S[4 * g] = b4.x * S[4 * g] + c4.x * U[4 * g]; S[4 * g + 1] = b4.y * S[4 * g + 1] + c4.y * U[4 * g + 1]; S[4 * g + 2] = b4.z * S[4 * g + 2] + c4.z * U[4 * g + 2]; S[4 * g + 3] = b4.w * S[4 * g + 3] + c4.w * U[4 * g + 3]; }
            }
            const bool outp = !(last && c < 4);
            if (w < 4 && outp) {
                const int tb = w >> 1, sb = w & 1;
                f32x16 acc;
#pragma unroll
                for (int i = 0; i < 16; ++i) acc[i] = 0.f;
#pragma unroll 4
                for (int ks = 0; ks < 8; ++ks) { const bf16x8v a = *(const LAS bf16x8v*)(L + O_QT + (tb * 32 + r32) * RS + (ks * 16 + 8 * hh) * 2), bq = *(const LAS bf16x8v*)(L + O_KT + (sb * 32 + r32) * RS + (ks * 16 + 8 * hh) * 2);
                    acc = __builtin_amdgcn_mfma_f32_32x32x16_bf16(a, bq, acc, 0, 0, 0); }
#pragma unroll
                for (int i = 0; i < 16; ++i) { const int t = tb * 32 + (i & 3) + 8 * (i >> 2) + 4 * hh, sp = sb * 32 + r32; const bool keep = dir ? (sp >= t) : (sp <= t);
                    *(LAS unsigned short*)(L + O_PM + t * RS64 + sp * 2) = f2bf1(keep ? acc[i] : 0.f); }
            }
            __syncthreads();
            if (filler && c < 32) {
                const int it = fidx + 1024 * c, e = it >> 1; unsigned char* dst = (it & 1) ? (unsigned char*)F.V : (unsigned char*)F.U;
                float am = 0.f;
#pragma unroll
                for (int c8 = 0; c8 < 8; ++c8) am = fmaxf(am, fmaxf(fmaxf(fabsf(fx[c8].x), fabsf(fx[c8].y)), fmaxf(fabsf(fx[c8].z), fabsf(fx[c8].w))));
#pragma unroll
                for (int o = 1; o < 64; o <<= 1) am = fmaxf(am, __shfl_xor(am, o));
                const float inv = am > 0.f ? 7.0f / am : 0.f, sc = am > 0.f ? am * (1.0f / 7.0f) : 0.f;
                v32h hx;
#pragma unroll
                for (int c8 = 0; c8 < 8; ++c8) { hx[c8 * 4 + 0] = (_Float16)(fx[c8].x * inv); hx[c8 * 4 + 1] = (_Float16)(fx[c8].y * inv); hx[c8 * 4 + 2] = (_Float16)(fx[c8].z * inv); hx[c8 * 4 + 3] = (_Float16)(fx[c8].w * inv); }
                const v6i p = __builtin_amdgcn_cvt_scalef32_pk32_fp6_f16(hx, 1.0f);
                eseg_store(dst, e, lane, p);
                if (lane == 0) ((float*)(F.ws + WS_ESCALE) + ((it & 1) ? NEXP : 0))[e] = sc;
                if (c + 1 < 32) fill_load(it + 1024);
            }
            if (w >= 4 && outp) {
                const int tb = (w - 4) >> 1, vb = (w - 4) & 1;
                f32x16 acc;
#pragma unroll
                for (int i = 0; i < 16; ++i) acc[i] = 0.f;
#pragma unroll
                for (int ks = 0; ks < 4; ++ks) { const bf16x8v a = *(const LAS bf16x8v*)(L + O_PM + (tb * 32 + r32) * RS64 + (ks * 16 + 8 * hh) * 2), bv = tr_frag(L + O_V, RS64, ks * 16 + 8 * hh, vb * 32, lane);
                    acc = __builtin_amdgcn_mfma_f32_32x32x16_bf16(a, bv, acc, 0, 0, 0); }
#pragma unroll 4
                for (int ks = 0; ks < 8; ++ks) { const bf16x8v a = *(const LAS bf16x8v*)(L + O_QT + (tb * 32 + r32) * RS + (ks * 16 + 8 * hh) * 2), bs = *(const LAS bf16x8v*)(L + O_ST + (vb * 32 + r32) * RS + (ks * 16 + 8 * hh) * 2);
                    acc = __builtin_amdgcn_mfma_f32_32x32x16_bf16(a, bs, acc, 0, 0, 0); }
                bf16* ob = (bf16*)F.OSC + ((size_t)dir * NTOK + row0) * DC + h * DK + vh * 64 + vb * 32 + r32;
#pragma unroll
                for (int i = 0; i < 16; ++i) { const int t = tb * 32 + (i & 3) + 8 * (i >> 2) + 4 * hh; ob[(size_t)t * DC] = f2bf1(acc[i]); }
            }
        }
    }
}

DI void phase_readout(int l, int nrows, int wv) {
    const Frame F = mkframe(wv);
    const int gw = blockIdx.x * NWAVES + F.wave, NGW = F.G * NWAVES;
    const float* ng = inp(I_HGG) + (size_t)l * DK;
    struct RowIn { u32x4 a[2], b[2]; u32x4 og[2]; };
    auto row_load = [&](int r, RowIn& R) { const bf16* prow = F.PROJ + (size_t)r * INW; const bf16* osc = (const bf16*)F.OSC;
#pragma unroll
        for (int c = 0; c < 2; ++c) { const int e0 = c * 512 + F.lane * 8;
            R.a[c] = *(const u32x4*)(osc + (size_t)r * DC + e0); R.b[c] = *(const u32x4*)(osc + ((size_t)NTOK + r) * DC + e0);
            R.og[c] = *(const u32x4*)(prow + C_OG + e0); } };
    auto row_compute = [&](int r, const RowIn& R) {
#pragma unroll
        for (int c = 0; c < 2; ++c) {
            const int e0 = c * 512 + F.lane * 8;
            float o[8], og[8], yb[8]; float ss = 0.f;
            { float fa[8], fb[8]; unpack8(R.a[c], fa); unpack8(R.b[c], fb);
#pragma unroll
              for (int j = 0; j < 8; ++j) o[j] = fa[j] + fb[j]; }
#pragma unroll
            for (int j = 0; j < 8; ++j) ss += o[j] * o[j];
            ss += __shfl_xor(ss, 1); ss += __shfl_xor(ss, 2); ss += __shfl_xor(ss, 4); ss += __shfl_xor(ss, 8);
            const float rs = rsqrtf(ss * (1.0f / DK) + LN_EPS);
            unpack8(R.og[c], og);
#pragma unroll
            for (int j = 0; j < 8; ++j) yb[j] = o[j] * rs * ng[(e0 + j) & (DK - 1)] * silu(og[j]);
            *(u32x2*)((unsigned char*)F.H + (size_t)r * D + DC + e0) = (u32x2){pk4_fp8(yb[0] * SA8_Y, yb[1] * SA8_Y, yb[2] * SA8_Y, yb[3] * SA8_Y), pk4_fp8(yb[4] * SA8_Y, yb[5] * SA8_Y, yb[6] * SA8_Y, yb[7] * SA8_Y)};
        } };
    RowIn RA, RB;
    int r = gw;
    if (r < nrows) row_load(r, RA);
    while (r < nrows) {
        const int n1 = r + NGW, n2 = r + 2 * NGW;
        if (n1 < nrows) row_load(n1, RB);
        row_compute(r, RA);
        if (n1 >= nrows) break;
        if (n2 < nrows) row_load(n2, RA);
        row_compute(n1, RB);
        r = n2;
    }
}

DI void phase_ln1(int l, int nrows, int wv) {
    const Frame F = mkframe(wv);
    const float* xin = inp(I_X); const float* cin = inp(I_CTX);
    const int gw = blockIdx.x * NWAVES + F.wave, NGW = F.G * NWAVES;
    const float* lg = inp(I_LN1G) + (size_t)l * D; const float* lbias = inp(I_LN1B) + (size_t)l * D;
    for (int r = gw; r < nrows; r += NGW) {
        const float* md = F.mod + ((size_t)l * 9 + modrow(r)) * MODW;
        float v[32], t[32];
        load_row_f32(xrow(xin, cin, F.X, l, r), F.lane, v);
        load_row_bf16(F.H + (size_t)r * D, F.lane, t);
        { float g1[32]; load_row_f32(md + 2 * D, F.lane, g1);
#pragma unroll
          for (int i = 0; i < 32; ++i) v[i] = ALPHA * v[i] + g1[i] * t[i]; }
        row_normalize(v);
        { float a[32], bb[32]; load_row_f32(lg, F.lane, a); load_row_f32(lbias, F.lane, bb);
#pragma unroll
          for (int i = 0; i < 32; ++i) v[i] = v[i] * a[i] + bb[i]; }
        store_row_f32(F.X + (size_t)r * D, F.lane, v);
        row_normalize(v);
        { float sh[32], sc[32]; load_row_f32(md + 3 * D, F.lane, sh); load_row_f32(md + 4 * D, F.lane, sc);
#pragma unroll
          for (int i = 0; i < 32; ++i) v[i] = v[i] * (1.0f + sc[i]) + sh[i]; }
        store_row_bf16(F.H + (size_t)r * D, F.lane, v);
    }
}

typedef __bf16 bf16x2v __attribute__((ext_vector_type(2)));
DI int crow32(int reg, int h) { return (reg & 3) + 8 * (reg >> 2) + 4 * h; }
#define CE_DESC(a, b) do { const float _x = (a), _y = (b); (a) = fmaxf(_x, _y); (b) = fminf(_x, _y); } while (0)
#define CE_ASC(a, b) do { const float _x = (a), _y = (b); (a) = fminf(_x, _y); (b) = fmaxf(_x, _y); } while (0)
DI void sort16_desc(float (&x)[16]) {
#pragma unroll
    for (int k = 2; k <= 16; k <<= 1)
#pragma unroll
        for (int j = k >> 1; j > 0; j >>= 1)
#pragma unroll
            for (int i = 0; i < 16; ++i) { const int l = i ^ j; if (l > i) { if ((i & k) == 0) CE_DESC(x[i], x[l]); else CE_ASC(x[i], x[l]); } }
}
DI void merge_top16(float (&a)[16], const float (&b)[16]) {
#pragma unroll
    for (int i = 0; i < 16; ++i) a[i] = fmaxf(a[i], b[15 - i]);
#pragma unroll
    for (int j = 8; j > 0; j >>= 1)
#pragma unroll
        for (int i = 0; i < 16; ++i) { const int l = i ^ j; if (l > i) CE_DESC(a[i], a[l]); }
}
DI void top16_of64(float (&x)[64], float (&t)[16]) {
    float g[4][16];
#pragma unroll
    for (int q = 0; q < 4; ++q) {
#pragma unroll
        for (int i = 0; i < 16; ++i) g[q][i] = x[q * 16 + i];
        sort16_desc(g[q]); }
    merge_top16(g[0], g[1]); merge_top16(g[2], g[3]); merge_top16(g[0], g[2]);
#pragma unroll
    for (int i = 0; i < 16; ++i) t[i] = g[0][i];
}
constexpr int cand_off(int i) { int o = 0; for (int a = 0; a < i; ++a) o += 16 / (a + 1); return o; }
static_assert(cand_off(16) == 50, "candidate count");
constexpr size_t WS_RIDX = 1068 * MiB, WS_RG = 1077 * MiB;
DI void route_block(const Frame& F, int t0, int t1) {
    const int lane = F.lane, r32 = lane & 31, hh = lane >> 5;
    unsigned short* RI = (unsigned short*)(F.ws + WS_RIDX) + (size_t)t0 * 128; float* RGl = (float*)(F.ws + WS_RG) + (size_t)t0 * 128;
    LAS unsigned* kl = (LAS unsigned*)(F.lds + 98304 + F.wave * 2048);
    const float NEG = -3.0e38f;
    const int ntile = (t1 - t0 + 31) / 32;
    for (int item = F.wave; item < ntile * NH; item += NWAVES) {
        const int tile = item >> 3, h = item & 7;
        const int tl = tile * 32 + r32; const bool valid = t0 + tl < t1;
        const int tok = valid ? t0 + tl : t1 - 1;
        float tv[2][16];
#pragma unroll
        for (int p = 0; p < 2; ++p) {
            f32x16 acc[4];
#pragma unroll
            for (int kb = 0; kb < 4; ++kb)
#pragma unroll
                for (int i = 0; i < 16; ++i) acc[kb][i] = 0.f;
            const bf16* qp = F.Y + (size_t)tok * D + (h * 2 + p) * 128 + 8 * hh;
            const bf16* kp = F.Keys + ((size_t)((h * 2 + p) * 128) + r32) * 128 + 8 * hh;
#pragma unroll 4
            for (int ks = 0; ks < 8; ++ks) {
                const bf16x8v bq = *(const bf16x8v*)(qp + ks * 16);
#pragma unroll
                for (int kb = 0; kb < 4; ++kb) { const bf16x8v ak = *(const bf16x8v*)(kp + (size_t)kb * 32 * 128 + ks * 16);
                    acc[kb] = __builtin_amdgcn_mfma_f32_32x32x16_bf16(ak, bq, acc[kb], 0, 0, 0); }
            }
            float x[64];
#pragma unroll
            for (int kb = 0; kb < 4; ++kb)
#pragma unroll
                for (int i = 0; i < 16; ++i) { const unsigned key = (unsigned)(kb * 32 + (i & 3) + 8 * (i >> 2)) + 4u * (unsigned)hh;
                    x[kb * 16 + i] = __uint_as_float((__float_as_uint(acc[kb][i]) & ~127u) | key); }
            float t[16], pb[16];
            top16_of64(x, t);
#pragma unroll
            for (int i = 0; i < 16; ++i) pb[i] = __shfl_xor(t[i], 32);
            merge_top16(t, pb);
#pragma unroll
            for (int i = 0; i < 16; ++i) tv[p][i] = t[i];
        }
#pragma unroll
        for (int w = 0; w < 8; ++w) { unsigned pk = 0;
#pragma unroll
            for (int b = 0; b < 4; ++b) { const int i = w * 4 + b; pk |= (__float_as_uint(i < 16 ? tv[0][i] : tv[1][i - 16]) & 127u) << (8 * b); }
            kl[w * 64 + lane] = pk; }
        float x[64];
#pragma unroll
        for (int i = 0; i < 64; ++i) x[i] = NEG;
#pragma unroll
        for (int i = 0; i < 16; ++i)
#pragma unroll
            for (int j = 0; j < 16; ++j) if ((i + 1) * (j + 1) <= 16) {
                const float sa = __uint_as_float(__float_as_uint(tv[0][i]) & ~127u), sb = __uint_as_float(__float_as_uint(tv[1][j]) & ~127u);
                x[cand_off(i) + j] = __uint_as_float((__float_as_uint(sa + sb) & ~255u) | (unsigned)(i * 16 + j)); }
        float c[16];
        top16_of64(x, c);
        asm volatile("s_waitcnt lgkmcnt(0)" ::: "memory");
        int eidx[16]; float ev[16]; float den = 0.f;
        const float mx = __uint_as_float(__float_as_uint(c[0]) & ~255u);
#pragma unroll
        for (int i = 0; i < 16; ++i) {
            const unsigned bits = __float_as_uint(c[i]); const int pos = bits & 255u, ia = pos >> 4, ib = 16 + (pos & 15);
            const unsigned wa = kl[(ia >> 2) * 64 + lane], wb = kl[(ib >> 2) * 64 + lane];
            const int ka = (wa >> (8 * (ia & 3))) & 127, kb2 = (wb >> (8 * (ib & 3))) & 127;
            eidx[i] = ka * 128 + kb2;
            ev[i] = __expf(__uint_as_float(bits & ~255u) - mx); den += ev[i]; }
        const float inv = 1.0f / den;
        if (valid) {
            if (hh == 0) {
#pragma unroll
                for (int q = 0; q < 2; ++q) *(u32x4*)(RI + tl * 128 + h * 16 + q * 8) = (u32x4){(unsigned)eidx[q * 8] | ((unsigned)eidx[q * 8 + 1] << 16), (unsigned)eidx[q * 8 + 2] | ((unsigned)eidx[q * 8 + 3] << 16), (unsigned)eidx[q * 8 + 4] | ((unsigned)eidx[q * 8 + 5] << 16), (unsigned)eidx[q * 8 + 6] | ((unsigned)eidx[q * 8 + 7] << 16)};
            } else {
#pragma unroll
                for (int q = 0; q < 4; ++q) *(f32x4*)(RGl + tl * 128 + h * 16 + q * 4) = (f32x4){ev[q * 4] * inv, ev[q * 4 + 1] * inv, ev[q * 4 + 2] * inv, ev[q * 4 + 3] * inv};
            }
        }
    }
}

DI float gelu_fast(float v) {
    const float av = fabsf(v), t = __builtin_amdgcn_rcpf(1.0f + 0.2316419f * av);
    float q = t * 0.5307027145f - 0.7265760135f; q = q * t + 0.7107068705f; q = q * t - 0.142248368f; q = q * t + 0.127414796f; q = q * t;
    const float m = v * (q * __builtin_amdgcn_exp2f(v * v * -0.72134752044f));
    return v < 0.f ? m : v - m;
}
constexpr size_t WS_PP = WS_OSC;
constexpr size_t WS_PW = WS_OSC + 72 * MiB;
static_assert(WS_PW + (size_t)NTOK * 128 * 4 <= WS_END, "ws map");
typedef float f32x2 __attribute__((ext_vector_type(2)));
template <int CTRL> DI float dpp_add(float x) { return x + __uint_as_float(__builtin_amdgcn_update_dpp(0u, __float_as_uint(x), CTRL, 0xf, 0xf, true)); }
struct ESeg { u32x4 a; u32x2 b; };
DI void eseg_load(ESeg& r, __amdgpu_buffer_rsrc_t rs, int voff) { r.a = __builtin_amdgcn_raw_buffer_load_b128(rs, voff, 0, 0); r.b = __builtin_amdgcn_raw_buffer_load_b64(rs, voff + 16, 0, 0); }
DI v32f eseg_unpack(const ESeg& r) { return __builtin_amdgcn_cvt_scalef32_pk32_f32_fp6((v6i){(int)r.a.x, (int)r.a.y, (int)r.a.z, (int)r.a.w, (int)r.b.x, (int)r.b.y}, 1.0f); }
DI unsigned char* uniform_ptr(unsigned char* p) {
    const unsigned long long v = (unsigned long long)p; const unsigned lo = __builtin_amdgcn_readfirstlane((unsigned)v), hi = __builtin_amdgcn_readfirstlane((unsigned)(v >> 32));
    return as_global<unsigned char>(((unsigned long long)hi << 32) | lo); }
DI void xcd_split(const Frame& F, int& x, int& wx, int& nwx) {
    if ((F.G & 7) == 0) { x = blockIdx.x & 7; wx = (blockIdx.x >> 3) * NWAVES + F.wave; nwx = (F.G >> 3) * NWAVES; }
    else { const int gw = blockIdx.x * NWAVES + F.wave, NW = F.G * NWAVES; x = gw & 7; wx = gw >> 3; nwx = (NW - x + 7) >> 3; }
}
DI void phase_peer_route(int nrows, int wv) {
    const Frame R = mkframe(wv);
    const int per0 = (nrows + R.G - 1) / R.G, s0 = blockIdx.x * per0, s1 = min(s0 + per0, nrows);
    __syncthreads();
    if (s0 < s1) route_block(R, s0, s1);
}
DI void ids_load(u32x4 (&d)[2], const unsigned short* RI16, int t, int g) { const u32x4* p = (const u32x4*)(RI16 + (size_t)t * 128 + g * 16); d[0] = p[0]; d[1] = p[1]; }
#ifndef ID_MASK
#define ID_MASK 0xffffu
#endif
DI int id_of(const u32x4 (&d)[2], int r, unsigned mask = 0xffffu) { const unsigned w = d[r >> 3][(r >> 1) & 3]; return (r & 1) ? (int)((w >> 16) & mask) : (int)(w & mask); }
template <int MODE = 0> DI void phase_peer_u(int nrows, int wv, unsigned mask = 0xffffu) {
    const Frame F = mkframe(wv);
    int x, wx, nwx; xcd_split(F, x, wx, nwx);
    const int lane = F.lane, s = lane & 7, g = lane >> 3, s24 = s * 24;
    const __amdgpu_buffer_rsrc_t US = __builtin_amdgcn_make_buffer_rsrc((void*)uniform_ptr((unsigned char*)F.U + (size_t)x * ESLICE), 0, (int)ESLICE, 0x00020000);
    const unsigned short* RI16 = (const unsigned short*)(F.ws + WS_RIDX);
    float* P = (float*)(F.ws + WS_PP) + (size_t)x * NTOK * 128;
    const bf16* Hs = F.H + (8 * x + s) * 4;
    int t = wx; if (t >= nrows) return;
    ESeg rw[16]; u32x4 idn[2], idnn[2]; u32x2 hp[8];
    { u32x4 idc[2]; ids_load(idc, RI16, t, g);
#pragma unroll
      for (int r = 0; r < 16; ++r) eseg_load(rw[r], US, id_of(idc, r, mask) * ESEG + s24); }
#pragma unroll
    for (int c = 0; c < 8; ++c) hp[c] = *(const u32x2*)(Hs + (size_t)t * D + c * 256);
    ids_load(idn, RI16, t + nwx < nrows ? t + nwx : t, g);
    __builtin_amdgcn_s_waitcnt(0);
    for (;;) {
        const int tn = t + nwx, tnn = tn + nwx, tn_c = tn < nrows ? tn : t, tnn_c = tnn < nrows ? tnn : t;
        ids_load(idnn, RI16, tnn_c, g);
        u32x2 hq[8];
#pragma unroll
        for (int c = 0; c < 8; ++c) hq[c] = hp[c];
        __builtin_amdgcn_sched_barrier(0);
#pragma unroll
        for (int c = 0; c < 8; ++c) hp[c] = *(const u32x2*)(Hs + (size_t)tn_c * D + c * 256);
        __builtin_amdgcn_sched_barrier(0);
        float o0 = 0.f, o1 = 0.f;
#pragma unroll
        for (int r = 0; r < 16; ++r) {
            if (MODE == 2) { o0 += __uint_as_float(rw[r].a.x ^ rw[r].a.w ^ rw[r].b.y); eseg_load(rw[r], US, id_of(idn, r, mask) * ESEG + s24); if (r & 1) __builtin_amdgcn_sched_barrier(0); continue; }
            typedef __bf16 bfx2 __attribute__((ext_vector_type(2))); typedef __bf16 bfx32 __attribute__((ext_vector_type(32)));
            const bfx32 rr = __builtin_amdgcn_cvt_scalef32_pk32_bf16_fp6((v6i){(int)rw[r].a.x, (int)rw[r].a.y, (int)rw[r].a.z, (int)rw[r].a.w, (int)rw[r].b.x, (int)rw[r].b.y}, 1.0f);
            float dA = 0.f, dB = 0.f;
#define DOT2(k, acc) acc = __builtin_amdgcn_fdot2_f32_bf16(__builtin_shufflevector(rr, rr, 2 * (k), 2 * (k) + 1), __builtin_bit_cast(bfx2, ((k) & 1) ? hq[(k) >> 1].y : hq[(k) >> 1].x), acc, false)
            DOT2(0, dA); DOT2(1, dB); DOT2(2, dA); DOT2(3, dB); DOT2(4, dA); DOT2(5, dB); DOT2(6, dA); DOT2(7, dB); DOT2(8, dA); DOT2(9, dB); DOT2(10, dA); DOT2(11, dB); DOT2(12, dA); DOT2(13, dB); DOT2(14, dA); DOT2(15, dB);
#undef DOT2
            float d = dA + dB;
            d = dpp_add<0xB1>(d); d = dpp_add<0x4E>(d); d = dpp_add<0x141>(d);
            if ((r >> 1) == s) { if (r & 1) o1 = d; else o0 = d; }
            if (MODE != 1) eseg_load(rw[r], US, id_of(idn, r, mask) * ESEG + s24);
            else asm volatile("" : "+v"(rw[r].a.x), "+v"(rw[r].a.y), "+v"(rw[r].a.z), "+v"(rw[r].a.w), "+v"(rw[r].b.x), "+v"(rw[r].b.y));
            if (r & 1) __builtin_amdgcn_sched_barrier(0);
        }
        *(f32x2*)(P + (size_t)t * 128 + g * 16 + 2 * s) = (f32x2){o0, o1};
        if (tn >= nrows) break;
        t = tn; idn[0] = idnn[0]; idn[1] = idnn[1];
    }
}
DI void phase_peer_w(int nrows, int wv) {
    const Frame F = mkframe(wv);
    const unsigned short* RI = (const unsigned short*)(F.ws + WS_RIDX); const float* RG = (const float*)(F.ws + WS_RG); const float* P = (const float*)(F.ws + WS_PP); float* W = (float*)(F.ws + WS_PW);
    const float* SU = (const float*)(F.ws + WS_ESCALE); const float* SV = SU + NEXP;
    const int n4 = nrows * 32;
    for (int i = blockIdx.x * NTHREADS + F.tid; i < n4; i += F.G * NTHREADS) {
        const u32x2 ep = *(const u32x2*)(RI + (size_t)i * 4); const u32x4 e = {ep.x & 0xffffu, ep.x >> 16, ep.y & 0xffffu, ep.y >> 16}; const f32x4 gt = *(const f32x4*)(RG + (size_t)i * 4);
        f32x4 sum = *(const f32x4*)(P + (size_t)i * 4);
#pragma unroll
        for (int xx = 1; xx < 8; ++xx) sum += *(const f32x4*)(P + (size_t)xx * NTOK * 128 + (size_t)i * 4);
        f32x4 w;
        w.x = gt.x * SV[e.x] * gelu_fast(SU[e.x] * sum.x); w.y = gt.y * SV[e.y] * gelu_fast(SU[e.y] * sum.y); w.z = gt.z * SV[e.z] * gelu_fast(SU[e.z] * sum.z); w.w = gt.w * SV[e.w] * gelu_fast(SU[e.w] * sum.w);
        *(f32x4*)(W + (size_t)i * 4) = w;
    }
}
DI void phase_peer_v(int l, int nrows, int wv, bool dry = false, unsigned mask = 0xffffu) {
    const Frame F = mkframe(wv);
    int x, wx, nwx; xcd_split(F, x, wx, nwx);
    const int lane = F.lane, s = lane & 7, g = lane >> 3, s24 = s * 24;
    const __amdgpu_buffer_rsrc_t VS = __builtin_amdgcn_make_buffer_rsrc((void*)uniform_ptr((unsigned char*)F.V + (size_t)x * ESLICE), 0, (int)ESLICE, 0x00020000);
    const unsigned short* RI16 = (const unsigned short*)(F.ws + WS_RIDX); const float* Wg = (const float*)(F.ws + WS_PW) + g * 16;
    const bool b3 = (lane >> 3) & 1; const int col = (((lane >> 5) * 2 + ((lane >> 4) & 1)) * 2 + (b3 ? 1 : 0)) * 256 + (8 * x + s) * 4;
    int t = wx; if (t >= nrows) return;
    ESeg rw[16]; u32x4 idn[2], idnn[2]; f32x4 wq[4];
    { u32x4 idc[2]; ids_load(idc, RI16, t, g);
#pragma unroll
      for (int r = 0; r < 16; ++r) eseg_load(rw[r], VS, id_of(idc, r, mask) * ESEG + s24); }
#pragma unroll
    for (int q = 0; q < 4; ++q) wq[q] = *(const f32x4*)(Wg + (size_t)t * 128 + q * 4);
    ids_load(idn, RI16, t + nwx < nrows ? t + nwx : t, g);
    __builtin_amdgcn_s_waitcnt(0);
    for (;;) {
        const int tn = t + nwx, tnn = tn + nwx, tn_c = tn < nrows ? tn : t, tnn_c = tnn < nrows ? tnn : t;
        ids_load(idnn, RI16, tnn_c, g);
        float wt[16];
#pragma unroll
        for (int q = 0; q < 4; ++q) { wt[q * 4] = wq[q].x; wt[q * 4 + 1] = wq[q].y; wt[q * 4 + 2] = wq[q].z; wt[q * 4 + 3] = wq[q].w; }
#pragma unroll
        for (int q = 0; q < 16; ++q) asm volatile("" : "+v"(wt[q]));
        __builtin_amdgcn_sched_barrier(0);
#pragma unroll
        for (int q = 0; q < 4; ++q) wq[q] = *(const f32x4*)(Wg + (size_t)tn_c * 128 + q * 4);
        float* xp = F.X + (size_t)t * D + col;
        const f32x4 x1 = *(const f32x4*)xp, g2 = *(const f32x4*)(F.mod + ((size_t)l * 9 + modrow(t)) * MODW + 5 * D + col);
        __builtin_amdgcn_sched_barrier(0);
        f32x2 fa[16];
#pragma unroll
        for (int j = 0; j < 16; ++j) fa[j] = (f32x2){0.f, 0.f};
#pragma unroll
        for (int r = 0; r < 16; ++r) {
            const v32f rr = eseg_unpack(rw[r]); const f32x2 w2 = {wt[r], wt[r]};
#pragma unroll
            for (int j = 0; j < 16; ++j) fa[j] = __builtin_elementwise_fma((f32x2){rr[2 * j], rr[2 * j + 1]}, w2, fa[j]);
            eseg_load(rw[r], VS, id_of(idn, r, mask) * ESEG + s24);
            if (r & 1) __builtin_amdgcn_sched_barrier(0);
        }
        float f16[16], f8[8];
#pragma unroll
        for (int j = 0; j < 16; ++j) { const float lo = (j & 1) ? fa[j >> 1].y : fa[j >> 1].x, hi = (j & 1) ? fa[8 + (j >> 1)].y : fa[8 + (j >> 1)].x;
            const auto a = __builtin_amdgcn_permlane32_swap(__float_as_uint(lo), __float_as_uint(hi), false, false); f16[j] = __uint_as_float(a[0]) + __uint_as_float(a[1]); }
#pragma unroll
        for (int j = 0; j < 8; ++j) { const auto a = __builtin_amdgcn_permlane16_swap(__float_as_uint(f16[j]), __float_as_uint(f16[j + 8]), false, false); f8[j] = __uint_as_float(a[0]) + __uint_as_float(a[1]); }
#pragma unroll
        for (int j = 0; j < 8; ++j) f8[j] = dpp_add<0x128>(f8[j]);
        f32x4 z;
        z.x = ALPHA * x1.x + g2.x * (b3 ? f8[4] : f8[0]); z.y = ALPHA * x1.y + g2.y * (b3 ? f8[5] : f8[1]); z.z = ALPHA * x1.z + g2.z * (b3 ? f8[6] : f8[2]); z.w = ALPHA * x1.w + g2.w * (b3 ? f8[7] : f8[3]);
        if (!dry) *(f32x4*)xp = z;
        if (tn >= nrows) break;
        t = tn; idn[0] = idnn[0]; idn[1] = idnn[1];
    }
}
DI void load16_f32(const float* src, int lane, float (&v)[32]) {
#pragma unroll
    for (int c = 0; c < 8; ++c) { const f32x4 a = *(const f32x4*)(src + c * 256 + lane * 4); v[c * 4 + 0] = a.x; v[c * 4 + 1] = a.y; v[c * 4 + 2] = a.z; v[c * 4 + 3] = a.w; }
}
DI void store16_f32(float* dst, int lane, const float (&v)[32]) {
#pragma unroll
    for (int c = 0; c < 8; ++c) *(f32x4*)(dst + c * 256 + lane * 4) = (f32x4){v[c * 4 + 0], v[c * 4 + 1], v[c * 4 + 2], v[c * 4 + 3]};
}
DI void phase_peer_ln2(int l, int nrows, bool last, int wv) {
    const Frame T = mkframe(wv);
    const int lane = T.lane;
    const float* lg2 = inp(I_LN2G) + (size_t)l * D; const float* lb2 = inp(I_LN2B) + (size_t)l * D;
#define CBAR() asm volatile("" ::: "memory")
    for (int r = blockIdx.x * NWAVES + T.wave; r < nrows; r += T.G * NWAVES) {
        float v[32];
        load16_f32(T.X + (size_t)r * D, lane, v);
        row_normalize(v);
        { float t[32]; load16_f32(lg2, lane, t);
#pragma unroll
          for (int i = 0; i < 32; ++i) v[i] *= t[i]; }
        CBAR();
        { float t[32]; load16_f32(lb2, lane, t);
#pragma unroll
          for (int i = 0; i < 32; ++i) v[i] += t[i]; }
        CBAR();
        store16_f32(last ? T.out + (size_t)r * D : T.X + (size_t)r * D, lane, v);
        if (!last) {
            const float* mdn = T.mod + ((size_t)(l + 1) * 9 + modrow(r)) * MODW;
            row_normalize(v);
            CBAR();
            { float t[32]; load16_f32(mdn + 1 * D, lane, t);
#pragma unroll
              for (int i = 0; i < 32; ++i) v[i] *= (1.0f + t[i]); }
            CBAR();
            { float t[32]; load16_f32(mdn + 0 * D, lane, t);
#pragma unroll
              for (int i = 0; i < 32; ++i) v[i] += t[i]; }
#pragma unroll
            for (int c = 0; c < 8; ++c) { u32x2 wv2; wv2.x = pk2(v[c * 4 + 0], v[c * 4 + 1]); wv2.y = pk2(v[c * 4 + 2], v[c * 4 + 3]);
                *(u32x2*)(T.H + (size_t)r * D + c * 256 + lane * 4) = wv2;
                *(unsigned*)(T.ws + WS_H8 + (size_t)r * D + c * 256 + lane * 4) = pk4_fp8(v[c * 4 + 0] * SA8_H, v[c * 4 + 1] * SA8_H, v[c * 4 + 2] * SA8_H, v[c * 4 + 3] * SA8_H); }
        }
        CBAR();
    }
#undef CBAR
}

#ifndef MK_N_LAUNCHES
#define MK_N_LAUNCHES 1
#endif
constexpr int PH_PER_LAYER = 15, N_PHASES = DEPTH * PH_PER_LAYER;
struct Args { const float* in[N_IN]; float* out; unsigned char* ws; int ph_lo, ph_hi; };
static_assert(sizeof(Args) == N_IN * 8 + 8 + 8 + 8, "Args has no padding");

struct OrderW8 : pg8::StaticOrder {
    int base, c_lo, nctx;
    __device__ void init3(int M_, int N_, int G_, int c_, int base_, int c_lo_, int nctx_) { init(M_, N_, G_, c_); base = base_; c_lo = c_lo_; nctx = nctx_; }
    __device__ bool unit_of(long L, pg8::Unit& u) const {
        if (L < nwg) { pg8::StaticOrder t = *this; t.c = (int)(L % G); return t.pg8::StaticOrder::next((int)(L / G), u); }
        const int r = (int)(L - nwg); if (r >= nctx) return false;
        u.pm = NLAT / 256 + (r & 7); u.pn = C_ZF / 256 + (r >> 3); return true;
    }
    __device__ bool next(int i, pg8::Unit& u) const {
        if (i < base) return unit_of((long)i * G + c, u);
        if (c < c_lo) return false;
        return unit_of((long)base * G + (long)(i - base) * (G - c_lo) + (c - c_lo), u);
    }
};
__global__ void __launch_bounds__(NTHREADS, 2) mk_fwd(Args args) {
    LAS unsigned char* ldsl = (LAS unsigned char*)lds_raw;
    for (int u = threadIdx.x; u < (LDS_BYTES - LDSCTL_OFF) / 4; u += NTHREADS) ((LAS unsigned*)(ldsl + LDSCTL_OFF))[u] = 0u;
    __syncthreads();
    if (threadIdx.x < N_IN + 2) { const int i = threadIdx.x; const unsigned long long v = i < N_IN ? (unsigned long long)args.in[i] : (i == N_IN ? (unsigned long long)args.out : (unsigned long long)args.ws);
        ((volatile LAS unsigned long long*)(ldsl + PTR_OFF))[i] = v; }
    __syncthreads();
    unsigned char* ws = as_global<unsigned char>(ld_ptr(N_IN + 1));
    const int wv = __builtin_amdgcn_readfirstlane(threadIdx.x >> 6);
    const int lo = args.ph_lo, hi = args.ph_hi;
    const bool multi = (hi - lo) > 1;
    XcdBarrier bar; bar.bar = (unsigned*)(ws + WS_CTL) + CW_BAR; bar.x = 0; bar.st = nullptr; bar.wv = wv;
    if (multi) bar = xcd_barrier_post((unsigned*)(ws + WS_CTL) + CW_BAR, (volatile LAS unsigned*)(ldsl + MISC_OFF) + 8, wv);
#ifndef PH_MASK
#define PH_MASK 0x7fff
#endif
#define IN(k) (((PH_MASK >> ((k) % PH_PER_LAYER)) & 1) && lo <= (k) && (k) < hi)
#define WSO() ({ unsigned long long _w = (unsigned long long)ws; asm volatile("" : "+s"(_w)); as_global<unsigned char>(_w); })
#define SEAM(k) do { if (IN(k) && IN((k) + 1)) xcd_barrier(bar); } while (0)

    for (int l = 0; l < DEPTH; ++l) {
        const int pb = l * PH_PER_LAYER;
        const bool last = (l == DEPTH - 1);
        const int nrows = last ? NLAT : NTOK;
        if (IN(pb + 0)) { phase_convert(l, wv, gridDim.x != 256); if (l == 0) phase_mod(wv);
#ifdef DUP_P0
            if (l == 0) { __syncthreads(); phase_convert(l, wv, gridDim.x != 256); phase_mod(wv); }
#endif
        }
        SEAM(pb + 0);
        if (IN(pb + 1) && l == 0) { phase_modulate1(l, wv);
#ifdef DUP_P1
            if (l == 0) { phase_modulate1(l, wv); phase_modulate1(l, wv); phase_modulate1(l, wv); phase_modulate1(l, wv); }
#endif
        }
        if (l == 0) SEAM(pb + 1);
        if (IN(pb + 2)) { unsigned char* wsl = WSO();
            {
                pg8::Gemm g{(bf16*)(wsl + WS_H), (bf16*)(wsl + WS_WIN), NTOK, 2 * DC, D, D}; pg8::StaticOrder S; S.init(NTOK, 2 * DC, (int)gridDim.x, (int)blockIdx.x);
                EpiStore E{(bf16*)(wsl + WS_PROJ) + C_ZF, INW, 1.0f, 1 << 30, 0};
                pg8::gemm_phase<EpiStore, pg8::StaticOrder, true, true>(ldsl, g, S, E, wv); }
            {
                const int mrows = last ? NLAT : NTOK;
                pg8::Gemm g{(bf16*)(wsl + WS_H8), (bf16*)(wsl + WS_WIN8), mrows, 10 * DC, D / 2, D / 2}; OrderW8 S;
                if (gridDim.x == 256) S.init3(mrows, 10 * DC, 256, (int)blockIdx.x, 9, 64, last ? 32 : 0);
                else S.init3(mrows, 10 * DC, (int)gridDim.x, (int)blockIdx.x, 1 << 20, 0, last ? 32 : 0);
                EpiStore E{(bf16*)(wsl + WS_PROJ), INW, 1.0f / (SW8 * SA8_H), C_ZF / 256, C_VI - C_ZF};
                pg8::gemm_phase<EpiStore, OrderW8, true, true, true>(ldsl, g, S, E, wv); }
        }
        SEAM(pb + 2);
        if (IN(pb + 3)) {
#ifdef DUP_PREP
            if (l == 0) phase_prep(l, wv, gridDim.x != 1);
#endif
            phase_prep(l, wv); }
        SEAM(pb + 3);
        if (IN(pb + 4)) { phase_scan(l, wv, gridDim.x == 256, last);
#ifdef DUP_P3
            if (l == 0) phase_scan(l, wv, gridDim.x == 256, last);
#endif
        }
        SEAM(pb + 4);
        if (IN(pb + 5)) phase_readout(l, nrows, wv);
        SEAM(pb + 5);
        if (IN(pb + 6)) { unsigned char* wsl = WSO(); pg8::Gemm g{(bf16*)(wsl + WS_H), (bf16*)(wsl + WS_WPA), nrows, D, D / 2, D / 2}; pg8::StaticOrder S; S.init(nrows, D, (int)gridDim.x, (int)blockIdx.x);
            EpiMerge E{(bf16*)(wsl + WS_PROJ) + C_GA, (bf16*)(wsl + WS_PROJ) + C_GB, INW, (bf16*)(wsl + WS_Y), D};
            pg8::gemm_phase<EpiMerge, pg8::StaticOrder, true, true, true>(ldsl, g, S, E, wv); }
        SEAM(pb + 6);
        if (IN(pb + 7)) { unsigned char* wsl = WSO(); pg8::Gemm g{(bf16*)(wsl + WS_Y), (bf16*)(wsl + WS_WO), nrows, D, D / 2, D / 2}; pg8::StaticOrder S; S.init(nrows, D, (int)gridDim.x, (int)blockIdx.x); EpiStore E{(bf16*)(wsl + WS_H), D, 1.0f / (SW8 * SA8_M), 1 << 30, 0};
            pg8::gemm_phase<EpiStore, pg8::StaticOrder, true, true, true>(ldsl, g, S, E, wv); }
        SEAM(pb + 7);
        if (IN(pb + 8)) phase_ln1(l, nrows, wv);
        SEAM(pb + 8);
        if (IN(pb + 9)) { unsigned char* wsl = WSO(); pg8::Gemm g{(bf16*)(wsl + WS_H), (bf16*)(wsl + WS_WQ), nrows, D, D, D}; pg8::StaticOrder S; S.init(nrows, D, (int)gridDim.x, (int)blockIdx.x); EpiStore E{(bf16*)(wsl + WS_Y), D, 1.0f, 1 << 30, 0};
            pg8::gemm_phase<EpiStore, pg8::StaticOrder, true, true>(ldsl, g, S, E, wv); }
        SEAM(pb + 9);

        if (IN(pb + 10)) { phase_peer_route(nrows, wv);
#ifdef DUP_RT
            if (last) phase_peer_route(nrows, wv);
#endif
        }
        SEAM(pb + 10);
        if (IN(pb + 11)) {
#ifdef DUP_PU
            if (last) phase_peer_u(nrows, wv, DUP_PU);
#endif
            phase_peer_u(nrows, wv); }
        SEAM(pb + 11);
        if (IN(pb + 12)) phase_peer_w(nrows, wv);
        SEAM(pb + 12);
        if (IN(pb + 13)) {
#ifdef DUP_PV
            if (last) phase_peer_v(l, nrows, wv, gridDim.x != 1, DUP_PV);
#endif
            phase_peer_v(l, nrows, wv); }
        SEAM(pb + 13);
        if (IN(pb + 14)) { phase_peer_ln2(l, nrows, last, wv);
#ifdef DUP_LN2
            if (last) { phase_peer_ln2(l, nrows, last, wv); phase_peer_ln2(l, nrows, last, wv); }
#endif
        }
        SEAM(pb + 14);
    }
#undef IN
#undef SEAM
}

extern "C" void kernel_launch(void* const* d_in, const int* in_sizes, int n_in, void* d_out, int out_size, void* d_ws, size_t ws_size, hipStream_t stream) {
    static int grid = 0;
    if (grid == 0) {
        if (n_in != N_IN || in_sizes[I_X] != NLAT * D || out_size != NLAT * D || ws_size < WS_H8 + 36 * MiB) { fprintf(stderr, "kernel_launch: unexpected shapes (n_in %d, ws %zu); nothing launched\n", n_in, ws_size); grid = -1; return; }
        int dev = 0, cus = 0, per_cu = 0;
        if (hipGetDevice(&dev) != hipSuccess || hipDeviceGetAttribute(&cus, hipDeviceAttributeMultiprocessorCount, dev) != hipSuccess) { grid = -1; return; }
        if (hipFuncSetAttribute((const void*)mk_fwd, hipFuncAttributeMaxDynamicSharedMemorySize, LDS_BYTES) != hipSuccess) { fprintf(stderr, "kernel_launch: hipFuncSetAttribute failed\n"); grid = -1; return; }
        if (hipOccupancyMaxActiveBlocksPerMultiprocessor(&per_cu, (const void*)mk_fwd, NTHREADS, LDS_BYTES) != hipSuccess || per_cu < 1) { fprintf(stderr, "kernel_launch: occupancy query says %d\n", per_cu); per_cu = 1; }
        (void)hipGetLastError();
        grid = cus;
        if ((NTOK + grid - 1) / grid > 96) { fprintf(stderr, "kernel_launch: %d CUs: the PEER phase holds at most 96 tokens per workgroup in LDS; nothing launched\n", cus); grid = -1; return; }
    }
    if (grid < 0) return;
    if (hipMemsetAsync((char*)d_ws + WS_CTL, 0, CTL_ZERO_BYTES, stream) != hipSuccess) return;
    Args a{};
    for (int i = 0; i < N_IN; ++i) a.in[i] = (const float*)d_in[i];
    a.out = (float*)d_out; a.ws = (unsigned char*)d_ws;
#if MK_N_LAUNCHES == 1
    a.ph_lo = 0; a.ph_hi = N_PHASES;
    hipLaunchKernelGGL(mk_fwd, dim3(grid), dim3(NTHREADS), LDS_BYTES, stream, a);
#else
    for (int p = 0; p < N_PHASES; ++p) { a.ph_lo = p; a.ph_hi = p + 1; hipLaunchKernelGGL(mk_fwd, dim3(grid), dim3(NTHREADS), LDS_BYTES, stream, a); }
#endif
}
```
